# Optimizing an MI355X kernel written in HIP

```python
import math
import jax, jax.numpy as jnp
from jax import lax
import numpy as np

D_MODEL = 2048
BATCH = 8
SEQ = 2048
DEPTH = 1

ROPE_THETA = 500000.0
Q_BLOCK = 128
NORM_EPS = 1e-6

DIFF_HEADS = 8
DIFF_HEAD_DIM = 64
DIFF_V_DIM = 2 * DIFF_HEAD_DIM
DIFF_ROT = DIFF_HEAD_DIM // 4
DIFF_SUBLN_EPS = 1e-5

MLA_HEADS = 8
MLA_Q_RANK = 512
MLA_KV_RANK = 256
MLA_NOPE_DIM = 128
MLA_ROPE_DIM = 64
MLA_V_DIM = 128

IN_SPLITS = (DIFF_HEADS * 2 * DIFF_HEAD_DIM,
             DIFF_HEADS * 2 * DIFF_HEAD_DIM,
             DIFF_HEADS * DIFF_V_DIM,
             MLA_Q_RANK,
             MLA_KV_RANK,
             MLA_ROPE_DIM,
             D_MODEL,
             D_MODEL)
D_IN = sum(IN_SPLITS)

MEM_LEN = 256
CROSS_HEADS = 4
CROSS_HEAD_DIM = 128

N_GROUPS = 4
EXPERTS_PER_GROUP = 8
N_EXPERTS = N_GROUPS * EXPERTS_PER_GROUP
TOP_K_IN_GROUP = 2
D_EXPERT = 512
MOE_BLOCK = 128

kernel_name = 'hybrid_diffattn_mla_hiermoe_encoder'


def rmsnorm(x, g, eps=NORM_EPS):
    xf = x.astype(jnp.float32)
    y = xf * lax.rsqrt(jnp.mean(xf * xf, axis=-1, keepdims=True) + eps)
    return (y * g.astype(jnp.float32)).astype(x.dtype)


def rope(x, positions, rot_dim):
    half = rot_dim // 2
    inv_freq = jnp.float32(ROPE_THETA) ** (-jnp.arange(half, dtype=jnp.float32) * 2.0 / rot_dim)
    ang = positions.astype(jnp.float32)[:, :, None] * inv_freq
    cos = jnp.cos(ang)[:, :, None, :]
    sin = jnp.sin(ang)[:, :, None, :]
    xr = x[..., :rot_dim].astype(jnp.float32)
    x1, x2 = xr[..., :half], xr[..., half:]
    rot = jnp.concatenate([x1 * cos - x2 * sin, x2 * cos + x1 * sin], axis=-1)
    return jnp.concatenate([rot.astype(x.dtype), x[..., rot_dim:]], axis=-1)


def sweep_query_blocks(fn, *q_arrays):
    b, s = q_arrays[0].shape[:2]
    nb = s // Q_BLOCK
    blocks = tuple(jnp.moveaxis(q.reshape(b, nb, Q_BLOCK, *q.shape[2:]), 1, 0) for q in q_arrays)
    out = lax.map(lambda blk: fn(*blk), blocks)
    out = jnp.moveaxis(out, 0, 1)
    return out.reshape(b, s, *out.shape[3:])


def differential_attention(q, k, v, lam, subln_g, lam_init):
    scale = DIFF_HEAD_DIM ** -0.5
    k1, k2 = k[..., 0, :], k[..., 1, :]

    def block(qb):
        s1 = jnp.einsum('bqhd,bkhd->bhqk', qb[..., 0, :], k1).astype(jnp.float32) * scale
        s2 = jnp.einsum('bqhd,bkhd->bhqk', qb[..., 1, :], k2).astype(jnp.float32) * scale
        a = jax.nn.softmax(s1, axis=-1) - lam * jax.nn.softmax(s2, axis=-1)
        return jnp.einsum('bhqk,bkhe->bqhe', a.astype(v.dtype), v)

    o = sweep_query_blocks(block, q)
    return rmsnorm(o, subln_g, DIFF_SUBLN_EPS) * (1.0 - lam_init)


def latent_attention(c_q, c_kv, k_pe_raw, positions, q_norm_g, w_uq, kv_norm_g, w_ukv):
    b, s = c_q.shape[:2]
    q = (rmsnorm(c_q, q_norm_g) @ w_uq).reshape(b, s, MLA_HEADS, MLA_NOPE_DIM + MLA_ROPE_DIM)
    q_nope = q[..., :MLA_NOPE_DIM]
    q_pe = rope(q[..., MLA_NOPE_DIM:], positions, MLA_ROPE_DIM)
    kv = (rmsnorm(c_kv, kv_norm_g) @ w_ukv).reshape(b, s, MLA_HEADS, MLA_NOPE_DIM + MLA_V_DIM)
    k_nope, v = kv[..., :MLA_NOPE_DIM], kv[..., MLA_NOPE_DIM:]
    k_pe = rope(k_pe_raw[:, :, None, :], positions, MLA_ROPE_DIM)[:, :, 0, :]
    scale = (MLA_NOPE_DIM + MLA_ROPE_DIM) ** -0.5

    def block(qn, qp):
        sc = (jnp.einsum('bqhd,bkhd->bhqk', qn, k_nope)
              + jnp.einsum('bqhr,bkr->bhqk', qp, k_pe)).astype(jnp.float32) * scale
        p = jax.nn.softmax(sc, axis=-1)
        return jnp.einsum('bhqk,bkhe->bqhe', p.astype(v.dtype), v)

    return sweep_query_blocks(block, q_nope, q_pe)


def memory_cross_attention(hn, mem, mem_norm_g, w_cq, w_ckv, w_co):
    b, s, _ = hn.shape
    m = mem.shape[1]
    q = (hn @ w_cq).reshape(b, s, CROSS_HEADS, CROSS_HEAD_DIM)
    kv = (rmsnorm(mem, mem_norm_g) @ w_ckv).reshape(b, m, 2, CROSS_HEADS, CROSS_HEAD_DIM)
    k, v = kv[:, :, 0], kv[:, :, 1]
    sc = jnp.einsum('bqhd,bmhd->bhqm', q, k).astype(jnp.float32) * CROSS_HEAD_DIM ** -0.5
    p = jax.nn.softmax(sc, axis=-1)
    o = jnp.einsum('bhqm,bmhd->bqhd', p.astype(v.dtype), v).reshape(b, s, CROSS_HEADS * CROSS_HEAD_DIM)
    return o @ w_co


def hierarchical_moe(t, w_rg, b_rg, w_re, b_re, w_gate, w_up, w_down):
    n, d = t.shape
    tf = t.astype(jnp.float32)
    g_prob = jax.nn.softmax(tf @ w_rg.astype(jnp.float32) + b_rg.astype(jnp.float32), axis=-1)
    g_p, g_idx = lax.top_k(g_prob, 1)
    e_logits = (tf @ w_re.astype(jnp.float32) + b_re.astype(jnp.float32)).reshape(n, N_GROUPS, EXPERTS_PER_GROUP)
    e_logits = jnp.take_along_axis(e_logits, g_idx[:, :, None], axis=1)[:, 0]
    e_p, e_local = lax.top_k(jax.nn.softmax(e_logits, axis=-1), TOP_K_IN_GROUP)
    e_p = e_p / jnp.sum(e_p, axis=-1, keepdims=True)
    weights = (g_p * e_p).reshape(-1)
    expert_ids = (g_idx * EXPERTS_PER_GROUP + e_local).reshape(-1).astype(jnp.int32)
    tok_ids = jnp.repeat(jnp.arange(n, dtype=jnp.int32), TOP_K_IN_GROUP)
    a = n * TOP_K_IN_GROUP

    order = jnp.argsort(expert_ids)
    e_sorted, tok_sorted, w_sorted = expert_ids[order], tok_ids[order], weights[order]
    counts = jnp.zeros((N_EXPERTS,), jnp.int32).at[expert_ids].add(1)
    offsets = jnp.cumsum(counts) - counts
    padded = ((counts + MOE_BLOCK - 1) // MOE_BLOCK) * MOE_BLOCK
    padded_end = jnp.cumsum(padded)
    padded_off = padded_end - padded
    dest = padded_off[e_sorted] + (jnp.arange(a, dtype=jnp.int32) - offsets[e_sorted])
    p_rows = ((a + MOE_BLOCK - 1) // MOE_BLOCK) * MOE_BLOCK + N_EXPERTS * MOE_BLOCK
    n_blocks = p_rows // MOE_BLOCK
    row_tok = jnp.full((p_rows,), n, jnp.int32).at[dest].set(tok_sorted)
    row_w = jnp.zeros((p_rows,), jnp.float32).at[dest].set(w_sorted)
    block_start = jnp.arange(n_blocks, dtype=jnp.int32) * MOE_BLOCK
    block_expert = jnp.clip(jnp.searchsorted(padded_end, block_start, side='right'), 0, N_EXPERTS - 1)

    xs = jnp.concatenate([t, jnp.zeros((1, d), t.dtype)], axis=0)
    xb = xs[row_tok].reshape(n_blocks, MOE_BLOCK, d)

    def expert_block(args):
        xblk, e = args
        hid = jax.nn.silu(xblk @ w_gate[e]) * (xblk @ w_up[e])
        return hid @ w_down[e]

    y = lax.map(expert_block, (xb, block_expert)).reshape(p_rows, d)
    out = jax.ops.segment_sum(y.astype(jnp.float32) * row_w[:, None], row_tok, num_segments=n + 1)[:n]
    return out.astype(t.dtype)


def setup_inputs(seed: int = 0) -> dict:
    key = jax.random.key(seed)
    ks = iter(jax.random.split(key, 40))
    L = DEPTH

    def w(shape, fan_in):
        return jax.random.normal(next(ks), shape, jnp.float32) * fan_in ** -0.5

    def gain(shape):
        return 1.0 + 0.01 * jax.random.normal(next(ks), shape, jnp.float32)

    def small(shape, s):
        return s * jax.random.normal(next(ks), shape, jnp.float32)

    return {
        'x': jax.random.normal(next(ks), (BATCH, SEQ, D_MODEL), jnp.float32),
        'mem': jax.random.normal(next(ks), (BATCH, MEM_LEN, D_MODEL), jnp.float32),
        'positions': jnp.broadcast_to(jnp.arange(SEQ, dtype=jnp.int32)[None, :], (BATCH, SEQ)),
        'attn_norm_g': gain((L, D_MODEL)),
        'w_in': w((L, D_MODEL, D_IN), D_MODEL),
        'diff_lambda_q1': small((L, DIFF_HEAD_DIM), 0.1),
        'diff_lambda_k1': small((L, DIFF_HEAD_DIM), 0.1),
        'diff_lambda_q2': small((L, DIFF_HEAD_DIM), 0.1),
        'diff_lambda_k2': small((L, DIFF_HEAD_DIM), 0.1),
        'diff_subln_g': gain((L, DIFF_V_DIM)),
        'w_o_diff': w((L, DIFF_HEADS * DIFF_V_DIM, D_MODEL), DIFF_HEADS * DIFF_V_DIM),
        'mla_q_norm_g': gain((L, MLA_Q_RANK)),
        'w_uq': w((L, MLA_Q_RANK, MLA_HEADS * (MLA_NOPE_DIM + MLA_ROPE_DIM)), MLA_Q_RANK),
        'mla_kv_norm_g': gain((L, MLA_KV_RANK)),
        'w_ukv': w((L, MLA_KV_RANK, MLA_HEADS * (MLA_NOPE_DIM + MLA_V_DIM)), MLA_KV_RANK),
        'w_o_mla': w((L, MLA_HEADS * MLA_V_DIM, D_MODEL), MLA_HEADS * MLA_V_DIM),
        'w_out': w((L, D_MODEL, D_MODEL), D_MODEL),
        'cross_norm_g': gain((L, D_MODEL)),
        'mem_norm_g': gain((L, D_MODEL)),
        'w_cq': w((L, D_MODEL, CROSS_HEADS * CROSS_HEAD_DIM), D_MODEL),
        'w_ckv': w((L, D_MODEL, 2 * CROSS_HEADS * CROSS_HEAD_DIM), D_MODEL),
        'w_co': w((L, CROSS_HEADS * CROSS_HEAD_DIM, D_MODEL), CROSS_HEADS * CROSS_HEAD_DIM),
        'ffn_norm_g': gain((L, D_MODEL)),
        'w_router_group': w((L, D_MODEL, N_GROUPS), D_MODEL),
        'b_router_group': small((L, N_GROUPS), 0.01),
        'w_router_expert': w((L, D_MODEL, N_EXPERTS), D_MODEL),
        'b_router_expert': small((L, N_EXPERTS), 0.01),
        'w_expert_gate': w((L, N_EXPERTS, D_MODEL, D_EXPERT), D_MODEL),
        'w_expert_up': w((L, N_EXPERTS, D_MODEL, D_EXPERT), D_MODEL),
        'w_expert_down': w((L, N_EXPERTS, D_EXPERT, D_MODEL), D_EXPERT),
        'final_norm_g': gain((D_MODEL,)),
    }


def reference(x, mem, positions, attn_norm_g, w_in,
              diff_lambda_q1, diff_lambda_k1, diff_lambda_q2, diff_lambda_k2, diff_subln_g, w_o_diff,
              mla_q_norm_g, w_uq, mla_kv_norm_g, w_ukv, w_o_mla, w_out,
              cross_norm_g, mem_norm_g, w_cq, w_ckv, w_co,
              ffn_norm_g, w_router_group, b_router_group, w_router_expert, b_router_expert,
              w_expert_gate, w_expert_up, w_expert_down, final_norm_g):
    b, s, d = x.shape
    split_points = [int(i) for i in np.cumsum(IN_SPLITS)[:-1]]
    h = x
    for l in range(DEPTH):
        lam_init = 0.8 - 0.6 * math.exp(-0.3 * l)

        xn = rmsnorm(h, attn_norm_g[l])
        proj = xn @ w_in[l]
        dq, dk, dv, c_q, c_kv, k_pe, g_a, g_b = jnp.split(proj, split_points, axis=-1)

        dq = rope(dq.reshape(b, s, 2 * DIFF_HEADS, DIFF_HEAD_DIM), positions, DIFF_ROT)
        dk = rope(dk.reshape(b, s, 2 * DIFF_HEADS, DIFF_HEAD_DIM), positions, DIFF_ROT)
        dq = dq.reshape(b, s, DIFF_HEADS, 2, DIFF_HEAD_DIM)
        dk = dk.reshape(b, s, DIFF_HEADS, 2, DIFF_HEAD_DIM)
        dv = dv.reshape(b, s, DIFF_HEADS, DIFF_V_DIM)
        lam = (jnp.exp(jnp.sum(diff_lambda_q1[l].astype(jnp.float32) * diff_lambda_k1[l].astype(jnp.float32)))
               - jnp.exp(jnp.sum(diff_lambda_q2[l].astype(jnp.float32) * diff_lambda_k2[l].astype(jnp.float32)))
               + lam_init)
        o_a = differential_attention(dq, dk, dv, lam, diff_subln_g[l], lam_init)
        y_a = o_a.reshape(b, s, DIFF_HEADS * DIFF_V_DIM) @ w_o_diff[l]

        o_b = latent_attention(c_q, c_kv, k_pe, positions, mla_q_norm_g[l], w_uq[l], mla_kv_norm_g[l], w_ukv[l])
        y_b = o_b.reshape(b, s, MLA_HEADS * MLA_V_DIM) @ w_o_mla[l]

        merged = jax.nn.sigmoid(g_a) * y_a + jax.nn.sigmoid(g_b) * y_b
        h = h + merged @ w_out[l]

        h = h + memory_cross_attention(rmsnorm(h, cross_norm_g[l]), mem, mem_norm_g[l], w_cq[l], w_ckv[l], w_co[l])

        t = rmsnorm(h, ffn_norm_g[l]).reshape(b * s, d)
        h = h + hierarchical_moe(t, w_router_group[l], b_router_group[l], w_router_expert[l], b_router_expert[l],
                                 w_expert_gate[l], w_expert_up[l], w_expert_down[l]).reshape(b, s, d)
    return rmsnorm(h, final_norm_g)
```

```cpp
#include <hip/hip_runtime.h>
#include <stdint.h>
#include <stdio.h>
namespace pg8 {
constexpr int MIXED_SA = 0x7c7c7c7c, MIXED_SB = 0x79797979;
#define PG8_LAS __attribute__((address_space(3)))
typedef unsigned short bf16_t;
typedef short bf16x8 __attribute__((ext_vector_type(8)));
typedef float f32x4 __attribute__((ext_vector_type(4)));
typedef float f32x2 __attribute__((ext_vector_type(2)));
typedef unsigned u32x4 __attribute__((ext_vector_type(4)));
typedef unsigned u32x2 __attribute__((ext_vector_type(2)));
typedef int i32x4 __attribute__((ext_vector_type(4)));
typedef int i32x8 __attribute__((ext_vector_type(8)));
constexpr int BM = 256, BK = 64, HALF = 128, HTB = HALF * BK * 2  , STAGE_BYTES = 8 * HTB, NXCD = 8, WGM = 8;

__host__ __device__ __forceinline__ int lds_byte(int r, int c) { const int st = (r >> 4) * 2 + (c >> 5), rr = r & 15, cc = c & 31, ob = rr * 64 + cc * 2; return st * 1024 + (ob ^ (((ob >> 9) & 1) << 5)); }
__host__ __device__ __forceinline__ void stage_rc(int b, int& R, int& C) { const int st = b / 1024, sb = b % 1024, swz = sb ^ (((sb >> 9) & 1) << 5); R = (st >> 1) * 16 + swz / 64; C = (st & 1) * 32 + (swz % 64) / 2; }
__host__ __device__ __forceinline__ int perm32(int rho) { const int n = rho >> 4, i = rho & 15; return 8 * (i >> 2) + 4 * n + (i & 3); }

struct Unit { int pm, pn, z; };

struct TileOrder {
    int nM, nN, nwg, G, c;
    __host__ __device__ void init(int nM_, int nN_, int G_, int c_) { nM = nM_; nN = nN_; nwg = nM * nN; G = G_; c = c_; }
    __host__ __device__ bool tile(int i, int& pm, int& pn) const {
        const long L = (long)i * G + c; if (L >= nwg) return false;
        int wgid = (int)L; { const int q = nwg / NXCD, r = nwg % NXCD, xcd = wgid % NXCD, off = wgid / NXCD; wgid = (xcd < r ? xcd * (q + 1) : r * (q + 1) + (xcd - r) * q) + off; }
        const int nig = WGM * nN, gid = wgid / nig, fm = gid * WGM, gsz = (nM - fm) < WGM ? (nM - fm) : WGM;
        pm = fm + ((wgid % nig) % gsz); pn = (wgid % nig) / gsz; return true;
    }
};

typedef __bf16 bf16x2_hw __attribute__((ext_vector_type(2)));
__device__ __forceinline__ unsigned cvt_pk_bf16(float lo, float hi) { const f32x2 v = {lo, hi}; return __builtin_bit_cast(unsigned, __builtin_convertvector(v, bf16x2_hw)); }
__device__ __forceinline__ u32x4 pack8(const f32x4 a, const f32x4 b) { u32x4 w; w.x = cvt_pk_bf16(a[0], a[1]); w.y = cvt_pk_bf16(a[2], a[3]); w.z = cvt_pk_bf16(b[0], b[1]); w.w = cvt_pk_bf16(b[2], b[3]); return w; }
__device__ __forceinline__ unsigned pack4_fp8(float a, float b, float c, float d) { int w = __builtin_amdgcn_cvt_pk_fp8_f32(a, b, 0, false); w = __builtin_amdgcn_cvt_pk_fp8_f32(c, d, w, true); return (unsigned)w; }
__device__ __forceinline__ float bf_lo(unsigned w) { return __uint_as_float(w << 16); }
__device__ __forceinline__ float bf_hi(unsigned w) { return __uint_as_float(w & 0xffff0000u); }

template <class Epi, class Sched, bool GATHER = false, bool ALIGN_EPI = true, bool CHAIN = false, int EB = 2, bool MIXED = false, bool I8 = false>
__device__ __forceinline__ void gemm_phase(PG8_LAS unsigned char* lds, const int K, const int lda, const int ldb, const Sched& S, const Epi& E, const int tid_in, const bool skip_epi = false) {
    int tid = tid_in; asm volatile("" : "+v"(tid));
    const int wid = __builtin_amdgcn_readfirstlane(tid >> 6), lane = tid & 63, wr = wid >> 2, wc = wid & 3, fr = lane & 15, fq = lane >> 4;
    int nt = K * EB / (BK * 2); if constexpr (EB == 1) asm volatile("" : "+s"(nt));
    int sR[2], sC[2];
    unsigned voA[2][2], nvoA[2][2], voffB[2];
#pragma unroll
    for (int i = 0; i < 2; ++i) { int R, C; stage_rc(tid * 16 + i * 8192, R, C); sR[i] = R; sC[i] = C; const int Rb = Epi::PERM ? ((R & ~31) + perm32(R & 31)) : R;
        voffB[i] = (unsigned)(Rb * ldb * EB + C * 2);
#pragma unroll
        for (int h = 0; h < 2; ++h) { voA[h][i] = (unsigned)((R + h * HALF) * lda * EB + C * 2); nvoA[h][i] = voA[h][i]; } }
    const size_t kstep = (size_t)(BK * 2);
    const size_t hstepB = (size_t)HALF * ldb * EB;
    const unsigned ldsw = (unsigned)wid * 1024u;
    const int aoff = lds_byte(wr * 64 + fr, fq * 8), boff = lds_byte(wc * 32 + fr, fq * 8);
#define PG8_SA(b, h) (((b) * 2 + (h)) * HTB)
#define PG8_SB(b, h) ((4 + (b) * 2 + (h)) * HTB)
#define PG8_STAGEB(bufoff, gbase) do { _Pragma("unroll") for (int _i = 0; _i < 2; ++_i) \
        __builtin_amdgcn_global_load_lds((const unsigned*)((const char*)(gbase) + voffB[_i]), (PG8_LAS unsigned*)(lds + (bufoff) + ldsw + _i * 8192), 16, 0, 0); } while (0)
#define PG8_STAGEA(bufoff, gbase, h, nx) do { _Pragma("unroll") for (int _i = 0; _i < 2; ++_i) { const unsigned _vo = (GATHER && (nx)) ? nvoA[h][_i] : voA[h][_i]; \
        __builtin_amdgcn_global_load_lds((const unsigned*)((const char*)(gbase) + _vo), (PG8_LAS unsigned*)(lds + (bufoff) + ldsw + _i * 8192), 16, 0, 0); } } while (0)
#define PG8_LDA(dst, b, h) do { _Pragma("unroll") for (int m = 0; m < 4; ++m) _Pragma("unroll") for (int k = 0; k < 2; ++k) dst[m][k] = *(const PG8_LAS bf16x8*)(lds + PG8_SA(b, h) + aoff + m * 2048 + k * 1024); } while (0)
#define PG8_LDB(dst, b, h) do { _Pragma("unroll") for (int n = 0; n < 2; ++n) _Pragma("unroll") for (int k = 0; k < 2; ++k) dst[n][k] = *(const PG8_LAS bf16x8*)(lds + PG8_SB(b, h) + boff + n * 2048 + k * 1024); } while (0)
#define PG8_MMAF(F8, ai, bj, At, Bt) do { __builtin_amdgcn_s_setprio(1); if constexpr (F8 && I8) { _Pragma("unroll") for (int m = 0; m < 4; ++m) _Pragma("unroll") for (int n = 0; n < 2; ++n) { _Pragma("unroll") for (int k = 0; k < 2; ++k) \
            acc[ai][bj][m][n] = __builtin_bit_cast(f32x4, __builtin_amdgcn_mfma_i32_16x16x64_i8(__builtin_bit_cast(i32x4, Bt[n][k]), __builtin_bit_cast(i32x4, At[m][k]), __builtin_bit_cast(i32x4, acc[ai][bj][m][n]), 0, 0, 0)); } \
          _Pragma("unroll") for (int m = 0; m < 4; ++m) _Pragma("unroll") for (int n = 0; n < 2; ++n) asm volatile("" : "+v"(acc[ai][bj][m][n])); } \
      else if constexpr (F8) { _Pragma("unroll") for (int m = 0; m < 4; ++m) _Pragma("unroll") for (int n = 0; n < 2; ++n) { i32x8 _a, _b; \
            { const i32x4 _b0 = __builtin_bit_cast(i32x4, Bt[n][0]), _b1 = __builtin_bit_cast(i32x4, Bt[n][1]), _a0 = __builtin_bit_cast(i32x4, At[m][0]), _a1 = __builtin_bit_cast(i32x4, At[m][1]); \
              _b = (i32x8){_b0[0], _b0[1], _b0[2], _b0[3], _b1[0], _b1[1], _b1[2], _b1[3]}; _a = (i32x8){_a0[0], _a0[1], _a0[2], _a0[3], _a1[0], _a1[1], _a1[2], _a1[3]}; } \
            acc[ai][bj][m][n] = __builtin_amdgcn_mfma_scale_f32_16x16x128_f8f6f4(_b, _a, acc[ai][bj][m][n], 0, 0, 0, MIXED ? MIXED_SB : 0x7f7f7f7f, 0, MIXED ? MIXED_SA : 0x7f7f7f7f); } \
          _Pragma("unroll") for (int m = 0; m < 4; ++m) _Pragma("unroll") for (int n = 0; n < 2; ++n) asm volatile("" : "+v"(acc[ai][bj][m][n])); }     \
        else { _Pragma("unroll") for (int m = 0; m < 4; ++m) _Pragma("unroll") for (int n = 0; n < 2; ++n) { _Pragma("unroll") for (int k = 0; k < 2; ++k) acc[ai][bj][m][n] = __builtin_amdgcn_mfma_f32_16x16x32_bf16(Bt[n][k], At[m][k], acc[ai][bj][m][n], 0, 0, 0); } } \
        __builtin_amdgcn_s_setprio(0); } while (0)
#define PG8_KLOOP(F8, NTU) \
        for (int t = 0; t < (NTU); t += 2) { \
            const bool last = (t == (NTU) - 2); \
            const char* a1 = cA + (size_t)(t + 1) * kstep; \
            const char* a2 = last ? nA : cA + (size_t)(t + 2) * kstep; const char* b2 = last ? nB : cB + (size_t)(t + 2) * kstep; \
            const char* a3 = a2 + kstep; const char* b3 = b2 + kstep; \
            PG8_LDB(B0, 0, 0); PG8_LDB(B1, 0, 1); PG8_SCHED; PG8_LDA(At, 0, 0); PG8_STAGEA(PG8_SA(1, 1), a1, 1, false); \
            PG8_WAIT_V(8); PG8_WAIT_L(0); PG8_BAR; PG8_MMAF(F8, 0, 0, At, B0); PG8_MMAF(F8, 0, 1, At, B1); PG8_BAR; PG8_SCHED; \
            PG8_LDA(At, 0, 1); PG8_STAGEB(PG8_SB(0, 0), b2); PG8_STAGEB(PG8_SB(0, 1), b2 + hstepB); PG8_STAGEA(PG8_SA(0, 0), a2, 0, last); \
            PG8_WAIT_V(8); PG8_WAIT_L(0); PG8_BAR; PG8_MMAF(F8, 1, 0, At, B0); PG8_MMAF(F8, 1, 1, At, B1); PG8_BAR; PG8_SCHED; \
            PG8_LDB(B0, 1, 0); PG8_LDB(B1, 1, 1); PG8_SCHED; PG8_LDA(At, 1, 0); PG8_STAGEA(PG8_SA(0, 1), a2, 1, last); \
            PG8_WAIT_V(8); PG8_WAIT_L(0); PG8_BAR; PG8_MMAF(F8, 0, 0, At, B0); PG8_MMAF(F8, 0, 1, At, B1); PG8_BAR; PG8_SCHED; \
            PG8_LDA(At, 1, 1); PG8_STAGEB(PG8_SB(1, 0), b3); PG8_STAGEB(PG8_SB(1, 1), b3 + hstepB); PG8_STAGEA(PG8_SA(1, 0), a3, 0, last); \
            PG8_WAIT_V(8); PG8_WAIT_L(0); PG8_BAR; PG8_MMAF(F8, 1, 0, At, B0); PG8_MMAF(F8, 1, 1, At, B1); PG8_BAR; PG8_SCHED; \
        }
#define PG8_WAIT_V(n) asm volatile("s_waitcnt vmcnt(" #n ")" ::: "memory")
#define PG8_WAIT_L(n) asm volatile("s_waitcnt lgkmcnt(" #n ")" ::: "memory")
#define PG8_BAR __builtin_amdgcn_s_barrier()
#define PG8_SCHED __builtin_amdgcn_sched_barrier(0)
#define PG8_GATHER_OFFS(dst, unit) do { if constexpr (GATHER) { _Pragma("unroll") for (int _i = 0; _i < 2; ++_i) _Pragma("unroll") for (int _h = 0; _h < 2; ++_h) \
        dst[_h][_i] = (unsigned)(S.arow(unit, sR[_i] + _h * HALF) * lda * EB + sC[_i] * 2); } } while (0)
    Unit cur, nxt; int ui = 0;
    if (!S.next(0, cur)) return;
    f32x4 acc[2][2][4][2];
#pragma unroll
    for (int a = 0; a < 2; ++a)
#pragma unroll
        for (int b = 0; b < 2; ++b)
#pragma unroll
            for (int m = 0; m < 4; ++m)
#pragma unroll
                for (int n = 0; n < 2; ++n) acc[a][b][m][n] = (f32x4){0.f, 0.f, 0.f, 0.f};
    bf16x8 At[4][2], B0[2][2], B1[2][2];
    const char* cA = S.A(cur); const char* cB = S.B(cur);
    PG8_GATHER_OFFS(voA, cur);
    PG8_STAGEB(PG8_SB(0, 0), cB); PG8_STAGEB(PG8_SB(0, 1), cB + hstepB); PG8_STAGEA(PG8_SA(0, 0), cA, 0, false); PG8_STAGEA(PG8_SA(0, 1), cA, 1, false);
    if (wr == 1) PG8_BAR;
    PG8_WAIT_V(2); PG8_BAR;
    PG8_STAGEB(PG8_SB(1, 0), cB + kstep); PG8_STAGEA(PG8_SA(1, 0), cA + kstep, 0, false); PG8_STAGEB(PG8_SB(1, 1), cB + hstepB + kstep);
    PG8_WAIT_V(6); PG8_BAR;
    if constexpr (MIXED) {
      for (;;) {
        { const bool has_next = S.next(ui + 1, nxt); const char* nA = has_next ? S.A(nxt) : cA; const char* nB = has_next ? S.B(nxt) : cB;
          PG8_KLOOP(false, nt)
          if (wr == 0) PG8_BAR;
          { int le = lane; asm volatile("" : "+v"(le)); E.mid(acc, cur, wr, wc, le & 15, le >> 4); }
          cur = nxt; cA = nA; cB = nB; ++ui;
          if (wr == 1) PG8_BAR; }
        { const bool has_next = S.next(ui + 1, nxt); const char* nA = has_next ? S.A(nxt) : cA; const char* nB = has_next ? S.B(nxt) : cB;
          int nth = nt >> 1; asm volatile("" : "+s"(nth));
          PG8_KLOOP(true, nth)
          if (wr == 0) PG8_BAR;
          { int le = lane; asm volatile("" : "+v"(le)); E(acc, cur, wr, wc, le & 15, le >> 4); }
          if (!has_next) break;
#pragma unroll
          for (int a = 0; a < 2; ++a)
#pragma unroll
            for (int b = 0; b < 2; ++b)
#pragma unroll
                for (int m = 0; m < 4; ++m)
#pragma unroll
                    for (int n = 0; n < 2; ++n) acc[a][b][m][n] = (f32x4){0.f, 0.f, 0.f, 0.f};
          cur = nxt; cA = nA; cB = nB; ++ui;
          if (wr == 1) PG8_BAR; }
      }
    } else
    for (;;) {
        const bool has_next = S.next(ui + 1, nxt);
        const char* nA = has_next ? S.A(nxt) : cA; const char* nB = has_next ? S.B(nxt) : cB;
        if constexpr (GATHER) { if (has_next) { PG8_GATHER_OFFS(nvoA, nxt); } else {
#pragma unroll
            for (int i = 0; i < 2; ++i)
#pragma unroll
                for (int h = 0; h < 2; ++h) nvoA[h][i] = voA[h][i]; } }
        PG8_KLOOP(EB == 1, nt)
        if constexpr (ALIGN_EPI) { if (wr == 0) PG8_BAR; }
        const bool chained = CHAIN && cur.z == 0;
        { int le = lane; asm volatile("" : "+v"(le));
          if (!skip_epi) { if constexpr (CHAIN) { if (chained) E.mid(acc, cur, wr, wc, le & 15, le >> 4); else E(acc, cur, wr, wc, le & 15, le >> 4); } else E(acc, cur, wr, wc, le & 15, le >> 4); }
          else { _Pragma("unroll") for (int a = 0; a < 2; ++a) _Pragma("unroll") for (int b = 0; b < 2; ++b) _Pragma("unroll") for (int m = 0; m < 4; ++m) _Pragma("unroll") for (int n = 0; n < 2; ++n) asm volatile("" :: "v"(acc[a][b][m][n])); } }
        if (!has_next) break;
        if (!chained) {
#pragma unroll
        for (int a = 0; a < 2; ++a)
#pragma unroll
            for (int b = 0; b < 2; ++b)
#pragma unroll
                for (int m = 0; m < 4; ++m)
#pragma unroll
                    for (int n = 0; n < 2; ++n) acc[a][b][m][n] = (f32x4){0.f, 0.f, 0.f, 0.f};
        }
        cur = nxt; cA = nA; cB = nB; ++ui;
        if constexpr (GATHER) {
#pragma unroll
            for (int i = 0; i < 2; ++i)
#pragma unroll
                for (int h = 0; h < 2; ++h) voA[h][i] = nvoA[h][i]; }
        if constexpr (ALIGN_EPI) { if (wr == 1) PG8_BAR; }
    }
    PG8_WAIT_V(0);
    if constexpr (!ALIGN_EPI) { if (wr == 0) PG8_BAR; }
    PG8_BAR;
#undef PG8_SA
#undef PG8_SB
#undef PG8_STAGEA
#undef PG8_STAGEB
#undef PG8_LDA
#undef PG8_LDB
#undef PG8_MMAF
#undef PG8_KLOOP
#undef PG8_WAIT_V
#undef PG8_WAIT_L
#undef PG8_BAR
#undef PG8_SCHED
#undef PG8_GATHER_OFFS
}
}
namespace att {
using bf16x8 = __attribute__((ext_vector_type(8))) short;
using s16x4  = __attribute__((ext_vector_type(4))) short;
using f32x16 = __attribute__((ext_vector_type(16))) float;
using u32x4  = __attribute__((ext_vector_type(4))) unsigned;
typedef unsigned short bf16_t;
constexpr int NW = 8, QBLK = 32, KVBLK = 64, DV = 128;
constexpr float THR2 = 8.f * 1.4426950408889634f;
#define ATT_SBAR() __builtin_amdgcn_sched_barrier(0)
#ifndef ATT_QKT_SB
#define ATT_QKT_SB 0
#endif
__device__ __forceinline__ int crow(int r, int hi) { return (r & 3) + 8 * (r >> 2) + 4 * hi; }
__device__ __forceinline__ unsigned cvtpk(float lo, float hi) { return pg8::cvt_pk_bf16(lo, hi); }

template <int DQK> __device__ __forceinline__ int kswz(int row, int chunk) {
    if constexpr (DQK == 128) return row * 256 + ((chunk ^ (row & 7)) << 4);
    else return row * (2 * DQK) + ((chunk ^ ((row >> 1) & 7)) << 4);
}
constexpr size_t SHM_V = KVBLK * DV * 2;
template <int DQK> constexpr size_t shm_k() { return (size_t)KVBLK * DQK * 2; }
template <int DQK> constexpr size_t shm_bytes() { return 2 * SHM_V + 2 * shm_k<DQK>() + NW * 64 * 4; }

__device__ __forceinline__ void partialSM(f32x16& p0, f32x16& p1, float& m_reg, float& mn, float& alpha) {
    float pmax = p0[0];
#pragma unroll
    for (int r = 1; r < 16; ++r) pmax = fmaxf(pmax, p0[r]);
#pragma unroll
    for (int r = 0; r < 16; ++r) pmax = fmaxf(pmax, p1[r]);
    { auto rr = __builtin_amdgcn_permlane32_swap(__float_as_uint(pmax), __float_as_uint(pmax), false, false);
      pmax = fmaxf(__uint_as_float(rr[0]), __uint_as_float(rr[1])); }
    if (__builtin_expect(__all(pmax - m_reg <= THR2), 1)) { mn = m_reg; alpha = 1.f; }
    else { mn = fmaxf(m_reg, pmax); alpha = __builtin_amdgcn_exp2f(m_reg - mn); m_reg = mn; }
#pragma unroll
    for (int r = 0; r < 16; ++r) p0[r] = p0[r] - mn;
#pragma unroll
    for (int r = 0; r < 16; ++r) p1[r] = p1[r] - mn;
#pragma unroll
    for (int r = 0; r < 16; ++r) p0[r] = __builtin_amdgcn_exp2f(p0[r]);
}
__device__ __forceinline__ void finishSM(f32x16& p0, f32x16& p1, float alpha, float& l_reg, bf16x8& pa0, bf16x8& pa1, bf16x8& pa2, bf16x8& pa3) {
#pragma unroll
    for (int r = 0; r < 16; ++r) p1[r] = __builtin_amdgcn_exp2f(p1[r]);
    float ps = 0;
#pragma unroll
    for (int r = 0; r < 16; ++r) ps += p0[r];
#pragma unroll
    for (int r = 0; r < 16; ++r) ps += p1[r];
    { auto rr = __builtin_amdgcn_permlane32_swap(__float_as_uint(ps), __float_as_uint(ps), false, false);
      ps = __uint_as_float(rr[0]) + __uint_as_float(rr[1]); }
    l_reg = l_reg * alpha + ps;
#define ATT_PK4(P, BASE, OUT) do { unsigned a0 = cvtpk(P[BASE + 0], P[BASE + 1]), a1 = cvtpk(P[BASE + 2], P[BASE + 3]);   \
    unsigned b0 = cvtpk(P[BASE + 4], P[BASE + 5]), b1 = cvtpk(P[BASE + 6], P[BASE + 7]);                              \
    auto r0 = __builtin_amdgcn_permlane32_swap(a0, b0, false, false); auto r1 = __builtin_amdgcn_permlane32_swap(a1, b1, false, false); \
    u32x4 w = {r0[0], r1[0], r0[1], r1[1]}; OUT = *reinterpret_cast<bf16x8*>(&w); } while (0)
    ATT_PK4(p0, 0, pa0); ATT_PK4(p0, 8, pa1); ATT_PK4(p1, 0, pa2); ATT_PK4(p1, 8, pa3);
#undef ATT_PK4
}
#define ATT_LAS __attribute__((address_space(3)))
template <int DQK, int NQR> __device__ __forceinline__ void qkt(f32x16& p0, f32x16& p1, const unsigned (&kb)[4], const int bufoff, const bf16x8* qr, const unsigned (&qlds)[4]) {
    p0 = f32x16{}; p1 = f32x16{};
#pragma unroll
    for (int d0 = 0; d0 < DQK / 16; ++d0) {
        const bf16x8 b0 = *(const ATT_LAS bf16x8*)(uintptr_t)(kb[d0 & 3] + (unsigned)(bufoff + 128 * (d0 >> 2)));
        const bf16x8 b1 = *(const ATT_LAS bf16x8*)(uintptr_t)(kb[d0 & 3] + (unsigned)(bufoff + 128 * (d0 >> 2) + 32 * 2 * DQK));
        bf16x8 q;
        if constexpr (NQR < DQK / 16) { if (d0 < NQR) q = qr[d0 < NQR ? d0 : 0]; else q = *(const ATT_LAS bf16x8*)(uintptr_t)qlds[(d0 - NQR) & 3]; }
        else q = qr[d0];
        p0 = __builtin_amdgcn_mfma_f32_32x32x16_bf16(b0, q, p0, 0, 0, 0);
        p1 = __builtin_amdgcn_mfma_f32_32x32x16_bf16(b1, q, p1, 0, 0, 0); }
}
__device__ __forceinline__ int v_st(int k, int c) { const int kk = (k & ~0xC) | ((k & 4) << 1) | ((k & 8) >> 1); return ((kk >> 3) * 4 + (c >> 5)) * 512 + ((kk & 7) * 32 + (c & 31)) * 2; }
__device__ __forceinline__ int v_rd_base(int lane) { return ((lane & 3) << 3) | (((lane >> 2) & 3) << 6) | (((lane >> 4) & 1) << 5) | (((lane >> 5) & 1) << 8); }
constexpr int v_rd_off(int d0, int ks, int half) { return d0 * 512 + ks * 4096 + half * 2048; }
template <int OFF> __device__ __forceinline__ s16x4 tr_read(int vb) {
    s16x4 r; asm volatile("ds_read_b64_tr_b16 %0, %1 offset:%2" : "=&v"(r) : "v"(vb), "i"(OFF) : "memory"); return r;
}
template <int D0> __device__ __forceinline__ void pv_one(f32x16& od, int vb, bf16x8 pa0, bf16x8 pa1, bf16x8 pa2, bf16x8 pa3) {
    const s16x4 l0 = tr_read<v_rd_off(D0, 0, 0)>(vb), h0 = tr_read<v_rd_off(D0, 0, 1)>(vb), l1 = tr_read<v_rd_off(D0, 1, 0)>(vb), h1 = tr_read<v_rd_off(D0, 1, 1)>(vb);
    const s16x4 l2 = tr_read<v_rd_off(D0, 2, 0)>(vb), h2 = tr_read<v_rd_off(D0, 2, 1)>(vb), l3 = tr_read<v_rd_off(D0, 3, 0)>(vb), h3 = tr_read<v_rd_off(D0, 3, 1)>(vb);
    asm volatile("s_waitcnt lgkmcnt(0)" ::: "memory"); ATT_SBAR();
#define ATT_PK(L, H) (bf16x8){L[0], L[1], L[2], L[3], H[0], H[1], H[2], H[3]}
    od = __builtin_amdgcn_mfma_f32_32x32x16_bf16(pa0, ATT_PK(l0, h0), od, 0, 0, 0);
    od = __builtin_amdgcn_mfma_f32_32x32x16_bf16(pa1, ATT_PK(l1, h1), od, 0, 0, 0);
    od = __builtin_amdgcn_mfma_f32_32x32x16_bf16(pa2, ATT_PK(l2, h2), od, 0, 0, 0);
    od = __builtin_amdgcn_mfma_f32_32x32x16_bf16(pa3, ATT_PK(l3, h3), od, 0, 0, 0);
#undef ATT_PK
}
struct VFrag { s16x4 l0, h0, l1, h1, l2, h2, l3, h3; };
template <int D0> __device__ __forceinline__ void v_rd(VFrag& f, int vb) {
    f.l0 = tr_read<v_rd_off(D0, 0, 0)>(vb); f.h0 = tr_read<v_rd_off(D0, 0, 1)>(vb); f.l1 = tr_read<v_rd_off(D0, 1, 0)>(vb); f.h1 = tr_read<v_rd_off(D0, 1, 1)>(vb);
    f.l2 = tr_read<v_rd_off(D0, 2, 0)>(vb); f.h2 = tr_read<v_rd_off(D0, 2, 1)>(vb); f.l3 = tr_read<v_rd_off(D0, 3, 0)>(vb); f.h3 = tr_read<v_rd_off(D0, 3, 1)>(vb);
}
__device__ __forceinline__ void pv_mm(f32x16& od, const VFrag& f, bf16x8 pa0, bf16x8 pa1, bf16x8 pa2, bf16x8 pa3) {
#define ATT_PK(L, H) (bf16x8){L[0], L[1], L[2], L[3], H[0], H[1], H[2], H[3]}
    od = __builtin_amdgcn_mfma_f32_32x32x16_bf16(pa0, ATT_PK(f.l0, f.h0), od, 0, 0, 0);
    od = __builtin_amdgcn_mfma_f32_32x32x16_bf16(pa1, ATT_PK(f.l1, f.h1), od, 0, 0, 0);
    od = __builtin_amdgcn_mfma_f32_32x32x16_bf16(pa2, ATT_PK(f.l2, f.h2), od, 0, 0, 0);
    od = __builtin_amdgcn_mfma_f32_32x32x16_bf16(pa3, ATT_PK(f.l3, f.h3), od, 0, 0, 0);
#undef ATT_PK
}
__device__ __forceinline__ void pv_d0(f32x16* o, int vb, bf16x8 pa0, bf16x8 pa1, bf16x8 pa2, bf16x8 pa3) {
    VFrag A, B;
    v_rd<0>(A, vb);
    v_rd<1>(B, vb); asm volatile("s_waitcnt lgkmcnt(8)" ::: "memory"); ATT_SBAR(); pv_mm(o[0], A, pa0, pa1, pa2, pa3); ATT_SBAR();
    v_rd<2>(A, vb); asm volatile("s_waitcnt lgkmcnt(8)" ::: "memory"); ATT_SBAR(); pv_mm(o[1], B, pa0, pa1, pa2, pa3); ATT_SBAR();
    v_rd<3>(B, vb); asm volatile("s_waitcnt lgkmcnt(8)" ::: "memory"); ATT_SBAR(); pv_mm(o[2], A, pa0, pa1, pa2, pa3); ATT_SBAR();
    asm volatile("s_waitcnt lgkmcnt(0)" ::: "memory"); ATT_SBAR(); pv_mm(o[3], B, pa0, pa1, pa2, pa3);
}

template <int DQK, int SDEPTH>
__device__ __forceinline__ void attn_core(const bf16_t* __restrict__ Qb, int ldq, const bf16_t* __restrict__ Kh, int ldk, const bf16_t* __restrict__ Vh, int ldv, int seq, char* lds, f32x16 (&o)[4], const int tid, const bf16_t* __restrict__ Kpe = nullptr) {
    constexpr int NP = DQK / 64, CPR = DQK / 8;
    constexpr size_t SHM_K = shm_k<DQK>();
    const int wid = tid >> 6, lane = tid & 63, r32 = lane & 31, hi = lane >> 5;
    char* V_lds = lds; char* K_lds = lds + 2 * SHM_V;
    float* ws = (float*)(lds + 2 * SHM_V + 2 * SHM_K) + wid * 64; float* li_l = ws; float* al_l = ws + 32;
    if (__builtin_amdgcn_readfirstlane(wid) >= 4) __builtin_amdgcn_s_setprio(1);
    float m_reg, l_reg = 0; asm volatile("v_mov_b32 %0, 0xf149f2ca" : "=v"(m_reg));
#pragma unroll
    for (int d = 0; d < 4; ++d) o[d] = f32x16{};
    constexpr int NQR = (DQK == 192) ? 8 : DQK / 16;
    bf16x8 qr[NQR]; unsigned qlds[4] = {0u, 0u, 0u, 0u};
    const bf16_t* Qw = Qb + (long)(wid * QBLK + r32) * ldq + hi * 8;
#pragma unroll
    for (int d0 = 0; d0 < NQR; ++d0) qr[d0] = *reinterpret_cast<const bf16x8*>(Qw + d0 * 16);
    if constexpr (NQR < DQK / 16) {
        const unsigned qbase = (unsigned)(uintptr_t)(lds + 2 * SHM_V + 2 * SHM_K + NW * 64 * 4) + (unsigned)(wid * 4096 + r32 * 128);
#pragma unroll
        for (int j = 0; j < 4; ++j) { qlds[j] = qbase + (unsigned)(((2 * j + hi) ^ ((r32 >> 1) & 7)) << 4);
            *(ATT_LAS bf16x8*)(uintptr_t)qlds[j] = *reinterpret_cast<const bf16x8*>(Qw + (NQR + j) * 16); }
    }
    const int sr = tid >> 4, sc = (tid & 15) * 8, vst0 = v_st(sr, sc), vst1 = v_st(32 + sr, sc);
    int krow[NP], kch[NP];
#pragma unroll
    for (int i = 0; i < NP; ++i) {
        if constexpr (DQK == 192) { if (i < 2) { const int p = tid + i * 512; krow[i] = p >> 4; kch[i] = p & 15; } else { krow[i] = tid >> 3; kch[i] = 16 + (tid & 7); } }
        else { const int p = tid + i * 512; krow[i] = p / CPR; kch[i] = p % CPR; } }
    const int vb0 = (int)(uintptr_t)V_lds + v_rd_base(lane);
    unsigned kb[4];
#pragma unroll
    for (int t = 0; t < 4; ++t) kb[t] = (unsigned)(uintptr_t)K_lds + (unsigned)kswz<DQK>(r32, 2 * t + hi);
    struct { bf16x8 vs0, vs1; bf16x8 ks[NP]; } sr_[SDEPTH];
    const unsigned vgo0 = (unsigned)(sr * ldv + sc) * 2u, vgo1 = (unsigned)((32 + sr) * ldv + sc) * 2u; unsigned kgo[NP];
#pragma unroll
    for (int i = 0; i < NP; ++i) kgo[i] = (DQK == 192 && i == 2) ? (unsigned)(krow[i] * 64 + (kch[i] - 16) * 8) * 2u : (unsigned)(krow[i] * ldk + kch[i] * 8) * 2u;
#define ATT_RSRC(P) __builtin_amdgcn_make_buffer_rsrc((void*)(uintptr_t)(((unsigned long long)(unsigned)__builtin_amdgcn_readfirstlane((unsigned)((unsigned long long)(uintptr_t)(P) >> 32)) << 32) | (unsigned long long)(unsigned)__builtin_amdgcn_readfirstlane((unsigned)(unsigned long long)(uintptr_t)(P))), 0, 0x7fffffff, 0x00027000)
    const __amdgpu_buffer_rsrc_t rK = ATT_RSRC(Kh), rV = ATT_RSRC(Vh), rP = ATT_RSRC(DQK == 192 ? Kpe : Kh);
#define ATT_BL(R, VO, SO_) __builtin_bit_cast(bf16x8, __builtin_amdgcn_raw_buffer_load_b128(R, VO, SO_, 0))
#define ATT_SLOAD(i, k0) do { const int vso_ = (k0) * ldv * 2, kso_ = (k0) * ldk * 2; sr_[i].vs0 = ATT_BL(rV, vgo0, vso_); sr_[i].vs1 = ATT_BL(rV, vgo1, vso_); \
    _Pragma("unroll") for (int _p = 0; _p < NP; ++_p) { if (DQK == 192 && _p == 2) sr_[i].ks[_p] = ATT_BL(rP, kgo[_p], (k0) * 128); else sr_[i].ks[_p] = ATT_BL(rK, kgo[_p], kso_); } } while (0)
#define ATT_SWRITE(b, i) do { *(bf16x8*)(V_lds + (b) * SHM_V + vst0) = sr_[i].vs0; *(bf16x8*)(V_lds + (b) * SHM_V + vst1) = sr_[i].vs1; \
    _Pragma("unroll") for (int _p = 0; _p < NP; ++_p) *(bf16x8*)(K_lds + (b) * SHM_K + kswz<DQK>(krow[_p], kch[_p])) = sr_[i].ks[_p]; } while (0)
#define ATT_SWAIT() do { if constexpr (SDEPTH == 2) asm volatile("s_waitcnt vmcnt(%0)" :: "n"(2 + NP) : "memory"); else asm volatile("s_waitcnt vmcnt(0)" ::: "memory"); } while (0)
#define ATT_RESC(a) do { if (__any((a) < 1.f)) { if (hi == 0) al_l[r32] = (a); asm volatile("s_waitcnt lgkmcnt(0)" ::: "memory"); \
    _Pragma("unroll") for (int d = 0; d < 4; ++d) _Pragma("unroll") for (int r = 0; r < 16; ++r) o[d][r] *= al_l[crow(r, hi)]; } } while (0)
    f32x16 pA0, pA1, pB0, pB1; float mnA, mnB, alA, alB; bf16x8 pa0, pa1, pa2, pa3; const int NT = seq / KVBLK;
    constexpr int SE = 0, SO = SDEPTH - 1;
    ATT_SLOAD(SE, 0); asm volatile("s_waitcnt vmcnt(0)" ::: "memory"); ATT_SWRITE(0, SE); __syncthreads();
    qkt<DQK, NQR>(pA0, pA1, kb, 0, qr, qlds); partialSM(pA0, pA1, m_reg, mnA, alA);
    ATT_SLOAD(SO, KVBLK); if constexpr (SDEPTH == 2) { if (2 < NT) ATT_SLOAD(SE, 2 * KVBLK); }
    ATT_SWAIT(); ATT_SWRITE(1, SO); __syncthreads();
    for (int j = 1; j + 1 < NT; j += 2) {
        ATT_SBAR(); qkt<DQK, NQR>(pB0, pB1, kb, (int)SHM_K, qr, qlds);
        finishSM(pA0, pA1, alA, l_reg, pa0, pa1, pa2, pa3); ATT_SBAR();
        ATT_SLOAD(SO, (j + SDEPTH) * KVBLK); ATT_SBAR();
        pv_d0(o, vb0, pa0, pa1, pa2, pa3); partialSM(pB0, pB1, m_reg, mnB, alB);
        __syncthreads(); ATT_SWAIT(); ATT_SWRITE(0, SE);
        ATT_RESC(alB); __syncthreads();
        ATT_SBAR(); qkt<DQK, NQR>(pA0, pA1, kb, 0, qr, qlds);
        finishSM(pB0, pB1, alB, l_reg, pa0, pa1, pa2, pa3); ATT_SBAR();
        if (SDEPTH == 1 || j + 3 < NT) ATT_SLOAD(SE, (j + 1 + SDEPTH) * KVBLK); ATT_SBAR();
        pv_d0(o, vb0 + (int)SHM_V, pa0, pa1, pa2, pa3); partialSM(pA0, pA1, m_reg, mnA, alA);
        __syncthreads(); ATT_SWAIT(); ATT_SWRITE(1, SO);
        ATT_RESC(alA); __syncthreads();
    }
    ATT_SBAR(); qkt<DQK, NQR>(pB0, pB1, kb, (int)SHM_K, qr, qlds);
    finishSM(pA0, pA1, alA, l_reg, pa0, pa1, pa2, pa3); ATT_SBAR();
    pv_d0(o, vb0, pa0, pa1, pa2, pa3); partialSM(pB0, pB1, m_reg, mnB, alB);
    __syncthreads(); ATT_RESC(alB);
    finishSM(pB0, pB1, alB, l_reg, pa0, pa1, pa2, pa3); ATT_SBAR();
    pv_d0(o, vb0 + (int)SHM_V, pa0, pa1, pa2, pa3);
    if (hi == 0) li_l[r32] = l_reg; asm volatile("s_waitcnt lgkmcnt(0)" ::: "memory");
#pragma unroll
    for (int r = 0; r < 16; ++r) { const float rl = __builtin_amdgcn_rcpf(li_l[crow(r, hi)]);
#pragma unroll
        for (int d0 = 0; d0 < 4; ++d0) o[d0][r] *= rl; }
    __builtin_amdgcn_s_setprio(0);
    __syncthreads();
#undef ATT_SLOAD
#undef ATT_BL
#undef ATT_RSRC
#undef ATT_SWRITE
#undef ATT_SWAIT
#undef ATT_RESC
}
using i32x4a = __attribute__((ext_vector_type(4))) int;
using i32x8a = __attribute__((ext_vector_type(8))) int;
constexpr int MLA8_SHM_K = KVBLK * 256;
template <int NS> __device__ __forceinline__ void qkt8(f32x16& p0, f32x16& p1, const unsigned (&ka)[NS][2], const int bufoff, const i32x8a (&qf)[NS], const int sca, const int scb) {
    p0 = f32x16{}; p1 = f32x16{};
#pragma unroll
    for (int s = 0; s < NS; ++s) {
        const i32x4a a00 = *(const ATT_LAS i32x4a*)(uintptr_t)(ka[s][0] + (unsigned)bufoff), a01 = *(const ATT_LAS i32x4a*)(uintptr_t)(ka[s][1] + (unsigned)bufoff);
        const i32x4a a10 = *(const ATT_LAS i32x4a*)(uintptr_t)(ka[s][0] + (unsigned)(bufoff + 32 * 256)), a11 = *(const ATT_LAS i32x4a*)(uintptr_t)(ka[s][1] + (unsigned)(bufoff + 32 * 256));
        const i32x8a a0 = {a00[0], a00[1], a00[2], a00[3], a01[0], a01[1], a01[2], a01[3]}, a1 = {a10[0], a10[1], a10[2], a10[3], a11[0], a11[1], a11[2], a11[3]};
        p0 = __builtin_amdgcn_mfma_scale_f32_32x32x64_f8f6f4(a0, qf[s], p0, 0, 0, 0, sca, 0, scb);
        p1 = __builtin_amdgcn_mfma_scale_f32_32x32x64_f8f6f4(a1, qf[s], p1, 0, 0, 0, sca, 0, scb); }
}
__device__ __forceinline__ void attn_core_mla8(const unsigned char* __restrict__ Qb8, const unsigned char* __restrict__ Kn8, const unsigned char* __restrict__ Kpe8, const bf16_t* __restrict__ Vh, int ldv, int seq, char* lds, f32x16 (&o)[4], const int tid, const int sca, const int scb) {
    constexpr size_t SHM_K = MLA8_SHM_K;
    const int wid = tid >> 6, lane = tid & 63, r32 = lane & 31, hi = lane >> 5;
    char* V_lds = lds; char* K_lds = lds + 2 * SHM_V;
    float* ws = (float*)(lds + 2 * SHM_V + 2 * SHM_K) + wid * 64; float* li_l = ws; float* al_l = ws + 32;
    float m_reg, l_reg = 0; asm volatile("v_mov_b32 %0, 0xf149f2ca" : "=v"(m_reg));
#pragma unroll
    for (int d = 0; d < 4; ++d) o[d] = f32x16{};
    i32x8a qf[3];
    { const unsigned char* Qw = Qb8 + (long)(wid * QBLK + r32) * 1536 + hi * 32;
#pragma unroll
      for (int s_ = 0; s_ < 3; ++s_) { const i32x4a q0 = *reinterpret_cast<const i32x4a*>(Qw + 64 * s_), q1 = *reinterpret_cast<const i32x4a*>(Qw + 64 * s_ + 16); qf[s_] = (i32x8a){q0[0], q0[1], q0[2], q0[3], q1[0], q1[1], q1[2], q1[3]}; } }
    const int sr = tid >> 4, sc = (tid & 15) * 8, vst0 = v_st(sr, sc), vst1 = v_st(32 + sr, sc);
    const int kr0 = tid >> 3, kc0 = tid & 7, kr1 = (tid & 255) >> 2, kc1 = 8 + (tid & 3);
    const unsigned kw0 = (unsigned)(kr0 * 256 + ((kc0 ^ (kr0 & 15)) << 4)), kw1 = (unsigned)(kr1 * 256 + ((kc1 ^ (kr1 & 15)) << 4));
    const int vb0 = (int)(uintptr_t)V_lds + v_rd_base(lane);
    unsigned ka[3][2];
#pragma unroll
    for (int s_ = 0; s_ < 3; ++s_)
#pragma unroll
        for (int c = 0; c < 2; ++c) ka[s_][c] = (unsigned)(uintptr_t)K_lds + (unsigned)(r32 * 256 + (((4 * s_ + 2 * hi + c) ^ (r32 & 15)) << 4));
    const unsigned vgo0 = (unsigned)(sr * ldv + sc) * 2u, vgo1 = (unsigned)((32 + sr) * ldv + sc) * 2u, kgo0 = (unsigned)(kr0 * 1024 + kc0 * 16), kgo1 = (unsigned)(kr1 * 64 + (kc1 - 8) * 16);
#define ATT_RSRC(P) __builtin_amdgcn_make_buffer_rsrc((void*)(uintptr_t)(((unsigned long long)(unsigned)__builtin_amdgcn_readfirstlane((unsigned)((unsigned long long)(uintptr_t)(P) >> 32)) << 32) | (unsigned long long)(unsigned)__builtin_amdgcn_readfirstlane((unsigned)(unsigned long long)(uintptr_t)(P))), 0, 0x7fffffff, 0x00027000)
    const __amdgpu_buffer_rsrc_t rK = ATT_RSRC(Kn8), rV = ATT_RSRC(Vh), rP = ATT_RSRC(Kpe8);
    struct { bf16x8 vs0, vs1; u32x4 k0, k1; } sr_;
#define M8_SLOAD(kk) do { sr_.vs0 = __builtin_bit_cast(bf16x8, __builtin_amdgcn_raw_buffer_load_b128(rV, vgo0, (kk) * ldv * 2, 0)); sr_.vs1 = __builtin_bit_cast(bf16x8, __builtin_amdgcn_raw_buffer_load_b128(rV, vgo1, (kk) * ldv * 2, 0)); \
    sr_.k0 = __builtin_bit_cast(u32x4, __builtin_amdgcn_raw_buffer_load_b128(rK, kgo0, (kk) * 1024, 0)); sr_.k1 = __builtin_bit_cast(u32x4, __builtin_amdgcn_raw_buffer_load_b128(rP, kgo1, (kk) * 64, 0)); } while (0)
#define M8_SWRITE(b) do { *(bf16x8*)(V_lds + (b) * SHM_V + vst0) = sr_.vs0; *(bf16x8*)(V_lds + (b) * SHM_V + vst1) = sr_.vs1; \
    *(u32x4*)(K_lds + (b) * SHM_K + kw0) = sr_.k0; *(u32x4*)(K_lds + (b) * SHM_K + kw1) = sr_.k1; } while (0)
#define M8_SWAIT() asm volatile("s_waitcnt vmcnt(0)" ::: "memory")
#define M8_RESC(a) do { if (__any((a) < 1.f)) { if (hi == 0) al_l[r32] = (a); asm volatile("s_waitcnt lgkmcnt(0)" ::: "memory"); \
    _Pragma("unroll") for (int d = 0; d < 4; ++d) _Pragma("unroll") for (int r = 0; r < 16; ++r) o[d][r] *= al_l[crow(r, hi)]; } } while (0)
    f32x16 pA0, pA1, pB0, pB1; float mnA, mnB, alA, alB; bf16x8 pa0, pa1, pa2, pa3; const int NT = seq / KVBLK;
    M8_SLOAD(0); asm volatile("s_waitcnt vmcnt(0)" ::: "memory"); M8_SWRITE(0); __syncthreads();
    qkt8<3>(pA0, pA1, ka, 0, qf, sca, scb); partialSM(pA0, pA1, m_reg, mnA, alA);
    M8_SLOAD(KVBLK);
    M8_SWAIT(); M8_SWRITE(1); __syncthreads();
    for (int j = 1; j + 1 < NT; j += 2) {
        ATT_SBAR(); qkt8<3>(pB0, pB1, ka, (int)SHM_K, qf, sca, scb);
        finishSM(pA0, pA1, alA, l_reg, pa0, pa1, pa2, pa3); ATT_SBAR();
        M8_SLOAD((j + 1) * KVBLK); ATT_SBAR();
        pv_d0(o, vb0, pa0, pa1, pa2, pa3); partialSM(pB0, pB1, m_reg, mnB, alB);
        __syncthreads(); M8_SWAIT(); M8_SWRITE(0);
        M8_RESC(alB); __syncthreads();
        ATT_SBAR(); qkt8<3>(pA0, pA1, ka, 0, qf, sca, scb);
        finishSM(pB0, pB1, alB, l_reg, pa0, pa1, pa2, pa3); ATT_SBAR();
        M8_SLOAD((j + 2) * KVBLK); ATT_SBAR();
        pv_d0(o, vb0 + (int)SHM_V, pa0, pa1, pa2, pa3); partialSM(pA0, pA1, m_reg, mnA, alA);
        __syncthreads(); M8_SWAIT(); M8_SWRITE(1);
        M8_RESC(alA); __syncthreads();
    }
    ATT_SBAR(); qkt8<3>(pB0, pB1, ka, (int)SHM_K, qf, sca, scb);
    finishSM(pA0, pA1, alA, l_reg, pa0, pa1, pa2, pa3); ATT_SBAR();
    pv_d0(o, vb0, pa0, pa1, pa2, pa3); partialSM(pB0, pB1, m_reg, mnB, alB);
    __syncthreads(); M8_RESC(alB);
    finishSM(pB0, pB1, alB, l_reg, pa0, pa1, pa2, pa3); ATT_SBAR();
    pv_d0(o, vb0 + (int)SHM_V, pa0, pa1, pa2, pa3);
    if (hi == 0) li_l[r32] = l_reg; asm volatile("s_waitcnt lgkmcnt(0)" ::: "memory");
#pragma unroll
    for (int r = 0; r < 16; ++r) { const float rl = __builtin_amdgcn_rcpf(li_l[crow(r, hi)]);
#pragma unroll
        for (int d0 = 0; d0 < 4; ++d0) o[d0][r] *= rl; }
    __syncthreads();
#undef ATT_RSRC
#undef M8_SLOAD
#undef M8_SWRITE
#undef M8_SWAIT
#undef M8_RESC
}
using u32x2a = __attribute__((ext_vector_type(2))) unsigned;
constexpr int MLA8_SHM_V = KVBLK * 128;
constexpr float THR8 = 2.f;
template <int OFF> __device__ __forceinline__ u32x2a tr8_read(int va) { u32x2a r; asm volatile("ds_read_b64_tr_b8 %0, %1 offset:%2" : "=&v"(r) : "v"(va), "i"(OFF) : "memory"); return r; }
__device__ __forceinline__ unsigned pk4f8(float a, float b, float c, float d) { int w = __builtin_amdgcn_cvt_pk_fp8_f32(a, b, 0, false); w = __builtin_amdgcn_cvt_pk_fp8_f32(c, d, w, true); return (unsigned)w; }
__device__ __forceinline__ void partialSM8(f32x16& p0, f32x16& p1, float& m_reg, float& mn6, float& alpha) {
    float pmax = p0[0];
#pragma unroll
    for (int r = 1; r < 16; ++r) pmax = fmaxf(pmax, p0[r]);
#pragma unroll
    for (int r = 0; r < 16; ++r) pmax = fmaxf(pmax, p1[r]);
    { auto rr = __builtin_amdgcn_permlane32_swap(__float_as_uint(pmax), __float_as_uint(pmax), false, false);
      pmax = fmaxf(__uint_as_float(rr[0]), __uint_as_float(rr[1])); }
    float mn;
    if (__builtin_expect(__all(pmax - m_reg <= THR8), 1)) { mn = m_reg; alpha = 1.f; }
    else { mn = fmaxf(m_reg, pmax); alpha = __builtin_amdgcn_exp2f(m_reg - mn); m_reg = mn; }
    mn6 = mn - 6.f;
#pragma unroll
    for (int r = 0; r < 16; ++r) p0[r] = p0[r] - mn6;
#pragma unroll
    for (int r = 0; r < 16; ++r) p1[r] = p1[r] - mn6;
#pragma unroll
    for (int r = 0; r < 16; ++r) p0[r] = __builtin_amdgcn_exp2f(p0[r]);
}
__device__ __forceinline__ void finishSM8(f32x16& p0, f32x16& p1, float alpha, float& l_reg, i32x8a& pb) {
#pragma unroll
    for (int r = 0; r < 16; ++r) p1[r] = __builtin_amdgcn_exp2f(p1[r]);
    float ps = 0;
#pragma unroll
    for (int r = 0; r < 16; ++r) ps += p0[r];
#pragma unroll
    for (int r = 0; r < 16; ++r) ps += p1[r];
    { auto rr = __builtin_amdgcn_permlane32_swap(__float_as_uint(ps), __float_as_uint(ps), false, false);
      ps = __uint_as_float(rr[0]) + __uint_as_float(rr[1]); }
    l_reg = l_reg * alpha + ps;
#pragma unroll
    for (int w = 0; w < 4; ++w) { pb[w] = (int)pk4f8(p0[4 * w], p0[4 * w + 1], p0[4 * w + 2], p0[4 * w + 3]); pb[4 + w] = (int)pk4f8(p1[4 * w], p1[4 * w + 1], p1[4 * w + 2], p1[4 * w + 3]); }
}
template <int B> __device__ __forceinline__ void pv8(f32x16 (&o)[4], const int (&va)[4], const i32x8a pb, const int scv, const int scp) {
    u32x2a t[4][4];
#pragma unroll
    for (int d0 = 0; d0 < 4; ++d0) { t[d0][0] = tr8_read<B * MLA8_SHM_V + 0>(va[d0]); t[d0][1] = tr8_read<B * MLA8_SHM_V + 2048>(va[d0]); t[d0][2] = tr8_read<B * MLA8_SHM_V + 4096>(va[d0]); t[d0][3] = tr8_read<B * MLA8_SHM_V + 6144>(va[d0]); }
#define PV8_MM(D0) do { const i32x8a a_ = {(int)t[D0][0].x, (int)t[D0][0].y, (int)t[D0][1].x, (int)t[D0][1].y, (int)t[D0][2].x, (int)t[D0][2].y, (int)t[D0][3].x, (int)t[D0][3].y}; \
    o[D0] = __builtin_amdgcn_mfma_scale_f32_32x32x64_f8f6f4(a_, pb, o[D0], 0, 0, 0, scv, 0, scp); } while (0)
    asm volatile("s_waitcnt lgkmcnt(12)" ::: "memory"); ATT_SBAR(); PV8_MM(0); ATT_SBAR();
    asm volatile("s_waitcnt lgkmcnt(8)" ::: "memory"); ATT_SBAR(); PV8_MM(1); ATT_SBAR();
    asm volatile("s_waitcnt lgkmcnt(4)" ::: "memory"); ATT_SBAR(); PV8_MM(2); ATT_SBAR();
    asm volatile("s_waitcnt lgkmcnt(0)" ::: "memory"); ATT_SBAR(); PV8_MM(3);
#undef PV8_MM
}
template <int NS, bool ROPE>
__device__ __forceinline__ void attn_core_f8(const unsigned char* __restrict__ Qb8, const int ldq, const unsigned char* __restrict__ Kn8, const int ldk, const unsigned char* __restrict__ Kpe8, const unsigned char* __restrict__ Vh8, const int ldv, int seq, char* lds, f32x16 (&o)[4], const int tid, const int sca, const int scb, const int scv, const int scp) {
    constexpr size_t SHM_K = MLA8_SHM_K, SHM_V8 = MLA8_SHM_V;
    const int wid = tid >> 6, lane = tid & 63, r32 = lane & 31, hi = lane >> 5;
    if (__builtin_amdgcn_readfirstlane(wid) >= 4) __builtin_amdgcn_s_setprio(1);
    char* V_lds = lds; char* K_lds = lds + 2 * SHM_V8;
    float m_reg, l_reg = 0; asm volatile("v_mov_b32 %0, 0xf149f2ca" : "=v"(m_reg));
#pragma unroll
    for (int d = 0; d < 4; ++d) o[d] = f32x16{};
    i32x8a qf[NS];
    { const unsigned char* Qw = Qb8 + (long)(wid * QBLK + r32) * ldq + hi * 32;
#pragma unroll
      for (int s_ = 0; s_ < NS; ++s_) { const i32x4a q0 = *reinterpret_cast<const i32x4a*>(Qw + 64 * s_), q1 = *reinterpret_cast<const i32x4a*>(Qw + 64 * s_ + 16); qf[s_] = (i32x8a){q0[0], q0[1], q0[2], q0[3], q1[0], q1[1], q1[2], q1[3]}; } }
    const int vk = tid >> 3, vc = tid & 7;
    const unsigned vw = (unsigned)(vk * 128 + ((vc ^ ((((vk >> 1) & 1) << 1) | (((vk >> 3) & 1) << 2))) << 4));
    const int kr0 = tid >> 3, kc0 = tid & 7, kr1 = (tid & 255) >> 2, kc1 = 8 + (tid & 3);
    const unsigned kw0 = (unsigned)(kr0 * 256 + ((kc0 ^ (kr0 & 15)) << 4)), kw1 = (unsigned)(kr1 * 256 + ((kc1 ^ (kr1 & 15)) << 4));
    int va[4];
    { const int li = lane & 15, r = li >> 1, c = li & 1, gi = (lane >> 4) & 1, kl = 8 * (r >> 2) + 4 * hi + (r & 3), g = (((kl >> 1) & 1) << 1) | (((kl >> 3) & 1) << 2);
#pragma unroll
      for (int d0 = 0; d0 < 4; ++d0) va[d0] = (int)(uintptr_t)V_lds + kl * 128 + (((2 * d0 + gi) ^ g) << 4) + 8 * c; }
    unsigned ka[NS][2];
#pragma unroll
    for (int s_ = 0; s_ < NS; ++s_)
#pragma unroll
        for (int c = 0; c < 2; ++c) ka[s_][c] = (unsigned)(uintptr_t)K_lds + (unsigned)(r32 * 256 + (((4 * s_ + 2 * hi + c) ^ (r32 & 15)) << 4));
    const unsigned vgo = (unsigned)(vk * ldv + vc * 16), kgo0 = (unsigned)(kr0 * ldk + kc0 * 16), kgo1 = (unsigned)(kr1 * 64 + (kc1 - 8) * 16);
#define ATT_RSRC(P) __builtin_amdgcn_make_buffer_rsrc((void*)(uintptr_t)(((unsigned long long)(unsigned)__builtin_amdgcn_readfirstlane((unsigned)((unsigned long long)(uintptr_t)(P) >> 32)) << 32) | (unsigned long long)(unsigned)__builtin_amdgcn_readfirstlane((unsigned)(unsigned long long)(uintptr_t)(P))), 0, 0x7fffffff, 0x00027000)
    const __amdgpu_buffer_rsrc_t rK = ATT_RSRC(Kn8), rV = ATT_RSRC(Vh8), rP = ATT_RSRC(ROPE ? Kpe8 : Kn8);
    struct { u32x4 v, k0, k1; } sr_;
#define M8_SLOAD(kk) do { sr_.v = __builtin_bit_cast(u32x4, __builtin_amdgcn_raw_buffer_load_b128(rV, vgo, (kk) * ldv, 0)); \
    sr_.k0 = __builtin_bit_cast(u32x4, __builtin_amdgcn_raw_buffer_load_b128(rK, kgo0, (kk) * ldk, 0)); if constexpr (ROPE) sr_.k1 = __builtin_bit_cast(u32x4, __builtin_amdgcn_raw_buffer_load_b128(rP, kgo1, (kk) * 64, 0)); } while (0)
#define M8_SWRITE(b) do { *(u32x4*)(V_lds + (b) * SHM_V8 + vw) = sr_.v; *(u32x4*)(K_lds + (b) * SHM_K + kw0) = sr_.k0; if constexpr (ROPE) *(u32x4*)(K_lds + (b) * SHM_K + kw1) = sr_.k1; } while (0)
#define M8_SWAIT() asm volatile("s_waitcnt vmcnt(0)" ::: "memory")
#define M8_RESC(a) do { if (__any((a) < 1.f)) { _Pragma("unroll") for (int d = 0; d < 4; ++d) _Pragma("unroll") for (int r = 0; r < 16; ++r) o[d][r] *= (a); } } while (0)
    f32x16 pA0, pA1, pB0, pB1; float mnA, mnB, alA, alB; i32x8a pb; const int NT = seq / KVBLK;
    M8_SLOAD(0); asm volatile("s_waitcnt vmcnt(0)" ::: "memory"); M8_SWRITE(0); __syncthreads();
    qkt8<NS>(pA0, pA1, ka, 0, qf, sca, scb); partialSM8(pA0, pA1, m_reg, mnA, alA);
    M8_SLOAD(KVBLK);
    M8_SWAIT(); M8_SWRITE(1); __syncthreads();
    for (int j = 1; j + 1 < NT; j += 2) {
        ATT_SBAR(); qkt8<NS>(pB0, pB1, ka, (int)SHM_K, qf, sca, scb);
        finishSM8(pA0, pA1, alA, l_reg, pb); ATT_SBAR();
        M8_SLOAD((j + 1) * KVBLK); ATT_SBAR();
        pv8<0>(o, va, pb, scv, scp); partialSM8(pB0, pB1, m_reg, mnB, alB);
        __syncthreads(); M8_SWAIT(); M8_SWRITE(0);
        M8_RESC(alB); __syncthreads();
        ATT_SBAR(); qkt8<NS>(pA0, pA1, ka, 0, qf, sca, scb);
        finishSM8(pB0, pB1, alB, l_reg, pb); ATT_SBAR();
        M8_SLOAD((j + 2) * KVBLK); ATT_SBAR();
        pv8<1>(o, va, pb, scv, scp); partialSM8(pA0, pA1, m_reg, mnA, alA);
        __syncthreads(); M8_SWAIT(); M8_SWRITE(1);
        M8_RESC(alA); __syncthreads();
    }
    ATT_SBAR(); qkt8<NS>(pB0, pB1, ka, (int)SHM_K, qf, sca, scb);
    finishSM8(pA0, pA1, alA, l_reg, pb); ATT_SBAR();
    pv8<0>(o, va, pb, scv, scp); partialSM8(pB0, pB1, m_reg, mnB, alB);
    __syncthreads(); M8_RESC(alB);
    finishSM8(pB0, pB1, alB, l_reg, pb); ATT_SBAR();
    pv8<1>(o, va, pb, scv, scp);
    { const float rl = 64.f * __builtin_amdgcn_rcpf(l_reg);
#pragma unroll
      for (int d0 = 0; d0 < 4; ++d0)
#pragma unroll
          for (int r = 0; r < 16; ++r) o[d0][r] *= rl; }
    __builtin_amdgcn_s_setprio(0);
    __syncthreads();
#undef ATT_RSRC
#undef M8_SLOAD
#undef M8_SWRITE
#undef M8_SWAIT
#undef M8_RESC
}
}
namespace mk {
using pg8::f32x4; using pg8::u32x4; using pg8::u32x2; using pg8::Unit; using pg8::bf16x8;
typedef unsigned short bf16;
#define GAS __attribute__((address_space(1)))
#define LAS __attribute__((address_space(3)))
typedef GAS unsigned gu32;
#define RLX_AGENT __ATOMIC_RELAXED, __HIP_MEMORY_SCOPE_AGENT
#define LDS_WAIT() asm volatile("s_waitcnt lgkmcnt(0)" ::: "memory")
#define VM_WAIT() asm volatile("s_waitcnt vmcnt(0)" ::: "memory")

constexpr int NWAVES = 8;
constexpr int NTOK = 16384, DM = 2048, SEQ = 2048, NB = 8, MEML = 256;
constexpr int NPROJ = 8192;
constexpr float LOG2E = 1.4426950408889634f;
constexpr float C2D = 0.125f * LOG2E;
constexpr float C2M = 0.07216878364870322f * LOG2E;
constexpr float C2C = 0.08838834764831845f * LOG2E;
constexpr int C_DQ = 0, C_DK = 1024, C_DV = 2048, C_CQ = 3072, C_CKV = 3584, C_KPE = 3840, C_GA = 3904, C_GB = 5952, D_IN = 8000;
constexpr int MOE_MAXT = 160;
constexpr float WIN_SCALE = 64.f, HID_SCALE = 4.f, WD_SCALE = 32.f, WGU_SCALE = 64.f;

constexpr size_t MiB = 1u << 20;
constexpr size_t WS_CTL = 0, CTL_ZERO_BYTES = 1 * MiB;
constexpr float MG_SCALE = 48.f, WOUT_SCALE = 1024.f;
constexpr float Y_SCALE = 16.f;
constexpr float MLA_QS = 32.f, MLA_KS = 8.f;
constexpr int MLA_SCB = 0x7a7a7a7a, MLA_SCA = 0x7c7c7c7c;
constexpr float MLA_VS = 8.f; constexpr int MLA_SCV = 0x7c7c7c7c, MLA_SCP = 0x79797979;
constexpr size_t WS_KPE = 120 * MiB;
constexpr size_t WS_RSTDX = 11 * MiB + 768 * 1024;
constexpr size_t WS_SS_CQ = 11 * MiB, WS_SS_CKV = 11 * MiB + 512 * 1024, WS_SS_H1 = 508 * MiB;
constexpr size_t WS_ROPE_D = 1 * MiB, WS_ROPE_M = 2 * MiB;
constexpr size_t WS_WR_T = 6 * MiB;
constexpr size_t WS_TOKES = 6 * MiB + 512 * 1024, WS_TOKW = WS_TOKES + 128 * 1024, WS_SCAL = WS_TOKW + 128 * 1024;
constexpr size_t WS_LIST = 7 * MiB, WS_LISTR = 9 * MiB;
constexpr size_t WS_WIN_T = 12 * MiB, WS_WOA_T = 44 * MiB, WS_WOB_T = 48 * MiB, WS_WOUT_T = 52 * MiB, WS_WUQ_T = 60 * MiB, WS_WUKV_T = 62 * MiB, WS_WCQ_T = 63 * MiB,
                 WS_WCKV_T = 65 * MiB, WS_WCO_T = 69 * MiB;
constexpr size_t WS_XN = 72 * MiB, WS_QM = 72 * MiB, WS_MG = 72 * MiB;
constexpr size_t WS_QD = 136 * MiB, WS_KD = 168 * MiB, WS_VD = 200 * MiB, WS_CQ = 232 * MiB, WS_CKV = 248 * MiB, WS_SGA = 256 * MiB, WS_SGB = 320 * MiB, WS_KM = 384 * MiB, WS_VM = 432 * MiB,
                 WS_OB = 464 * MiB, WS_MEMN = 496 * MiB, WS_KVC = 504 * MiB, WS_HB = 512 * MiB, WS_QC = 576 * MiB, WS_OC = 592 * MiB;
constexpr size_t WS_WGU_T = 136 * MiB, WS_WD_T = 264 * MiB, WS_HID = 72 * MiB, WS_Y = 328 * MiB, WS_H8 = 200 * MiB, WS_XN8 = 464 * MiB, WS_WIN8 = 576 * MiB, WS_WCQ8 = 592 * MiB, WS_WCKV8 = 593 * MiB, WS_MEMN8 = 596 * MiB, WS_END = 608 * MiB;
constexpr int CW_TMO = 0, CW_CODE = 1, CW_BAR = 4096, CW_CNT = 8192;

constexpr int RING_OFF = 0, RING_BYTES = 131072;
constexpr int LDSCTL_OFF = RING_BYTES, MISC_OFF = LDSCTL_OFF + 320;
constexpr int LDS_BYTES = 147456;

#define XB_TMO      128
#define XB_XCNT(j)  (256  + 64 * (j))
#define XB_XSUB(j)  (1280 + 64 * (j))
#define XB_XGEN(j)  (2304 + 64 * (j))
#define XB_TOP      3328
#define XB_TOPGEN   3392
#define XCD_BAR_WORDS 3456
#define XB_SPIN_CAP (1u << 18)
__device__ __forceinline__ unsigned xb_ld(unsigned* p)              { return __hip_atomic_load(p, __ATOMIC_RELAXED, __HIP_MEMORY_SCOPE_AGENT); }
__device__ __forceinline__ unsigned xb_add(unsigned* p, unsigned v) { return __hip_atomic_fetch_add(p, v, __ATOMIC_RELAXED, __HIP_MEMORY_SCOPE_AGENT); }
__device__ __forceinline__ unsigned xb_xcc_id() { return (unsigned)__builtin_amdgcn_s_getreg((3 << 11) | 20) & 0xFu; }
#define XB_SPIN(cond, bar) do { unsigned _sp = 0; while (cond) { __builtin_amdgcn_s_sleep(1); \
    if ((++_sp & 255u) == 0u) { if (xb_ld(&(bar)[XB_TMO])) break; if (_sp > XB_SPIN_CAP) { atomicAdd(&(bar)[XB_TMO], 1u); break; } } } } while (0)
struct XcdBarrier { unsigned* bar; unsigned x; volatile LAS unsigned* st; };
__device__ __forceinline__ XcdBarrier xcd_barrier_post(unsigned* bar, volatile LAS unsigned* st) {
    XcdBarrier b; b.bar = bar; b.x = xb_xcc_id(); b.st = st;
    if (threadIdx.x == 0) (void)xb_add(&bar[XB_XCNT(b.x)], 1u);
    return b;
}
__device__ __forceinline__ void xcd_barrier_complete(unsigned* bar, unsigned x, unsigned& nloc, unsigned& nx) {
    const unsigned G = gridDim.x * gridDim.y * gridDim.z;
    unsigned sum, cnt, mine, sp = 0u;
    for (;;) {
        sum = 0u; cnt = 0u; mine = 0u;
#pragma unroll
        for (unsigned j = 0; j < 16; ++j) { const unsigned c = xb_ld(&bar[XB_XCNT(j)]); sum += c; cnt += (c > 0u) ? 1u : 0u; mine = (j == x) ? c : mine; }
        if (sum == G) break;
        __builtin_amdgcn_s_sleep(1);
        if ((++sp & 255u) == 0u) { if (xb_ld(&bar[XB_TMO])) break; if (sp > XB_SPIN_CAP) { atomicAdd(&bar[XB_TMO], 1u); break; } }
    }
    nloc = mine > 0u ? mine : 1u; nx = cnt > 0u ? cnt : 1u;
}
__device__ __forceinline__ void xcd_barrier(const XcdBarrier& b, const int tid_) {
    asm volatile("s_waitcnt vmcnt(0)" ::: "memory");
    __syncthreads();
    if (tid_ == 0) {
        unsigned* bar = b.bar;
        __builtin_amdgcn_s_waitcnt(0);
        unsigned nloc = b.st[0], nx = b.st[1];
        if (nloc == 0u) { xcd_barrier_complete(bar, b.x, nloc, nx); b.st[0] = nloc; b.st[1] = nx; }
        const unsigned old = xb_add(&bar[XB_XSUB(b.x)], 1u);
        const unsigned gen = old / nloc;
        if (old + 1u == (gen + 1u) * nloc) {
            __builtin_amdgcn_fence(__ATOMIC_RELEASE, "agent");
            asm volatile("s_waitcnt vmcnt(0)" ::: "memory");
            const unsigned og = xb_add(&bar[XB_TOP], 1u);
            const unsigned tg = og / nx;
            if (og + 1u == (tg + 1u) * nx) xb_add(&bar[XB_TOPGEN], 1u);
            else XB_SPIN(xb_ld(&bar[XB_TOPGEN]) == tg, bar);
            __builtin_amdgcn_fence(__ATOMIC_ACQUIRE, "agent");
            xb_add(&bar[XB_XGEN(b.x)], 1u);
            asm volatile("s_waitcnt vmcnt(0)" ::: "memory");
        } else {
            XB_SPIN(xb_ld(&bar[XB_XGEN(b.x)]) == gen, bar);
            __builtin_amdgcn_fence(__ATOMIC_ACQUIRE, "agent");
            asm volatile("s_waitcnt vmcnt(0)" ::: "memory");
        }
    }
    __syncthreads();
}

struct Args {
    const float *x, *mem; const int* positions; const float *attn_norm_g, *w_in, *lq1, *lk1, *lq2, *lk2, *subln_g, *w_o_diff, *mla_q_norm_g, *w_uq, *mla_kv_norm_g, *w_ukv, *w_o_mla, *w_out,
        *cross_norm_g, *mem_norm_g, *w_cq, *w_ckv, *w_co, *ffn_norm_g, *w_rg, *b_rg, *w_re, *b_re, *w_gate, *w_up, *w_down, *final_norm_g;
    float* out; unsigned char* ws; int ph_lo, ph_hi;
};

__device__ __forceinline__ float wave_sum(float v) {
#pragma unroll
    for (int o = 1; o < 64; o <<= 1) v += __shfl_xor(v, o);
    return v;
}
__device__ __forceinline__ float sigmoidf_fast(float x) { return __builtin_amdgcn_rcpf(1.f + __builtin_amdgcn_exp2f(-x * LOG2E)); }

__device__ __forceinline__ unsigned pack4_u8(float a, float b, float c, float d) { unsigned w = 0u; w = __builtin_amdgcn_cvt_pk_u8_f32(a, 0, w); w = __builtin_amdgcn_cvt_pk_u8_f32(b, 1, w); w = __builtin_amdgcn_cvt_pk_u8_f32(c, 2, w); w = __builtin_amdgcn_cvt_pk_u8_f32(d, 3, w); return w; }
__device__ __forceinline__ unsigned pack4_i8(float a, float b, float c, float d) { return pack4_u8(a + 128.f, b + 128.f, c + 128.f, d + 128.f) ^ 0x80808080u; }
template <bool FP8 = false> __device__ __forceinline__ void transpose_item(const float* W, int ldw, int srccol, const float* gain, int k0, bf16* WT, int ldt, int row0, LAS float* scr, int lane, float wscale = 1.f) {
    float v[32];
    const float* wp = W + (size_t)(k0 + (lane >> 5)) * ldw + (srccol >= 0 ? srccol : 0);
#pragma unroll
    for (int i = 0; i < 32; ++i) v[i] = __builtin_nontemporal_load(wp + (size_t)(2 * i) * ldw);
    if (gain) {
#pragma unroll
        for (int i = 0; i < 32; ++i) v[i] *= gain[k0 + 2 * i + (lane >> 5)]; }
    if (srccol < 0) {
#pragma unroll
        for (int i = 0; i < 32; ++i) v[i] = 0.f; }
#pragma unroll
    for (int i = 0; i < 32; ++i) scr[(2 * i + (lane >> 5)) * 33 + (lane & 31)] = v[i];
    LDS_WAIT(); asm volatile("" ::: "memory");
    const int c = lane & 7;
#pragma unroll
    for (int j = 0; j < 4; ++j) { const int n = (lane >> 3) + 8 * j; const LAS float* s = scr + (8 * c) * 33 + n;
        if constexpr (FP8) { u32x2 o; o.x = pg8::pack4_fp8(s[0 * 33] * wscale, s[1 * 33] * wscale, s[2 * 33] * wscale, s[3 * 33] * wscale); o.y = pg8::pack4_fp8(s[4 * 33] * wscale, s[5 * 33] * wscale, s[6 * 33] * wscale, s[7 * 33] * wscale);
            *(GAS u32x2*)((unsigned char*)WT + (size_t)(row0 + n) * ldt + k0 + 8 * c) = o; }
        else { u32x4 o; o.x = pg8::cvt_pk_bf16(s[0 * 33], s[1 * 33]); o.y = pg8::cvt_pk_bf16(s[2 * 33], s[3 * 33]); o.z = pg8::cvt_pk_bf16(s[4 * 33], s[5 * 33]); o.w = pg8::cvt_pk_bf16(s[6 * 33], s[7 * 33]);
            *(GAS u32x4*)(WT + (size_t)(row0 + n) * ldt + k0 + 8 * c) = o; } }
    LDS_WAIT(); asm volatile("" ::: "memory");
}
struct TItem { const float* wp; const float* gain; unsigned char* dst; int ldw, k0, ldt, fp8; float wscale; bool zero; };
__device__ __forceinline__ void tr_load(const TItem& t, float (&v)[32]) {
#pragma unroll
    for (int i = 0; i < 32; ++i) v[i] = __builtin_nontemporal_load(t.wp + (size_t)(2 * i) * t.ldw);
}
__device__ __forceinline__ void tr_finish(const TItem& t, float (&v)[32], LAS float* scr, int lane) {
    if (t.gain) {
#pragma unroll
        for (int i = 0; i < 32; ++i) v[i] *= t.gain[t.k0 + 2 * i + (lane >> 5)]; }
    if (t.zero) {
#pragma unroll
        for (int i = 0; i < 32; ++i) v[i] = 0.f; }
#pragma unroll
    for (int i = 0; i < 32; ++i) scr[(2 * i + (lane >> 5)) * 33 + (lane & 31)] = v[i];
    LDS_WAIT(); asm volatile("" ::: "memory");
    const int c = lane & 7;
#pragma unroll
    for (int j = 0; j < 4; ++j) { const int n = (lane >> 3) + 8 * j; const LAS float* q = scr + (8 * c) * 33 + n;
        if (t.fp8 == 2) { u32x2 o; o.x = pack4_i8(q[0 * 33] * t.wscale, q[1 * 33] * t.wscale, q[2 * 33] * t.wscale, q[3 * 33] * t.wscale); o.y = pack4_i8(q[4 * 33] * t.wscale, q[5 * 33] * t.wscale, q[6 * 33] * t.wscale, q[7 * 33] * t.wscale);
            *(GAS u32x2*)(t.dst + (size_t)n * t.ldt + 8 * c) = o; }
        else if (t.fp8) { u32x2 o; o.x = pg8::pack4_fp8(q[0 * 33] * t.wscale, q[1 * 33] * t.wscale, q[2 * 33] * t.wscale, q[3 * 33] * t.wscale); o.y = pg8::pack4_fp8(q[4 * 33] * t.wscale, q[5 * 33] * t.wscale, q[6 * 33] * t.wscale, q[7 * 33] * t.wscale);
            *(GAS u32x2*)(t.dst + (size_t)n * t.ldt + 8 * c) = o; }
        else { u32x4 o; o.x = pg8::cvt_pk_bf16(q[0 * 33], q[1 * 33]); o.y = pg8::cvt_pk_bf16(q[2 * 33], q[3 * 33]); o.z = pg8::cvt_pk_bf16(q[4 * 33], q[5 * 33]); o.w = pg8::cvt_pk_bf16(q[6 * 33], q[7 * 33]);
            *(GAS u32x4*)(t.dst + (size_t)n * t.ldt + 16 * c) = o; } }
    LDS_WAIT(); asm volatile("" ::: "memory");
}
__device__ __forceinline__ TItem tr_make(const float* W, int ldw, int srccol, const float* gain, int k0, void* WT, int ldt_elems, int row0, int lane, int fp8, float wscale = 1.f) {
    TItem t; t.wp = W + (size_t)(k0 + (lane >> 5)) * ldw + (srccol >= 0 ? srccol : 0); t.gain = gain; t.ldw = ldw; t.k0 = k0; t.fp8 = fp8; t.wscale = wscale; t.zero = srccol < 0;
    const int eb = fp8 ? 1 : 2; t.ldt = ldt_elems * eb; t.dst = (unsigned char*)WT + ((size_t)row0 * ldt_elems + k0) * eb; return t;
}
__device__ __forceinline__ int sigma16(int s) { return 8 * ((s >> 2) & 1) + 4 * (s >> 3) + (s & 3); }
__device__ __forceinline__ int sigma64(int s) { return 32 * ((s >> 2) & 1) + 4 * (s >> 3) + (s & 3); }
__device__ __forceinline__ int win_src(int n) {
    if (n < 2048) { const int base = n < 1024 ? C_DQ : C_DK, m = n & 1023, ch = m >> 6, s = m & 63; return base + ch * 64 + (s < 16 ? sigma16(s) : s); }
    if (n < 3072) return C_DV + (n - 2048);
    if (n < 3584) return C_CQ + (n - 3072);
    if (n < 3840) return C_CKV + (n - 3584);
    if (n < 5888) return C_GA + (n - 3840);
    if (n < 7936) return C_GB + (n - 5888);
    if (n < 8000) return C_KPE + sigma64(n - 7936);
    return -1;
}
__device__ __forceinline__ int wuq_src(int n) { const int h = n / 192, off = n - h * 192; return h * 192 + (off < 128 ? off : 128 + sigma64(off - 128)); }

__device__ __forceinline__ void rms_row_to_bf16(const float* xrow, const float* g, bf16* orow, int lane, unsigned char* orow8 = nullptr, bf16* xcopy = nullptr, float* rstd_out = nullptr) {
    const GAS f32x4* xr = (const GAS f32x4*)xrow + lane; const GAS f32x4* gr = (const GAS f32x4*)g + lane;
    f32x4 v[8]; float s = 0.f;
#pragma unroll
    for (int j = 0; j < 8; ++j) { v[j] = __builtin_nontemporal_load(xr + 64 * j); s += (v[j].x * v[j].x + v[j].y * v[j].y) + (v[j].z * v[j].z + v[j].w * v[j].w); }
    const float rstd = rsqrtf(wave_sum(s) * (1.f / DM) + 1e-6f);
    GAS u32x2* o8 = (GAS u32x2*)orow + lane;
    if (rstd_out && lane == 0) *rstd_out = rstd;
    if (xcopy) { GAS u32x2* c8 = (GAS u32x2*)xcopy + lane;
#pragma unroll
        for (int j = 0; j < 8; ++j) { u32x2 w; w.x = pg8::cvt_pk_bf16(v[j].x, v[j].y); w.y = pg8::cvt_pk_bf16(v[j].z, v[j].w); c8[64 * j] = w; } }
#pragma unroll
    for (int j = 0; j < 8; ++j) { const f32x4 gg = gr[64 * j]; u32x2 w; w.x = pg8::cvt_pk_bf16(v[j].x * rstd * gg.x, v[j].y * rstd * gg.y); w.y = pg8::cvt_pk_bf16(v[j].z * rstd * gg.z, v[j].w * rstd * gg.w); if (orow) o8[64 * j] = w;
        if (orow8) ((GAS unsigned*)orow8)[lane + 64 * j] = pg8::pack4_fp8(v[j].x * rstd * gg.x, v[j].y * rstd * gg.y, v[j].z * rstd * gg.z, v[j].w * rstd * gg.w); }
}

__device__ __forceinline__ void rms_rows2_x(const float* xa, const float* xb, const float* g, unsigned char* oa8, unsigned char* ob8, bf16* ca, bf16* cb, float* ra, float* rb, int lane) {
    const GAS f32x4* pa = (const GAS f32x4*)xa + lane; const GAS f32x4* pb = (const GAS f32x4*)xb + lane; const GAS f32x4* gr = (const GAS f32x4*)g + lane;
    f32x4 va[8], vb[8]; float sa = 0.f, sb = 0.f;
#pragma unroll
    for (int j = 0; j < 8; ++j) va[j] = __builtin_nontemporal_load(pa + 64 * j);
#pragma unroll
    for (int j = 0; j < 8; ++j) vb[j] = __builtin_nontemporal_load(pb + 64 * j);
#pragma unroll
    for (int j = 0; j < 8; ++j) sa += (va[j].x * va[j].x + va[j].y * va[j].y) + (va[j].z * va[j].z + va[j].w * va[j].w);
#pragma unroll
    for (int j = 0; j < 8; ++j) sb += (vb[j].x * vb[j].x + vb[j].y * vb[j].y) + (vb[j].z * vb[j].z + vb[j].w * vb[j].w);
    const float rsa = rsqrtf(wave_sum(sa) * (1.f / DM) + 1e-6f), rsb = rsqrtf(wave_sum(sb) * (1.f / DM) + 1e-6f);
    if (lane == 0) { *ra = rsa; *rb = rsb; }
    GAS u32x2* c8a = (GAS u32x2*)ca + lane; GAS u32x2* c8b = (GAS u32x2*)cb + lane;
#pragma unroll
    for (int j = 0; j < 8; ++j) { u32x2 w; w.x = pg8::cvt_pk_bf16(va[j].x, va[j].y); w.y = pg8::cvt_pk_bf16(va[j].z, va[j].w); c8a[64 * j] = w; w.x = pg8::cvt_pk_bf16(vb[j].x, vb[j].y); w.y = pg8::cvt_pk_bf16(vb[j].z, vb[j].w); c8b[64 * j] = w; }
#pragma unroll
    for (int j = 0; j < 8; ++j) { const f32x4 gg = gr[64 * j];
        ((GAS unsigned*)oa8)[lane + 64 * j] = pg8::pack4_fp8(va[j].x * rsa * gg.x, va[j].y * rsa * gg.y, va[j].z * rsa * gg.z, va[j].w * rsa * gg.w);
        ((GAS unsigned*)ob8)[lane + 64 * j] = pg8::pack4_fp8(vb[j].x * rsb * gg.x, vb[j].y * rsb * gg.y, vb[j].z * rsb * gg.z, vb[j].w * rsb * gg.w); }
}

struct SchedTile {
    pg8::TileOrder ord; const char* Ab; const char* Bb; size_t tA, tB;
    __device__ __forceinline__ bool next(int i, Unit& u) const { u.z = 0; return ord.tile(i, u.pm, u.pn); }
    __device__ __forceinline__ const char* A(const Unit& u) const { return Ab + (size_t)u.pm * tA; }
    __device__ __forceinline__ const char* B(const Unit& u) const { return Bb + (size_t)u.pn * tB; }
};
struct SchedProj {
    pg8::TileOrder ord; const char* Ab; const char* Bb; size_t tA, tB; int fp8;
    __device__ __forceinline__ bool next(int i, Unit& u) const { int pn; if (!ord.tile(i, u.pm, pn)) return false; u.z = pn;
        u.pn = fp8 ? (pn < 16 ? 15 + pn : (pn < 19 ? pn - 4 : 31)) : pn; return true; }
    __device__ __forceinline__ const char* A(const Unit& u) const { return Ab + (size_t)u.pm * tA; }
    __device__ __forceinline__ const char* B(const Unit& u) const { return Bb + (size_t)u.z * tB; }
};
struct SchedBal {
    int G, c; const char* Ab; const char* Bb; size_t tA, tB;
    __device__ __forceinline__ bool next(int i, Unit& u) const { int L;
        if (G == 256) { if (c < 128) { if (i > 0) return false; L = c; } else { if (i > 2) return false; L = 128 + (c - 128) + 128 * i; } }
        else { L = i * G + c; if (L >= 512) return false; }
        u.pm = L >> 3; u.pn = L & 7; u.z = 0; return true; }
    __device__ __forceinline__ const char* A(const Unit& u) const { return Ab + (size_t)u.pm * tA; }
    __device__ __forceinline__ const char* B(const Unit& u) const { return Bb + (size_t)u.pn * tB; }
};
struct SchedOff {
    int nN, n, c; const char* Ab; const char* Bb; size_t tA, tB;
    __device__ __forceinline__ bool next(int i, Unit& u) const { if (i > 0 || c < 0 || c >= n) return false; u.pm = c / nN; u.pn = c % nN; u.z = 0; return true; }
    __device__ __forceinline__ const char* A(const Unit& u) const { return Ab + (size_t)u.pm * tA; }
    __device__ __forceinline__ const char* B(const Unit& u) const { return Bb + (size_t)u.pn * tB; }
};
struct SchedGate {
    pg8::TileOrder ord; const char* A0; const char* A1; const char* B0; const char* B1; size_t tA, tB;
    __device__ __forceinline__ bool next(int j, Unit& u) const { u.z = j & 1; return ord.tile(j >> 1, u.pm, u.pn); }
    __device__ __forceinline__ const char* A(const Unit& u) const { return (u.z ? A1 : A0) + (size_t)u.pm * tA; }
    __device__ __forceinline__ const char* B(const Unit& u) const { return (u.z ? B1 : B0) + (size_t)u.pn * tB; }
};
struct MoeTab { const LAS int* tpre; const LAS int* cnt; };
__device__ __forceinline__ int moe_find(const MoeTab& t, int T) { int e = 0;
#pragma unroll 1
    for (int k = 1; k < 32; ++k) if (T >= t.tpre[k]) e = k;
    return e; }
struct SchedMoe1 {
    MoeTab tab; int G, vcu; const char* Ab; const char* Bb; const int* list;
    __device__ __forceinline__ bool next(int i, Unit& u) const { const int L = i * G + vcu; if (L >= tab.tpre[32] * 4) return false; u.pm = L >> 2; u.pn = L & 3; const int e = moe_find(tab, u.pm); u.z = e | ((u.pm - tab.tpre[e]) << 8); return true; }
    __device__ __forceinline__ const char* A(const Unit&) const { return Ab; }
    __device__ __forceinline__ const char* B(const Unit& u) const { return Bb + ((size_t)(u.z & 255) * 1024 + (size_t)u.pn * 256) * 2048; }
    __device__ __forceinline__ int arow(const Unit& u, int r) const { const int e = u.z & 255, c = tab.cnt[e]; int idx = (u.z >> 8) * 256 + r; idx = idx < c ? idx : c - 1; return list[e * NTOK + idx]; }
};
struct SchedMoe2 {
    MoeTab tab; int G, vcu; const char* Ab; const char* Bb;
    __device__ __forceinline__ bool next(int i, Unit& u) const { const int L = i * G + vcu; if (L >= tab.tpre[32] * 8) return false; u.pm = L >> 3; u.pn = L & 7; u.z = moe_find(tab, u.pm); return true; }
    __device__ __forceinline__ const char* A(const Unit& u) const { return Ab + (size_t)u.pm * (256 * 512); }
    __device__ __forceinline__ const char* B(const Unit& u) const { return Bb + ((size_t)u.z * 2048 + (size_t)u.pn * 256) * 512; }
};

#define EPI_ROWS_BEGIN  _Pragma("unroll") for (int ai = 0; ai < 2; ++ai) _Pragma("unroll") for (int m = 0; m < 4; ++m) { const int row = u.pm * 256 + ai * 128 + wr * 64 + m * 16 + fr;
#define EPI_ROWS_END    }
__device__ __forceinline__ f32x4 unpack4_u8(unsigned w) { return (f32x4){(float)(w & 0xffu), (float)((w >> 8) & 0xffu), (float)((w >> 16) & 0xffu), (float)(w >> 24)}; }
__device__ __forceinline__ void st16(bf16* p, const f32x4 a, const f32x4 b) { *(GAS u32x4*)p = pg8::pack8(a, b); }

struct EpiProj {
    static constexpr bool PERM = true;
    bf16 *QD, *KD, *VD; const float* rope_d; const float* rstd;
    __device__ __forceinline__ void operator()(f32x4 (&acc)[2][2][4][2], const Unit& u, int wr, int wc, int fr, int fq) const {
        const int pn = u.pn, colw = wc * 32 + 8 * fq;
        if (pn < 8) {
            bf16* dst = pn < 4 ? QD : KD; const float sc = pn < 4 ? C2D : 1.f; const bool rot = ((wc & 1) == 0) && fq < 2;
#pragma unroll
            for (int ai = 0; ai < 2; ++ai) {
                f32x4 cs[4][2]; float rs[4];
#pragma unroll
                for (int m = 0; m < 4; ++m) rs[m] = rstd[u.pm * 256 + ai * 128 + wr * 64 + m * 16 + fr] * sc;
#pragma unroll
                for (int m = 0; m < 4; ++m) if (rot) { const int row = u.pm * 256 + ai * 128 + wr * 64 + m * 16 + fr; const GAS f32x4* t = (const GAS f32x4*)(rope_d + (size_t)row * 16 + fq * 8); cs[m][0] = t[0]; cs[m][1] = t[1]; }
#pragma unroll
                for (int m = 0; m < 4; ++m) { const int row = u.pm * 256 + ai * 128 + wr * 64 + m * 16 + fr;
#pragma unroll
                    for (int bj = 0; bj < 2; ++bj) { f32x4 v0 = acc[ai][bj][m][0], v1 = acc[ai][bj][m][1];
                        if (rot) {
#pragma unroll
                            for (int j = 0; j < 4; ++j) { const float c = cs[m][j >> 1][(j & 1) * 2], s = cs[m][j >> 1][(j & 1) * 2 + 1], x1 = v0[j], x2 = v1[j]; v0[j] = x1 * c - x2 * s; v1[j] = x2 * c + x1 * s; } }
                        st16(dst + (size_t)row * 1024 + (pn & 3) * 256 + bj * 128 + colw, v0 * rs[m], v1 * rs[m]); } }
            }
        } else if (pn < 12) {
            float rs[2][4];
#pragma unroll
            for (int ai = 0; ai < 2; ++ai)
#pragma unroll
                for (int m = 0; m < 4; ++m) rs[ai][m] = rstd[u.pm * 256 + ai * 128 + wr * 64 + m * 16 + fr];
            EPI_ROWS_BEGIN
#pragma unroll
                for (int bj = 0; bj < 2; ++bj) st16(VD + (size_t)row * 1024 + (pn - 8) * 256 + bj * 128 + colw, acc[ai][bj][m][0] * rs[ai][m], acc[ai][bj][m][1] * rs[ai][m]);
            EPI_ROWS_END
        }
    }
};
struct EpiGates {
    static constexpr bool PERM = true;
    bf16 *SGA, *SGB, *CQ, *CKV, *KM; float *ss_cq, *ss_ckv; const float* rope_m; float scale;
    __device__ __forceinline__ void operator()(f32x4 (&acc)[2][2][4][2], const Unit& u, int wr, int wc, int fr, int fq) const {
        const int pn = u.pn, colw = wc * 32 + 8 * fq;
        if (pn < 15) {
            unsigned char* dst = pn < 14 ? (unsigned char*)CQ + (pn - 12) * 256 : (unsigned char*)CKV; const int ld = pn < 14 ? 512 : 256; float* ss = pn < 14 ? ss_cq + (pn - 12) * 4 + wc : ss_ckv + wc; const int ssld = pn < 14 ? 8 : 4;
            EPI_ROWS_BEGIN
                float s = 0.f;
#pragma unroll
                for (int bj = 0; bj < 2; ++bj) { const f32x4 v0 = acc[ai][bj][m][0] * scale, v1 = acc[ai][bj][m][1] * scale;
                    s += (v0[0] * v0[0] + v0[1] * v0[1]) + (v0[2] * v0[2] + v0[3] * v0[3]) + (v1[0] * v1[0] + v1[1] * v1[1]) + (v1[2] * v1[2] + v1[3] * v1[3]);
                    u32x2 w; w.x = pg8::pack4_fp8(v0[0], v0[1], v0[2], v0[3]); w.y = pg8::pack4_fp8(v1[0], v1[1], v1[2], v1[3]);
                    *(GAS u32x2*)(dst + (size_t)row * ld + bj * 128 + colw) = w; }
                s += __shfl_xor(s, 16); s += __shfl_xor(s, 32);
                if (fq == 0) ss[(size_t)row * ssld] = s;
            EPI_ROWS_END
            return;
        }
        if (pn == 31) {
            if (wc < 2) {
                const int q = 4 * wc + fq;
#pragma unroll
                for (int ai = 0; ai < 2; ++ai) {
                    f32x4 cs[4][2];
#pragma unroll
                    for (int m = 0; m < 4; ++m) { const int row = u.pm * 256 + ai * 128 + wr * 64 + m * 16 + fr; const GAS f32x4* t = (const GAS f32x4*)(rope_m + (size_t)row * 64 + q * 8); cs[m][0] = t[0]; cs[m][1] = t[1]; }
#pragma unroll
                    for (int m = 0; m < 4; ++m) { const int row = u.pm * 256 + ai * 128 + wr * 64 + m * 16 + fr;
                        f32x4 v0 = acc[ai][0][m][0] * scale, v1 = acc[ai][0][m][1] * scale;
#pragma unroll
                        for (int j = 0; j < 4; ++j) { const float c = cs[m][j >> 1][(j & 1) * 2], s = cs[m][j >> 1][(j & 1) * 2 + 1], x1 = v0[j], x2 = v1[j]; v0[j] = x1 * c - x2 * s; v1[j] = x2 * c + x1 * s; }
                        u32x2 w; w.x = pg8::pack4_fp8(v0[0] * MLA_KS, v0[1] * MLA_KS, v0[2] * MLA_KS, v0[3] * MLA_KS); w.y = pg8::pack4_fp8(v1[0] * MLA_KS, v1[1] * MLA_KS, v1[2] * MLA_KS, v1[3] * MLA_KS);
                        *(GAS u32x2*)((unsigned char*)KM + (size_t)row * 64 + 8 * q) = w; }
                }
            }
            return;
        }
        unsigned char* dst = (unsigned char*)(pn < 23 ? SGA : SGB) + (pn < 23 ? pn - 15 : pn - 23) * 256;
        EPI_ROWS_BEGIN
#pragma unroll
            for (int bj = 0; bj < 2; ++bj) { f32x4 v0 = acc[ai][bj][m][0], v1 = acc[ai][bj][m][1];
#pragma unroll
                for (int j = 0; j < 4; ++j) { v0[j] = fmaxf(sigmoidf_fast(v0[j] * scale) * 255.f, 1.f); v1[j] = fmaxf(sigmoidf_fast(v1[j] * scale) * 255.f, 1.f); }
                u32x2 w; w.x = pack4_u8(v0[0], v0[1], v0[2], v0[3]); w.y = pack4_u8(v1[0], v1[1], v1[2], v1[3]);
                *(GAS u32x2*)(dst + (size_t)row * 2048 + bj * 128 + colw) = w; }
        EPI_ROWS_END
    }
};
struct EpiQup {
    static constexpr bool PERM = true;
    bf16* QM; const float* ss_cq; const float* rope_m;
    __device__ __forceinline__ void operator()(f32x4 (&acc)[2][2][4][2], const Unit& u, int wr, int wc, int fr, int fq) const {
        const int colw = wc * 32 + 8 * fq;
        int c0[2], hh[2], off[2];
#pragma unroll
        for (int bj = 0; bj < 2; ++bj) { c0[bj] = u.pn * 256 + bj * 128 + colw; hh[bj] = c0[bj] / 192; off[bj] = c0[bj] - hh[bj] * 192; }
#pragma unroll
        for (int ai = 0; ai < 2; ++ai)
#pragma unroll
            for (int mp = 0; mp < 2; ++mp) {
                f32x4 sa[2], sb[2], cs[2][2][2];
#pragma unroll
                for (int mm = 0; mm < 2; ++mm) { const int row = u.pm * 256 + ai * 128 + wr * 64 + (mp * 2 + mm) * 16 + fr; const GAS f32x4* sp = (const GAS f32x4*)(ss_cq + (size_t)row * 8); sa[mm] = sp[0]; sb[mm] = sp[1];
#pragma unroll
                    for (int bj = 0; bj < 2; ++bj) if (off[bj] >= 128) { const GAS f32x4* t = (const GAS f32x4*)(rope_m + (size_t)row * 64 + ((off[bj] - 128) >> 3) * 8); cs[mm][bj][0] = t[0]; cs[mm][bj][1] = t[1]; } }
#pragma unroll
                for (int mm = 0; mm < 2; ++mm) { const int m = mp * 2 + mm, row = u.pm * 256 + ai * 128 + wr * 64 + m * 16 + fr;
                    const float rs = rsqrtf((((sa[mm][0] + sa[mm][1]) + (sa[mm][2] + sa[mm][3])) + ((sb[mm][0] + sb[mm][1]) + (sb[mm][2] + sb[mm][3]))) * (1.f / 512.f) + 1e-6f) * (C2M * MLA_QS / WIN_SCALE);
#pragma unroll
                    for (int bj = 0; bj < 2; ++bj) { f32x4 v0 = acc[ai][bj][m][0] * rs, v1 = acc[ai][bj][m][1] * rs;
                        if (off[bj] >= 128) {
#pragma unroll
                            for (int j = 0; j < 4; ++j) { const float c = cs[mm][bj][j >> 1][(j & 1) * 2], s = cs[mm][bj][j >> 1][(j & 1) * 2 + 1], x1 = v0[j], x2 = v1[j]; v0[j] = x1 * c - x2 * s; v1[j] = x2 * c + x1 * s; } }
                        u32x2 w; w.x = pg8::pack4_fp8(v0[0], v0[1], v0[2], v0[3]); w.y = pg8::pack4_fp8(v1[0], v1[1], v1[2], v1[3]);
                        *(GAS u32x2*)((unsigned char*)QM + (size_t)row * 1536 + c0[bj]) = w; } }
            }
    }
};
struct EpiKVup {
    static constexpr bool PERM = true;
    bf16 *KM, *VM; const float* ss_ckv;
    __device__ __forceinline__ void operator()(f32x4 (&acc)[2][2][4][2], const Unit& u, int wr, int wc, int fr, int fq) const {
        const int colw = wc * 32 + 8 * fq, h = u.pn;
#pragma unroll
        for (int ai = 0; ai < 2; ++ai) {
            f32x4 sa[4];
#pragma unroll
            for (int m = 0; m < 4; ++m) { const int row = u.pm * 256 + ai * 128 + wr * 64 + m * 16 + fr; sa[m] = *(const GAS f32x4*)(ss_ckv + (size_t)row * 4); }
#pragma unroll
            for (int m = 0; m < 4; ++m) { const int row = u.pm * 256 + ai * 128 + wr * 64 + m * 16 + fr;
                const float rs = rsqrtf(((sa[m][0] + sa[m][1]) + (sa[m][2] + sa[m][3])) * (1.f / 256.f) + 1e-6f) * (1.f / WIN_SCALE);
                { const f32x4 k0 = acc[ai][0][m][0] * (rs * MLA_KS), k1 = acc[ai][0][m][1] * (rs * MLA_KS); u32x2 w; w.x = pg8::pack4_fp8(k0[0], k0[1], k0[2], k0[3]); w.y = pg8::pack4_fp8(k1[0], k1[1], k1[2], k1[3]);
                  *(GAS u32x2*)((unsigned char*)KM + (size_t)row * 1024 + h * 128 + colw) = w; }
                { const f32x4 v0 = acc[ai][1][m][0] * (rs * MLA_VS), v1 = acc[ai][1][m][1] * (rs * MLA_VS); u32x2 w; w.x = pg8::pack4_fp8(v0[0], v0[1], v0[2], v0[3]); w.y = pg8::pack4_fp8(v1[0], v1[1], v1[2], v1[3]);
                  *(GAS u32x2*)((unsigned char*)VM + (size_t)row * 1024 + h * 128 + colw) = w; } }
        }
    }
};
struct EpiPlain {
    static constexpr bool PERM = true;
    bf16* O; int ldc; const float* ss; float ssn_inv, scale; int f8;
    __device__ __forceinline__ void operator()(f32x4 (&acc)[2][2][4][2], const Unit& u, int wr, int wc, int fr, int fq) const {
        const int colw = wc * 32 + 8 * fq;
        float rsv[2][4];
#pragma unroll
        for (int ai = 0; ai < 2; ++ai)
#pragma unroll
            for (int m = 0; m < 4; ++m) rsv[ai][m] = scale;
        if (ss) {
#pragma unroll
            for (int ai = 0; ai < 2; ++ai)
#pragma unroll
                for (int mp = 0; mp < 2; ++mp) { f32x4 q[2][8];
#pragma unroll
                    for (int mm = 0; mm < 2; ++mm) { const int row = u.pm * 256 + ai * 128 + wr * 64 + (mp * 2 + mm) * 16 + fr; const GAS f32x4* sp = (const GAS f32x4*)(ss + (size_t)row * 32);
#pragma unroll
                        for (int i = 0; i < 8; ++i) q[mm][i] = sp[i]; }
#pragma unroll
                    for (int mm = 0; mm < 2; ++mm) { float t = 0.f;
#pragma unroll
                        for (int i = 0; i < 8; ++i) t += (q[mm][i][0] + q[mm][i][1]) + (q[mm][i][2] + q[mm][i][3]);
                        rsv[ai][mp * 2 + mm] = rsqrtf(t * ssn_inv + 1e-6f) * scale; } }
        }
        EPI_ROWS_BEGIN
            const float rs = rsv[ai][m];
#pragma unroll
            for (int bj = 0; bj < 2; ++bj) { const f32x4 v0 = acc[ai][bj][m][0] * rs, v1 = acc[ai][bj][m][1] * rs;
                u32x2 w; w.x = pg8::pack4_fp8(v0[0], v0[1], v0[2], v0[3]); w.y = pg8::pack4_fp8(v1[0], v1[1], v1[2], v1[3]); *(GAS u32x2*)((unsigned char*)O + (size_t)row * ldc + u.pn * 256 + bj * 128 + colw) = w; }
        EPI_ROWS_END
    }
};
struct EpiDown {
    static constexpr bool PERM = true;
    bf16* O; MoeTab tab; float scale;
    __device__ __forceinline__ void operator()(f32x4 (&acc)[2][2][4][2], const Unit& u, int wr, int wc, int fr, int fq) const {
        const int colw = wc * 32 + 8 * fq, nvalid = tab.cnt[u.z] - (u.pm - tab.tpre[u.z]) * 256;
        EPI_ROWS_BEGIN
            if (ai * 128 + wr * 64 + m * 16 + fr < nvalid) {
#pragma unroll
                for (int bj = 0; bj < 2; ++bj) { const f32x4 v0 = acc[ai][bj][m][0] * scale, v1 = acc[ai][bj][m][1] * scale; u32x2 w; w.x = pg8::pack4_fp8(v0[0], v0[1], v0[2], v0[3]); w.y = pg8::pack4_fp8(v1[0], v1[1], v1[2], v1[3]);
                    *(GAS u32x2*)((unsigned char*)O + (size_t)row * 2048 + u.pn * 256 + bj * 128 + colw) = w; } }
        EPI_ROWS_END
    }
};
struct EpiGate {
    static constexpr bool PERM = true;
    const bf16 *SGA, *SGB; bf16* MG;
    __device__ __forceinline__ void mid(f32x4 (&acc)[2][2][4][2], const Unit& u, int wr, int wc, int fr, int fq) const {
        const int colw = wc * 32 + 8 * fq; const unsigned char* A8 = (const unsigned char*)SGA; const unsigned char* B8 = (const unsigned char*)SGB;
        EPI_ROWS_BEGIN
#pragma unroll
            for (int bj = 0; bj < 2; ++bj) { const size_t off = (size_t)row * 2048 + u.pn * 256 + bj * 128 + colw;
                const u32x2 a = *(const GAS u32x2*)(A8 + off), b = *(const GAS u32x2*)(B8 + off);
                const f32x4 a0 = unpack4_u8(a.x), a1 = unpack4_u8(a.y), b0 = unpack4_u8(b.x), b1 = unpack4_u8(b.y);
                f32x4& v0 = acc[ai][bj][m][0]; f32x4& v1 = acc[ai][bj][m][1];
#pragma unroll
                for (int j = 0; j < 4; ++j) { v0[j] *= a0[j] * __builtin_amdgcn_rcpf(b0[j]); v1[j] *= a1[j] * __builtin_amdgcn_rcpf(b1[j]); } }
        EPI_ROWS_END
    }
    __device__ __forceinline__ void operator()(f32x4 (&acc)[2][2][4][2], const Unit& u, int wr, int wc, int fr, int fq) const {
        const int colw = wc * 32 + 8 * fq; const unsigned char* B8 = (const unsigned char*)SGB;
#pragma unroll
        for (int ai = 0; ai < 2; ++ai) {
            u32x2 g[4][2];
#pragma unroll
            for (int m = 0; m < 4; ++m)
#pragma unroll
                for (int bj = 0; bj < 2; ++bj) { const int row = u.pm * 256 + ai * 128 + wr * 64 + m * 16 + fr; g[m][bj] = *(const GAS u32x2*)(B8 + (size_t)row * 2048 + u.pn * 256 + bj * 128 + colw); }
#pragma unroll
            for (int m = 0; m < 4; ++m)
#pragma unroll
                for (int bj = 0; bj < 2; ++bj) { const int row = u.pm * 256 + ai * 128 + wr * 64 + m * 16 + fr; const size_t off = (size_t)row * 2048 + u.pn * 256 + bj * 128 + colw;
                    const f32x4 g0 = unpack4_u8(g[m][bj].x) * (MG_SCALE / 255.f), g1 = unpack4_u8(g[m][bj].y) * (MG_SCALE / 255.f);
                    { const f32x4 v0 = acc[ai][bj][m][0] * g0, v1 = acc[ai][bj][m][1] * g1; u32x2 w; w.x = pack4_i8(v0[0], v0[1], v0[2], v0[3]); w.y = pack4_i8(v1[0], v1[1], v1[2], v1[3]); *(GAS u32x2*)((unsigned char*)MG + off) = w; } }
        }
    }
};
template <bool BASE_BF16, bool I32ACC = false> struct EpiResid {
    static constexpr bool PERM = true;
    const void* base; bf16* HB; float* ss; unsigned char* H8; float ascale;
    __device__ __forceinline__ void operator()(f32x4 (&acc)[2][2][4][2], const Unit& u, int wr, int wc, int fr, int fq) const {
        const int colw = wc * 32 + 8 * fq;
#pragma unroll
        for (int ai = 0; ai < 2; ++ai) {
            if constexpr (BASE_BF16) {
#pragma unroll
                for (int m = 0; m < 4; ++m)
#pragma unroll
                    for (int bj = 0; bj < 2; ++bj) { const int row = u.pm * 256 + ai * 128 + wr * 64 + m * 16 + fr; const u32x4 g = *(const GAS u32x4*)((const bf16*)base + (size_t)row * 2048 + u.pn * 256 + bj * 128 + colw);
                        f32x4& v0 = acc[ai][bj][m][0]; f32x4& v1 = acc[ai][bj][m][1];
                        if constexpr (I32ACC) { v0 = __builtin_convertvector(__builtin_bit_cast(pg8::i32x4, v0), f32x4); v1 = __builtin_convertvector(__builtin_bit_cast(pg8::i32x4, v1), f32x4); }
                        v0[0] = v0[0] * ascale + pg8::bf_lo(g.x); v0[1] = v0[1] * ascale + pg8::bf_hi(g.x); v0[2] = v0[2] * ascale + pg8::bf_lo(g.y); v0[3] = v0[3] * ascale + pg8::bf_hi(g.y); v1[0] = v1[0] * ascale + pg8::bf_lo(g.z); v1[1] = v1[1] * ascale + pg8::bf_hi(g.z); v1[2] = v1[2] * ascale + pg8::bf_lo(g.w); v1[3] = v1[3] * ascale + pg8::bf_hi(g.w); }
            } else {
#pragma unroll
                for (int m = 0; m < 4; ++m)
#pragma unroll
                    for (int bj = 0; bj < 2; ++bj) { const int row = u.pm * 256 + ai * 128 + wr * 64 + m * 16 + fr; const size_t off = (size_t)row * 2048 + u.pn * 256 + bj * 128 + colw;
                        acc[ai][bj][m][0] += *(const GAS f32x4*)((const float*)base + off); acc[ai][bj][m][1] += *(const GAS f32x4*)((const float*)base + off + 4); }
            }
#pragma unroll
            for (int m = 0; m < 4; ++m) { const int row = u.pm * 256 + ai * 128 + wr * 64 + m * 16 + fr; float s = 0.f;
#pragma unroll
                for (int bj = 0; bj < 2; ++bj) { const size_t off = (size_t)row * 2048 + u.pn * 256 + bj * 128 + colw; const f32x4 v0 = acc[ai][bj][m][0], v1 = acc[ai][bj][m][1];
                    st16(HB + off, v0, v1);
                    if (H8) { u32x2 w; w.x = pg8::pack4_fp8(v0[0], v0[1], v0[2], v0[3]); w.y = pg8::pack4_fp8(v1[0], v1[1], v1[2], v1[3]); *(GAS u32x2*)(H8 + off) = w; }
                    s += (v0[0] * v0[0] + v0[1] * v0[1]) + (v0[2] * v0[2] + v0[3] * v0[3]) + (v1[0] * v1[0] + v1[1] * v1[1]) + (v1[2] * v1[2] + v1[3] * v1[3]); }
                if (ss) { s += __shfl_xor(s, 16); s += __shfl_xor(s, 32); if (fq == 0) ss[(size_t)row * 32 + u.pn * 4 + wc] = s; } }
        }
    }
};
struct EpiHid {
    static constexpr bool PERM = true;
    bf16* HID; const float* listr; const LAS int* cnt;
    __device__ __forceinline__ void operator()(f32x4 (&acc)[2][2][4][2], const Unit& u, int wr, int wc, int fr, int fq) const {
        const int colw = wc * 32 + 8 * fq, e = u.z & 255, tl = u.z >> 8, c = cnt[e];
        float rsv[2][4];
#pragma unroll
        for (int ai = 0; ai < 2; ++ai)
#pragma unroll
            for (int m = 0; m < 4; ++m) { const int r = ai * 128 + wr * 64 + m * 16 + fr; int idx = tl * 256 + r; idx = idx < c ? idx : c - 1; rsv[ai][m] = listr[e * NTOK + idx]; }
#pragma unroll
        for (int ai = 0; ai < 2; ++ai)
#pragma unroll
            for (int m = 0; m < 4; ++m) { const int r = ai * 128 + wr * 64 + m * 16 + fr;
                const float rs = rsv[ai][m] * (1.f / WGU_SCALE);
                f32x4 o0, o1;
#pragma unroll
                for (int j = 0; j < 4; ++j) { const float g0 = acc[ai][0][m][0][j] * rs, u0 = acc[ai][1][m][0][j] * rs, g1 = acc[ai][0][m][1][j] * rs, u1 = acc[ai][1][m][1][j] * rs;
                    o0[j] = g0 * sigmoidf_fast(g0) * u0; o1[j] = g1 * sigmoidf_fast(g1) * u1; }
                u32x2 w; w.x = pg8::pack4_fp8(o0[0] * HID_SCALE, o0[1] * HID_SCALE, o0[2] * HID_SCALE, o0[3] * HID_SCALE); w.y = pg8::pack4_fp8(o1[0] * HID_SCALE, o1[1] * HID_SCALE, o1[2] * HID_SCALE, o1[3] * HID_SCALE);
                *(GAS u32x2*)((unsigned char*)HID + (size_t)(u.pm * 256 + r) * 512 + u.pn * 128 + colw) = w; }
    }
};

__device__ __forceinline__ void store_o_bf16(const att::f32x16 (&o)[4], bf16* O, int ldo, int wid, int r32, int hi) {
#pragma unroll
    for (int r = 0; r < 16; ++r) { bf16* rowp = O + (size_t)(wid * 32 + att::crow(r, hi)) * ldo + r32;
#pragma unroll
        for (int d0 = 0; d0 < 4; ++d0) rowp[d0 * 32] = (bf16)(pg8::cvt_pk_bf16(o[d0][r], 0.f) & 0xffffu); }
}
__device__ __forceinline__ void store_ot_bf16(const att::f32x16 (&o)[4], bf16* O, int ldo, int wid, int r32, int hi) {
    bf16* rowp = O + (size_t)(wid * 32 + r32) * ldo + 4 * hi;
#pragma unroll
    for (int d0 = 0; d0 < 4; ++d0)
#pragma unroll
        for (int rg = 0; rg < 4; ++rg) { u32x2 w; w.x = pg8::cvt_pk_bf16(o[d0][4 * rg], o[d0][4 * rg + 1]); w.y = pg8::cvt_pk_bf16(o[d0][4 * rg + 2], o[d0][4 * rg + 3]); *(GAS u32x2*)(rowp + 32 * d0 + 8 * rg) = w; }
}
__device__ __forceinline__ void store_ot_fp8(const att::f32x16 (&o)[4], unsigned char* O8, int ldo_bytes, int wid, int r32, int hi, float scale) {
    unsigned char* rowp = O8 + (size_t)(wid * 32 + r32) * ldo_bytes + 4 * hi;
#pragma unroll
    for (int d0 = 0; d0 < 4; ++d0)
#pragma unroll
        for (int rg = 0; rg < 4; ++rg) *(GAS unsigned*)(rowp + 32 * d0 + 8 * rg) = pg8::pack4_fp8(o[d0][4 * rg] * scale, o[d0][4 * rg + 1] * scale, o[d0][4 * rg + 2] * scale, o[d0][4 * rg + 3] * scale);
}
}
namespace mk {
constexpr int N_PHASES = 13;
#define WIN_T ((bf16*)(ws + WS_WIN_T))
#define WOA_T ((bf16*)(ws + WS_WOA_T))
#define WOB_T ((bf16*)(ws + WS_WOB_T))
#define WOUT_T ((bf16*)(ws + WS_WOUT_T))
#define WUQ_T ((bf16*)(ws + WS_WUQ_T))
#define WUKV_T ((bf16*)(ws + WS_WUKV_T))
#define WCQ_T ((bf16*)(ws + WS_WCQ_T))
#define WCKV_T ((bf16*)(ws + WS_WCKV_T))
#define WCO_T ((bf16*)(ws + WS_WCO_T))
#define XN ((bf16*)(ws + WS_XN))
#define QM ((bf16*)(ws + WS_QM))
#define MG ((bf16*)(ws + WS_MG))
#define QD ((bf16*)(ws + WS_QD))
#define KD ((bf16*)(ws + WS_KD))
#define VD ((bf16*)(ws + WS_VD))
#define CQ ((bf16*)(ws + WS_CQ))
#define CKV ((bf16*)(ws + WS_CKV))
#define SGA ((bf16*)(ws + WS_SGA))
#define SGB ((bf16*)(ws + WS_SGB))
#define KM ((bf16*)(ws + WS_KM))
#define VM ((bf16*)(ws + WS_VM))
#define OB ((bf16*)(ws + WS_OB))
#define MEMN ((bf16*)(ws + WS_MEMN))
#define KVC ((bf16*)(ws + WS_KVC))
#define HB ((bf16*)(ws + WS_HB))
#define QC ((bf16*)(ws + WS_QC))
#define OC ((bf16*)(ws + WS_OC))
#define WGU_T ((bf16*)(ws + WS_WGU_T))
#define WD_T ((bf16*)(ws + WS_WD_T))
#define HID ((bf16*)(ws + WS_HID))
#define Y ((bf16*)(ws + WS_Y))
#define SS_CQ ((float*)(ws + WS_SS_CQ))
#define SS_CKV ((float*)(ws + WS_SS_CKV))
#define SS_H1 ((float*)(ws + WS_SS_H1))
#define ROPE_D ((float*)(ws + WS_ROPE_D))
#define ROPE_M ((float*)(ws + WS_ROPE_M))
#define WR_T ((float*)(ws + WS_WR_T))
#define TOKES ((int*)(ws + WS_TOKES))
#define TOKW ((float*)(ws + WS_TOKW))
#define SCAL ((float*)(ws + WS_SCAL))
#define LIST ((int*)(ws + WS_LIST))
#define LISTR ((float*)(ws + WS_LISTR))


__device__ __forceinline__ int mk_lane_now() { int t; asm volatile("v_mbcnt_lo_u32_b32 %0, -1, 0\n\tv_mbcnt_hi_u32_b32 %0, -1, %0" : "=v"(t)); return t; }
typedef const __attribute__((address_space(4))) Args* ArgP;
constexpr int MOE_I_GU = (2048 / 64) * (1024 / 32), MOE_I_DN = (512 / 64) * (2048 / 32), MOE_I_E = MOE_I_GU + MOE_I_DN, MOE_CONV_ITEMS = 32 * MOE_I_E;
constexpr int MOE_N_GU = 32 * MOE_I_GU, MOE_N_DN = 32 * MOE_I_DN, MOE_GU_P5 = MOE_N_GU - 4424;
constexpr int MOE_CONV_P5 = (MOE_CONV_ITEMS * 91 / 100) / 8 * 8;
__device__ __forceinline__ void moe_conv_item(int it, ArgP ap, unsigned char* ws, LAS float* scr, int lane) {
    const int e = it / MOE_I_E; int r = it - e * MOE_I_E; const int nl = lane & 31;
    if (r < MOE_I_GU) { const int nblk = 1024 / 32, kb = r / nblk, nb = r % nblk, n = nb * 32, pn = n >> 8, half = (n >> 7) & 1, j = n & 127;
        const float* src = (half ? ap->w_up : ap->w_gate) + (size_t)e * 2048 * 512;
        transpose_item<true>(src, 512, pn * 128 + j + nl, ap->ffn_norm_g, kb * 64, (bf16*)((unsigned char*)WGU_T + (size_t)e * 1024 * 2048), 2048, n, scr, lane, WGU_SCALE); }
    else { r -= MOE_I_GU; const int nblk = 2048 / 32, kb = r / nblk, nb = r % nblk;
        transpose_item<true>(ap->w_down + (size_t)e * 512 * 2048, 2048, nb * 32 + nl, nullptr, kb * 64, (bf16*)((unsigned char*)WD_T + (size_t)e * 2048 * 512), 512, nb * 32, scr, lane, WD_SCALE); }
}
__device__ __forceinline__ TItem moe_item(int it, ArgP ap, unsigned char* ws, int lane) {
    const int e = it / MOE_I_E; int r = it - e * MOE_I_E; const int nl = lane & 31;
    if (r < MOE_I_GU) { const int nblk = 1024 / 32, kb = r / nblk, nb = r % nblk, n = nb * 32, pn = n >> 8, half = (n >> 7) & 1, j = n & 127;
        const float* src = (half ? ap->w_up : ap->w_gate) + (size_t)e * 2048 * 512;
        return tr_make(src, 512, pn * 128 + j + nl, ap->ffn_norm_g, kb * 64, (unsigned char*)WGU_T + (size_t)e * 1024 * 2048, 2048, n, lane, true, WGU_SCALE); }
    r -= MOE_I_GU; const int nblk = 2048 / 32, kb = r / nblk, nb = r % nblk;
    return tr_make(ap->w_down + (size_t)e * 512 * 2048, 2048, nb * 32 + nl, nullptr, kb * 64, (unsigned char*)WD_T + (size_t)e * 2048 * 512, 512, nb * 32, lane, true, WD_SCALE);
}
template <int KIND> __device__ __forceinline__ int moe_map(int i) { return KIND == 0 ? (i / MOE_I_GU) * MOE_I_E + i % MOE_I_GU : (i / MOE_I_DN) * MOE_I_E + MOE_I_GU + i % MOE_I_DN; }
template <int KIND> __device__ __forceinline__ void moe_conv_run(int first, int limit, int stride, ArgP ap, unsigned char* ws, LAS float* scr, int lane) {
    if (first >= limit) return;
    TItem cur = moe_item(moe_map<KIND>(first), ap, ws, lane); float v[32]; tr_load(cur, v);
    for (int it = first; ; ) { const int nx = it + stride; const bool has = nx < limit; TItem nt_; float w[32];
        if (has) { nt_ = moe_item(moe_map<KIND>(nx), ap, ws, lane); tr_load(nt_, w); }
        tr_finish(cur, v, scr, lane);
        if (!has) break;
        cur = nt_; it = nx;
#pragma unroll
        for (int i = 0; i < 32; ++i) v[i] = w[i]; }
}
__device__ __forceinline__ ArgP argp() { ArgP p = (ArgP)__builtin_amdgcn_kernarg_segment_ptr(); asm volatile("" : "+s"(p)); return p; }
__global__ void __launch_bounds__(NWAVES * 64, 2) fused_fwd(Args a_kernarg) {
    extern __shared__ __attribute__((aligned(16))) unsigned char lds_raw[];
    LAS unsigned char* lds = (LAS unsigned char*)lds_raw;
    volatile LAS unsigned* MISC = (volatile LAS unsigned*)(lds + MISC_OFF);
    const int tid0 = threadIdx.x;
    const int wave0 = __builtin_amdgcn_readfirstlane(tid0 >> 6);
#define MK_TID() (wave0 * 64 + mk_lane_now())
    const int G = gridDim.x, bx = blockIdx.x, vcu = (G % 8 == 0) ? (bx % 8) * (G / 8) + bx / 8 : bx;
    for (int u = tid0; u < (LDS_BYTES - LDSCTL_OFF) / 4; u += NWAVES * 64) ((LAS unsigned*)(lds + LDSCTL_OFF))[u] = 0u;
    __syncthreads();
    (void)xcd_barrier_post((unsigned*)((gu32*)argp()->ws + CW_BAR), MISC + 8);
#define MK_BAR() XcdBarrier{(unsigned*)((gu32*)argp()->ws + CW_BAR), xb_xcc_id(), (volatile LAS unsigned*)(lds + MISC_OFF) + 8}
    const int lo = argp()->ph_lo, hi = argp()->ph_hi & 0xffff;
#ifdef MK_PROBE_SKIP
    const bool skip_epi = (argp()->ph_hi >> 16) & 1;
#else
    constexpr bool skip_epi = false;
#endif
#ifndef MK_P3_DIFF
#define MK_P3_DIFF 1
#endif
#ifndef MK_P3_MLA
#define MK_P3_MLA 1
#endif
#ifndef MK_PHASE_MASK
#define MK_PHASE_MASK 0xFFFF
#endif
#define IN(k) (((MK_PHASE_MASK >> (k)) & 1) && lo <= (k) && (k) < hi)
#define PHASE_IDS() int tid = MK_TID(); asm volatile("" : "+v"(tid)); const int lane = tid & 63, wave = __builtin_amdgcn_readfirstlane(tid >> 6), gw = vcu * NWAVES + wave; \
    LAS float* scr = (LAS float*)(lds + RING_OFF + wave * 16384); const ArgP ap = argp(); unsigned char* const ws = ap->ws; gu32* const ctl = (gu32*)ws; (void)lane; (void)gw; (void)scr; (void)ap; (void)ctl
#define SEAM(k) do { if (IN(k) && IN((k) + 1)) { const XcdBarrier bar_ = MK_BAR(); xcd_barrier(bar_, MK_TID()); } } while (0)
    const int NGW = G * NWAVES;

    if (IN(0)) { asm volatile("; MKPHASE 0" ::: "memory"); PHASE_IDS();
        constexpr int I_IN = (2048 / 64) * (NPROJ / 32), I_OA = (1024 / 64) * (2048 / 32), I_OUT = (2048 / 64) * (2048 / 32), I_UQ = (512 / 64) * (1536 / 32), I_UKV = (256 / 64) * (2048 / 32),
                      I_CQ = (2048 / 64) * (512 / 32), I_CKV = (2048 / 64) * (1024 / 32), I_CO = (512 / 64) * (2048 / 32);
        constexpr int NITEMS = I_IN + 2 * I_OA + I_OUT + I_UQ + I_UKV + I_CQ + I_CKV + I_CO;
        auto p0_item = [&](int it) -> TItem { int r = it; const int nl = lane & 31;
            if (r < I_IN) { const int nblk = NPROJ / 32, kb = r / nblk, nb = r % nblk, n0 = nb * 32;
                if (n0 >= 3072) { const int r8 = n0 < 3840 ? n0 - 3072 + 4096 : (n0 < 7936 ? n0 - 3840 : n0 - 7936 + 4864);
                    return tr_make(ap->w_in, D_IN, win_src(n0 + nl), nullptr, kb * 64, ws + WS_WIN8, 2048, r8, lane, true, WIN_SCALE); }
                return tr_make(ap->w_in, D_IN, win_src(n0 + nl), ap->attn_norm_g, kb * 64, WIN_T, 2048, n0, lane, false); }
            r -= I_IN;
            if (r < I_OA) { const int nblk = 2048 / 32, kb = r / nblk, nb = r % nblk; return tr_make(ap->w_o_diff, 2048, nb * 32 + nl, nullptr, kb * 64, WOA_T, 1024, nb * 32, lane, false); } r -= I_OA;
            if (r < I_OA) { const int nblk = 2048 / 32, kb = r / nblk, nb = r % nblk; return tr_make(ap->w_o_mla, 2048, nb * 32 + nl, nullptr, kb * 64, WOB_T, 2048, nb * 32, lane, true, 64.f); } r -= I_OA;
            if (r < I_OUT) { const int nblk = 2048 / 32, kb = r / nblk, nb = r % nblk; return tr_make(ap->w_out, 2048, nb * 32 + nl, nullptr, kb * 64, WOUT_T, 2048, nb * 32, lane, 2, WOUT_SCALE); } r -= I_OUT;
            if (r < I_UQ) { const int nblk = 1536 / 32, kb = r / nblk, nb = r % nblk; return tr_make(ap->w_uq, 1536, wuq_src(nb * 32 + nl), ap->mla_q_norm_g, kb * 64, WUQ_T, 512, nb * 32, lane, true, WIN_SCALE); } r -= I_UQ;
            if (r < I_UKV) { const int nblk = 2048 / 32, kb = r / nblk, nb = r % nblk; return tr_make(ap->w_ukv, 2048, nb * 32 + nl, ap->mla_kv_norm_g, kb * 64, WUKV_T, 256, nb * 32, lane, true, WIN_SCALE); } r -= I_UKV;
            if (r < I_CQ) { const int nblk = 512 / 32, kb = r / nblk, nb = r % nblk; return tr_make(ap->w_cq, 512, nb * 32 + nl, ap->cross_norm_g, kb * 64, ws + WS_WCQ8, 2048, nb * 32, lane, true, WIN_SCALE); } r -= I_CQ;
            if (r < I_CKV) { const int nblk = 1024 / 32, kb = r / nblk, nb = r % nblk; return tr_make(ap->w_ckv, 1024, nb * 32 + nl, nullptr, kb * 64, ws + WS_WCKV8, 2048, nb * 32, lane, true, WIN_SCALE); } r -= I_CKV;
            { const int nblk = 2048 / 32, kb = r / nblk, nb = r % nblk; return tr_make(ap->w_co, 2048, nb * 32 + nl, nullptr, kb * 64, WCO_T, 512, nb * 32, lane, true, 64.f); } };
        if (gw < NITEMS) {
            TItem cur = p0_item(gw); float v[32]; tr_load(cur, v);
            for (int it = gw; ; ) { const int nx = it + NGW; const bool has = nx < NITEMS; TItem nt_; float w[32];
                if (has) { nt_ = p0_item(nx); tr_load(nt_, w); }
                tr_finish(cur, v, scr, lane);
                if (!has) break;
                cur = nt_; it = nx;
#pragma unroll
                for (int i = 0; i < 32; ++i) v[i] = w[i]; } }
        { int m = gw;
          for (; m + NGW < NTOK; m += 2 * NGW) { const int m2 = m + NGW;
              rms_rows2_x(ap->x + (size_t)m * DM, ap->x + (size_t)m2 * DM, ap->attn_norm_g, ws + WS_XN8 + (size_t)m * DM, ws + WS_XN8 + (size_t)m2 * DM, HB + (size_t)m * DM, HB + (size_t)m2 * DM, (float*)(ws + WS_RSTDX) + m, (float*)(ws + WS_RSTDX) + m2, lane); }
          if (m < NTOK) rms_row_to_bf16(ap->x + (size_t)m * DM, ap->attn_norm_g, nullptr, lane, ws + WS_XN8 + (size_t)m * DM, HB + (size_t)m * DM, (float*)(ws + WS_RSTDX) + m); }
        for (int m = gw; m < NB * MEML; m += NGW) rms_row_to_bf16(ap->mem + (size_t)m * DM, ap->mem_norm_g, MEMN + (size_t)m * DM, lane, ws + WS_MEMN8 + (size_t)m * DM);
        for (int idx = (vcu * NWAVES * 64) + tid; idx < NTOK * 40; idx += G * NWAVES * 64) { const int tok = idx / 40, j = idx - tok * 40; const float p = (float)ap->positions[tok];
            if (j < 8) { const float inv = powf(500000.0f, -(float)j * 2.0f / 16.0f), ang = p * inv; ROPE_D[(size_t)tok * 16 + j * 2] = cosf(ang); ROPE_D[(size_t)tok * 16 + j * 2 + 1] = sinf(ang); }
            else { const int i = j - 8; const float inv = powf(500000.0f, -(float)i * 2.0f / 64.0f), ang = p * inv; ROPE_M[(size_t)tok * 64 + i * 2] = cosf(ang); ROPE_M[(size_t)tok * 64 + i * 2 + 1] = sinf(ang); } }
        for (int idx = (vcu * NWAVES * 64) + tid; idx < 48 * DM; idx += G * NWAVES * 64) { const int j = idx / DM, k = idx - j * DM; float v = 0.f;
            if (j < 4) v = ap->w_rg[k * 4 + j] * ap->ffn_norm_g[k]; else if (j < 36) v = ap->w_re[k * 32 + (j - 4)] * ap->ffn_norm_g[k];
            const unsigned hi = pg8::cvt_pk_bf16(v, 0.f) & 0xffffu; const float r = v - __uint_as_float(hi << 16); const unsigned lo = pg8::cvt_pk_bf16(r, 0.f) & 0xffffu;
            ((bf16*)WR_T)[idx] = (bf16)hi; ((bf16*)WR_T)[48 * DM + idx] = (bf16)lo; }
        if (bx == 0 && wave == 0) { const float p1 = wave_sum(ap->lq1[lane] * ap->lk1[lane]), p2 = wave_sum(ap->lq2[lane] * ap->lk2[lane]); if (lane == 0) SCAL[0] = expf(p1) - expf(p2) + 0.2f; }
    }
    SEAM(0);

    if (IN(1)) { asm volatile("; MKPHASE 1" ::: "memory"); PHASE_IDS();
        { SchedProj S; S.ord.init(NTOK / 256, 12, G, bx); S.Ab = (const char*)HB; S.Bb = (const char*)WIN_T; S.tA = (size_t)256 * 2048 * 2; S.tB = (size_t)256 * 2048 * 2; S.fp8 = 0;
          EpiProj E{QD, KD, VD, ROPE_D, (const float*)(ws + WS_RSTDX)};
          pg8::gemm_phase<EpiProj, SchedProj>(lds + RING_OFF, 2048, 2048, 2048, S, E, MK_TID(), skip_epi); }
        { SchedProj S; S.ord.init(NTOK / 256, 20, G, bx); S.Ab = (const char*)(ws + WS_XN8); S.Bb = (const char*)(ws + WS_WIN8); S.tA = (size_t)256 * 2048; S.tB = (size_t)256 * 2048; S.fp8 = 1;
          EpiGates E{SGA, SGB, CQ, CKV, (bf16*)(ws + WS_KPE), SS_CQ, SS_CKV, ROPE_M, 1.f / WIN_SCALE};
          pg8::gemm_phase<EpiGates, SchedProj, false, true, false, 1>(lds + RING_OFF, 2048, 2048, 2048, S, E, MK_TID(), skip_epi); }
    }
    SEAM(1);

    if (IN(2)) { asm volatile("; MKPHASE 2" ::: "memory"); PHASE_IDS();
        { SchedTile S; S.ord.init(NTOK / 256, 1536 / 256, G, vcu); S.Ab = (const char*)CQ; S.Bb = (const char*)WUQ_T; S.tA = (size_t)256 * 512; S.tB = (size_t)256 * 512;
          EpiQup E{QM, SS_CQ, ROPE_M}; pg8::gemm_phase<EpiQup, SchedTile, false, true, false, 1>(lds + RING_OFF, 512, 512, 512, S, E, MK_TID(), skip_epi); }
        { SchedBal S{G, vcu, (const char*)CKV, (const char*)WUKV_T, (size_t)256 * 256, (size_t)256 * 256};
          EpiKVup E{KM, VM, SS_CKV}; pg8::gemm_phase<EpiKVup, SchedBal, false, true, false, 1>(lds + RING_OFF, 256, 256, 256, S, E, MK_TID(), skip_epi); }
    }
    SEAM(2);

    if (IN(3)) { asm volatile("; MKPHASE 3" ::: "memory"); PHASE_IDS();
        char* al = (char*)lds_raw + RING_OFF;
        const float lam = __uint_as_float(__builtin_amdgcn_readfirstlane(__hip_atomic_load((const unsigned*)SCAL, RLX_AGENT)));
        for (int L = vcu; L < 1024; L += G) {
            att::f32x16 o[4];
            if (MK_P3_DIFF && L < 512) {
                int tl = MK_TID(); asm volatile("" : "+v"(tl));
                const int bh = L >> 3, qb = L & 7, b = bh >> 3, h = bh & 7; const size_t tok0 = (size_t)b * SEQ + qb * 256;
                LAS unsigned* stash = (LAS unsigned*)(lds + 65536);
                att::attn_core<64, 2>(QD + tok0 * 1024 + (2 * h) * 64, 1024, KD + (size_t)b * SEQ * 1024 + (2 * h) * 64, 1024, VD + (size_t)b * SEQ * 1024 + h * 128, 1024, SEQ, al, o, tl);
#pragma unroll
                for (int d0 = 0; d0 < 4; ++d0)
#pragma unroll
                    for (int r = 0; r < 16; r += 2) stash[(d0 * 8 + (r >> 1)) * 512 + tl] = pg8::cvt_pk_bf16(o[d0][r], o[d0][r + 1]);
                int tl2 = tl; asm volatile("" : "+v"(tl2)); const int r32b = tl2 & 31, hhb = (tl2 >> 5) & 1, twb = tl2 >> 6;
                att::attn_core<64, 2>(QD + tok0 * 1024 + (2 * h + 1) * 64, 1024, KD + (size_t)b * SEQ * 1024 + (2 * h + 1) * 64, 1024, VD + (size_t)b * SEQ * 1024 + h * 128, 1024, SEQ, al, o, tl2);
                float q[16];
#pragma unroll
                for (int r = 0; r < 16; ++r) q[r] = 0.f;
#pragma unroll
                for (int d0 = 0; d0 < 4; ++d0)
#pragma unroll
                    for (int r = 0; r < 16; r += 2) { const unsigned w = stash[(d0 * 8 + (r >> 1)) * 512 + tl2];
                        o[d0][r] = pg8::bf_lo(w) - lam * o[d0][r]; o[d0][r + 1] = pg8::bf_hi(w) - lam * o[d0][r + 1]; q[r] += o[d0][r] * o[d0][r]; q[r + 1] += o[d0][r + 1] * o[d0][r + 1]; }
#pragma unroll
                for (int r = 0; r < 16; ++r) { float s = q[r];
#define SWZ_ADD(m) s += __int_as_float(__builtin_amdgcn_ds_swizzle(__float_as_int(s), ((m) << 10) | 0x1f))
                    SWZ_ADD(1); SWZ_ADD(2); SWZ_ADD(4); SWZ_ADD(8); SWZ_ADD(16);
#undef SWZ_ADD
                    q[r] = rsqrtf(s * (1.f / 128.f) + 1e-5f) * 0.8f; }
#pragma unroll
                for (int d0 = 0; d0 < 4; ++d0) { const float g = ap->subln_g[d0 * 32 + r32b];
#pragma unroll
                    for (int r = 0; r < 16; ++r) o[d0][r] *= q[r] * g; }
                store_o_bf16(o, QD + tok0 * 1024 + h * 128, 1024, twb, r32b, hhb);
                __syncthreads();
            } else if (MK_P3_MLA) {
                int tl = MK_TID(); asm volatile("" : "+v"(tl));
                const int L2 = L - 512, bh = L2 >> 3, qb = L2 & 7, b = bh >> 3, h = bh & 7; const size_t tok0 = (size_t)b * SEQ + qb * 256;
                att::attn_core_f8<3, true>((const unsigned char*)QM + tok0 * 1536 + h * 192, 1536, (const unsigned char*)KM + (size_t)b * SEQ * 1024 + h * 128, 1024, ws + WS_KPE + (size_t)b * SEQ * 64, (const unsigned char*)VM + (size_t)b * SEQ * 1024 + h * 128, 1024, SEQ, al, o, tl, MLA_SCA, MLA_SCB, MLA_SCV, MLA_SCP);
                int tl3 = tl; asm volatile("" : "+v"(tl3));
                store_ot_fp8(o, (unsigned char*)OB + tok0 * 2048 + h * 128, 2048, tl3 >> 6, tl3 & 31, (tl3 >> 5) & 1, 8.f);
            }
        }
    }
    SEAM(3);

    if (IN(4)) { asm volatile("; MKPHASE 4" ::: "memory"); PHASE_IDS();
        SchedGate S; S.ord.init(NTOK / 256, 2048 / 256, G, bx); S.A0 = (const char*)QD; S.A1 = (const char*)OB; S.B0 = (const char*)WOA_T; S.B1 = (const char*)WOB_T; S.tA = (size_t)256 * 1024 * 2; S.tB = (size_t)256 * 1024 * 2;
        EpiGate E{SGA, SGB, MG};
        pg8::gemm_phase<EpiGate, SchedGate, false, true, true, 2, true>(lds + RING_OFF, 1024, 1024, 1024, S, E, MK_TID(), skip_epi);
    }
    SEAM(4);

    if (IN(5)) { asm volatile("; MKPHASE 5" ::: "memory"); PHASE_IDS();
        const bool conv_first = (G != 256) || (((vcu >> 5) & 1) == 0);
        const int nconv = (G == 256) ? MOE_GU_P5 : MOE_N_GU;
        if (conv_first) { moe_conv_run<0>(gw, nconv, NGW, ap, ws, scr, lane); __syncthreads(); }
        { SchedTile S; S.ord.init(NTOK / 256, 2048 / 256, G, bx); S.Ab = (const char*)MG; S.Bb = (const char*)WOUT_T; S.tA = (size_t)256 * 2048; S.tB = (size_t)256 * 2048;
          EpiResid<true, true> E{HB, HB, SS_H1, ws + WS_H8, 1.f / (MG_SCALE * WOUT_SCALE)};
          pg8::gemm_phase<EpiResid<true, true>, SchedTile, false, true, false, 1, false, true>(lds + RING_OFF, 2048, 2048, 2048, S, E, MK_TID(), skip_epi); }
        if (!conv_first) { __syncthreads(); moe_conv_run<0>(gw, nconv, NGW, ap, ws, scr, lane); }
    }
    SEAM(5);

    if (IN(6)) { asm volatile("; MKPHASE 6" ::: "memory"); PHASE_IDS();
        if (bx < 128 || G != 256) {
            SchedTile S; S.ord.init(NTOK / 256, 512 / 256, G, bx); S.Ab = (const char*)(ws + WS_H8); S.Bb = (const char*)(ws + WS_WCQ8); S.tA = (size_t)256 * 2048; S.tB = (size_t)256 * 2048;
            EpiPlain E{QC, 512, SS_H1, 1.f / 2048.f, C2C * MLA_QS / WIN_SCALE, 1};
            pg8::gemm_phase<EpiPlain, SchedTile, false, true, false, 1>(lds + RING_OFF, 2048, 2048, 2048, S, E, MK_TID(), skip_epi);
        }
        if (G != 256 || (bx >= 128 && bx < 160)) {
            SchedOff S{1024 / 256, NB * MEML / 256 * 4, G == 256 ? bx - 128 : bx, (const char*)(ws + WS_MEMN8), (const char*)(ws + WS_WCKV8), (size_t)256 * 2048, (size_t)256 * 2048};
            EpiPlain E{KVC, 1024, nullptr, 0.f, MLA_KS / WIN_SCALE, 1}; pg8::gemm_phase<EpiPlain, SchedOff, false, true, false, 1>(lds + RING_OFF, 2048, 2048, 2048, S, E, MK_TID(), skip_epi);
        }
        if (G == 256 && bx >= 160) moe_conv_run<0>(MOE_GU_P5 + (bx - 160) * NWAVES + wave, MOE_N_GU, 96 * NWAVES, ap, ws, scr, lane);
    }
    SEAM(6);

    if (IN(7)) { asm volatile("; MKPHASE 7" ::: "memory"); PHASE_IDS();
        char* al = (char*)lds_raw + RING_OFF;
        for (int L = vcu; L < 256; L += G) {
            const int bh = L >> 3, qb = L & 7, b = bh >> 2, h = bh & 3; const size_t tok0 = (size_t)b * SEQ + qb * 256;
            att::f32x16 o[4]; int tl = MK_TID(); asm volatile("" : "+v"(tl));
            att::attn_core_f8<2, false>((const unsigned char*)QC + tok0 * 512 + h * 128, 512, (const unsigned char*)KVC + (size_t)b * MEML * 1024 + h * 128, 1024, nullptr, (const unsigned char*)KVC + (size_t)b * MEML * 1024 + 512 + h * 128, 1024, MEML, al, o, tl, MLA_SCA, MLA_SCB, MLA_SCV, MLA_SCP);
            int tl3 = tl; asm volatile("" : "+v"(tl3));
            store_ot_fp8(o, (unsigned char*)OC + tok0 * 512 + h * 128, 512, tl3 >> 6, tl3 & 31, (tl3 >> 5) & 1, 8.f);
        }
    }
    SEAM(7);

    if (IN(8)) { asm volatile("; MKPHASE 8" ::: "memory"); PHASE_IDS();
        SchedTile S; S.ord.init(NTOK / 256, 2048 / 256, G, bx); S.Ab = (const char*)OC; S.Bb = (const char*)WCO_T; S.tA = (size_t)256 * 512; S.tB = (size_t)256 * 512;
        EpiResid<true> E{HB, HB, nullptr, ws + WS_H8, 1.f / 512.f};
        pg8::gemm_phase<EpiResid<true>, SchedTile, false, true, false, 1>(lds + RING_OFF, 512, 512, 512, S, E, MK_TID(), skip_epi);
    }
    SEAM(8);

    if (IN(9)) { asm volatile("; MKPHASE 9" ::: "memory"); PHASE_IDS();
        const int tg = wave & 1, kq4 = wave >> 1;
        LAS float* rbias = (LAS float*)(lds + RING_OFF + 65536);
        if (wave == 0 && lane < 36) rbias[lane] = lane < 4 ? ap->b_rg[lane] : ap->b_re[lane - 4];
        LAS float* lgb = (LAS float*)(lds + RING_OFF + tg * 32768);
        LAS float* lg = lgb + kq4 * 1600;
        for (int grp = vcu * 2 + tg; grp < NTOK / 32; grp += G * 2) {
            const int row = lane & 15, kq = lane >> 4, tok0 = grp * 32;
            const GAS u32x4* hp0 = (const GAS u32x4*)(HB + (size_t)(tok0 + row) * DM + kq4 * (DM / 4)) + kq; const GAS u32x4* hp1 = hp0 + 16 * DM / 8;
            const GAS u32x4* wh = (const GAS u32x4*)((const bf16*)WR_T + (size_t)row * DM + kq4 * (DM / 4)) + kq;
            const GAS u32x4* wl = wh + 48 * DM / 8;
            f32x4 c[2][3]; float ss0 = 0.f, ss1 = 0.f;
#pragma unroll
            for (int i = 0; i < 2; ++i)
#pragma unroll
                for (int j = 0; j < 3; ++j) c[i][j] = (f32x4){0.f, 0.f, 0.f, 0.f};
#pragma unroll 4
            for (int ks = 0; ks < DM / 128; ++ks) { const u32x4 aw0 = hp0[ks * 4], aw1 = hp1[ks * 4];
                u32x4 bh[3], bl[3];
#pragma unroll
                for (int j = 0; j < 3; ++j) { bh[j] = wh[ks * 4 + j * 16 * DM / 8]; bl[j] = wl[ks * 4 + j * 16 * DM / 8]; }
#define SSQ(W) (((pg8::bf_lo(W.x) * pg8::bf_lo(W.x) + pg8::bf_hi(W.x) * pg8::bf_hi(W.x)) + (pg8::bf_lo(W.y) * pg8::bf_lo(W.y) + pg8::bf_hi(W.y) * pg8::bf_hi(W.y))) + ((pg8::bf_lo(W.z) * pg8::bf_lo(W.z) + pg8::bf_hi(W.z) * pg8::bf_hi(W.z)) + (pg8::bf_lo(W.w) * pg8::bf_lo(W.w) + pg8::bf_hi(W.w) * pg8::bf_hi(W.w))))
                ss0 += SSQ(aw0); ss1 += SSQ(aw1);
#undef SSQ
                const bf16x8 af0 = __builtin_bit_cast(bf16x8, aw0), af1 = __builtin_bit_cast(bf16x8, aw1);
#pragma unroll
                for (int j = 0; j < 3; ++j) { const bf16x8 fh = __builtin_bit_cast(bf16x8, bh[j]), fl = __builtin_bit_cast(bf16x8, bl[j]);
                    c[0][j] = __builtin_amdgcn_mfma_f32_16x16x32_bf16(af0, fh, c[0][j], 0, 0, 0); c[0][j] = __builtin_amdgcn_mfma_f32_16x16x32_bf16(af0, fl, c[0][j], 0, 0, 0);
                    c[1][j] = __builtin_amdgcn_mfma_f32_16x16x32_bf16(af1, fh, c[1][j], 0, 0, 0); c[1][j] = __builtin_amdgcn_mfma_f32_16x16x32_bf16(af1, fl, c[1][j], 0, 0, 0); } }
            ss0 += __shfl_xor(ss0, 16); ss0 += __shfl_xor(ss0, 32); ss1 += __shfl_xor(ss1, 16); ss1 += __shfl_xor(ss1, 32);
#pragma unroll
            for (int mb = 0; mb < 2; ++mb)
#pragma unroll
                for (int t = 0; t < 4; ++t) { const int i = 16 * mb + 4 * kq + t;
#pragma unroll
                    for (int j = 0; j < 3; ++j) lg[i * 48 + 16 * j + row] = c[mb][j][t]; }
            if (kq == 0) { lg[1536 + row] = ss0; lg[1536 + 16 + row] = ss1; }
            __syncthreads();
            if (kq4 == 0) {
                const int tl = lane & 31; const LAS float* l = lgb + tl * 48;
                const float rs = rsqrtf(((lgb[1536 + tl] + lgb[1600 + 1536 + tl]) + (lgb[3200 + 1536 + tl] + lgb[4800 + 1536 + tl])) * (1.f / DM) + 1e-6f);
#define LG(j) (((l[j] + l[1600 + (j)]) + (l[3200 + (j)] + l[4800 + (j)])) * rs)
                int g = 0; float gm = LG(0) + rbias[0];
                for (int j = 1; j < 4; ++j) { const float v = LG(j) + rbias[j]; if (v > gm) { gm = v; g = j; } }
                float gs = 0.f; for (int j = 0; j < 4; ++j) gs += expf(LG(j) + rbias[j] - gm); const float gp = 1.f / gs;
                int i0 = 0; float m0 = LG(4 + g * 8) + rbias[4 + g * 8];
                for (int j = 1; j < 8; ++j) { const float v = LG(4 + g * 8 + j) + rbias[4 + g * 8 + j]; if (v > m0) { m0 = v; i0 = j; } }
                int i1 = 0; float m1 = -3.0e38f;
                for (int j = 0; j < 8; ++j) { const float v = LG(4 + g * 8 + j) + rbias[4 + g * 8 + j]; if (j != i0 && v > m1) { m1 = v; i1 = j; } }
#undef LG
                const float p1 = expf(m1 - m0), w0 = 1.f / (1.f + p1), w1 = p1 / (1.f + p1);
                const int second = lane >> 5, e = g * 8 + (second ? i1 : i0), tk = tok0 + tl;
                int rank = 0, run = 0, lead = 0;
#pragma unroll 1
                for (int x = 0; x < 32; ++x) { const unsigned long long mk_ = __ballot(e == x);
                    if (e == x) { rank = __popcll(mk_ & ((1ull << lane) - 1ull)); run = __popcll(mk_); lead = __ffsll((long long)mk_) - 1; } }
                int base = 0; if (lane == lead) base = (int)__hip_atomic_fetch_add(ctl + CW_CNT + 16 * e, (unsigned)run, RLX_AGENT);
                base = __shfl(base, lead); const int slot = base + rank;
                LIST[e * NTOK + slot] = tk; LISTR[e * NTOK + slot] = rs;
                TOKES[tk * 2 + second] = (e << 16) | slot; TOKW[tk * 2 + second] = gp * (second ? w1 : w0);
            }
            __syncthreads();
        }
    }
    SEAM(9);
    LAS int* tpre = (LAS int*)(lds + LDSCTL_OFF); LAS int* ecnt = (LAS int*)(lds + LDSCTL_OFF + 160);
    if (hi > 10 && lo <= 12) { gu32* const ctl = (gu32*)argp()->ws;
        if (MK_TID() == 0) { int s = 0; for (int e = 0; e < 32; ++e) { const int c = (int)__hip_atomic_load(ctl + CW_CNT + 16 * e, RLX_AGENT); ecnt[e] = c; tpre[e] = s; s += (c + 255) >> 8; } tpre[32] = s; }
        __syncthreads();
    }
    const MoeTab tab{tpre, ecnt};

    if (IN(10)) { asm volatile("; MKPHASE 10" ::: "memory"); PHASE_IDS();
        SchedMoe1 S{tab, G, vcu, (const char*)(ws + WS_H8), (const char*)WGU_T, LIST};
        EpiHid E{HID, LISTR, ecnt};
        pg8::gemm_phase<EpiHid, SchedMoe1, true, true, false, 1>(lds + RING_OFF, 2048, 2048, 2048, S, E, MK_TID(), skip_epi);
        { const int U = tab.tpre[32] * 4, R = (U + G - 1) / G, first_light = U - (R - 1) * G, n_light = G - first_light;
          __syncthreads();
          if (n_light >= 32) { if (vcu >= first_light) moe_conv_run<1>((vcu - first_light) * NWAVES + wave, MOE_N_DN, n_light * NWAVES, ap, ws, scr, lane); }
          else moe_conv_run<1>(gw, MOE_N_DN, NGW, ap, ws, scr, lane); }
    }
    SEAM(10);

    if (IN(11)) { asm volatile("; MKPHASE 11" ::: "memory"); PHASE_IDS();
        SchedMoe2 S{tab, G, vcu, (const char*)HID, (const char*)WD_T};
        EpiDown E{Y, tab, Y_SCALE / (HID_SCALE * WD_SCALE)};
        pg8::gemm_phase<EpiDown, SchedMoe2, false, true, false, 1>(lds + RING_OFF, 512, 512, 512, S, E, MK_TID(), skip_epi);
    }
    SEAM(11);

    if (IN(12)) { asm volatile("; MKPHASE 12" ::: "memory"); PHASE_IDS();
        for (int tokA = gw; tokA < NTOK; tokA += 2 * NGW) {
            const int tokB = tokA + NGW; const bool hasB = tokB < NTOK; const int tb = hasB ? tokB : tokA;
            const int a0 = TOKES[tokA * 2], a1 = TOKES[tokA * 2 + 1], b0 = TOKES[tb * 2], b1 = TOKES[tb * 2 + 1];
            const float wa0 = TOKW[tokA * 2] * (1.f / Y_SCALE), wa1 = TOKW[tokA * 2 + 1] * (1.f / Y_SCALE), wb0 = TOKW[tb * 2] * (1.f / Y_SCALE), wb1 = TOKW[tb * 2 + 1] * (1.f / Y_SCALE);
            const size_t ra0 = (size_t)tpre[a0 >> 16] * 256 + (a0 & 0xffff), ra1 = (size_t)tpre[a1 >> 16] * 256 + (a1 & 0xffff), rb0 = (size_t)tpre[b0 >> 16] * 256 + (b0 & 0xffff), rb1 = (size_t)tpre[b1 >> 16] * 256 + (b1 & 0xffff);
            const GAS u32x2* hA = (const GAS u32x2*)(HB + (size_t)tokA * DM) + lane; const GAS unsigned* yA0 = (const GAS unsigned*)((const unsigned char*)Y + ra0 * DM) + lane; const GAS unsigned* yA1 = (const GAS unsigned*)((const unsigned char*)Y + ra1 * DM) + lane;
            const GAS u32x2* hB = (const GAS u32x2*)(HB + (size_t)tb * DM) + lane; const GAS unsigned* yB0 = (const GAS unsigned*)((const unsigned char*)Y + rb0 * DM) + lane; const GAS unsigned* yB1 = (const GAS unsigned*)((const unsigned char*)Y + rb1 * DM) + lane;
            const GAS f32x4* gp = (const GAS f32x4*)ap->final_norm_g + lane;
            u32x2 hwA[8], hwB[8]; unsigned pA[8], qA[8], pB[8], qB[8];
#pragma unroll
            for (int j = 0; j < 8; ++j) { hwA[j] = hA[64 * j]; pA[j] = yA0[64 * j]; qA[j] = yA1[64 * j]; }
#pragma unroll
            for (int j = 0; j < 8; ++j) { hwB[j] = hB[64 * j]; pB[j] = yB0[64 * j]; qB[j] = yB1[64 * j]; }
#define P12_ONE(TOK, HW, PP, QQ, W0, W1) do { f32x4 v[8]; float s_ = 0.f; \
            _Pragma("unroll") for (int j = 0; j < 8; ++j) { f32x4 t = {pg8::bf_lo(HW[j].x), pg8::bf_hi(HW[j].x), pg8::bf_lo(HW[j].y), pg8::bf_hi(HW[j].y)}; \
                { const auto p01 = __builtin_amdgcn_cvt_pk_f32_fp8((int)PP[j], false), p23 = __builtin_amdgcn_cvt_pk_f32_fp8((int)PP[j], true), q01 = __builtin_amdgcn_cvt_pk_f32_fp8((int)QQ[j], false), q23 = __builtin_amdgcn_cvt_pk_f32_fp8((int)QQ[j], true); \
                  t[0] += W0 * p01[0] + W1 * q01[0]; t[1] += W0 * p01[1] + W1 * q01[1]; t[2] += W0 * p23[0] + W1 * q23[0]; t[3] += W0 * p23[1] + W1 * q23[1]; } \
                v[j] = t; s_ += (t[0] * t[0] + t[1] * t[1]) + (t[2] * t[2] + t[3] * t[3]); } \
            const float rstd_ = rsqrtf(wave_sum(s_) * (1.f / DM) + 1e-6f); GAS f32x4* op_ = (GAS f32x4*)(ap->out + (size_t)(TOK) * DM) + lane; \
            _Pragma("unroll") for (int j = 0; j < 8; ++j) op_[64 * j] = v[j] * rstd_ * gp[64 * j]; } while (0)
            P12_ONE(tokA, hwA, pA, qA, wa0, wa1);
            if (hasB) P12_ONE(tokB, hwB, pB, qB, wb0, wb1);
#undef P12_ONE
        }
    }
#undef IN
#undef SEAM
}

static int g_grid = 0;
static bool launch_fused(const Args& a0, int ph_lo, int ph_hi, hipStream_t stream, size_t ws_size) {
    if (g_grid == 0) {
        int dev = 0, cus = 0, per_cu = 0;
        if (ws_size < WS_END) { fprintf(stderr, "kernel_launch: workspace too small: %zu < %zu\n", ws_size, (size_t)WS_END); g_grid = -1; return false; }
        if (hipGetDevice(&dev) != hipSuccess || hipDeviceGetAttribute(&cus, hipDeviceAttributeMultiprocessorCount, dev) != hipSuccess) { g_grid = -1; return false; }
        if (hipFuncSetAttribute((const void*)fused_fwd, hipFuncAttributeMaxDynamicSharedMemorySize, LDS_BYTES) != hipSuccess) { fprintf(stderr, "kernel_launch: hipFuncSetAttribute failed\n"); g_grid = -1; return false; }
        if (hipOccupancyMaxActiveBlocksPerMultiprocessor(&per_cu, (const void*)fused_fwd, NWAVES * 64, LDS_BYTES) != hipSuccess || per_cu < 1) { fprintf(stderr, "kernel_launch: occupancy query reports %d blocks per CU\n", per_cu); (void)hipGetLastError(); g_grid = -1; return false; }
        g_grid = cus;
    }
    if (g_grid < 0) return false;
    Args a = a0; a.ph_lo = ph_lo; a.ph_hi = ph_hi;
    hipLaunchKernelGGL(fused_fwd, dim3(g_grid), dim3(NWAVES * 64), LDS_BYTES, stream, a);
    return true;
}
static Args make_args(void* const* d_in, void* d_out, void* d_ws) {
    Args a{}; int k = 0;
    a.x = (const float*)d_in[k++]; a.mem = (const float*)d_in[k++]; a.positions = (const int*)d_in[k++]; a.attn_norm_g = (const float*)d_in[k++]; a.w_in = (const float*)d_in[k++];
    a.lq1 = (const float*)d_in[k++]; a.lk1 = (const float*)d_in[k++]; a.lq2 = (const float*)d_in[k++]; a.lk2 = (const float*)d_in[k++]; a.subln_g = (const float*)d_in[k++]; a.w_o_diff = (const float*)d_in[k++];
    a.mla_q_norm_g = (const float*)d_in[k++]; a.w_uq = (const float*)d_in[k++]; a.mla_kv_norm_g = (const float*)d_in[k++]; a.w_ukv = (const float*)d_in[k++]; a.w_o_mla = (const float*)d_in[k++]; a.w_out = (const float*)d_in[k++];
    a.cross_norm_g = (const float*)d_in[k++]; a.mem_norm_g = (const float*)d_in[k++]; a.w_cq = (const float*)d_in[k++]; a.w_ckv = (const float*)d_in[k++]; a.w_co = (const float*)d_in[k++];
    a.ffn_norm_g = (const float*)d_in[k++]; a.w_rg = (const float*)d_in[k++]; a.b_rg = (const float*)d_in[k++]; a.w_re = (const float*)d_in[k++]; a.b_re = (const float*)d_in[k++];
    a.w_gate = (const float*)d_in[k++]; a.w_up = (const float*)d_in[k++]; a.w_down = (const float*)d_in[k++]; a.final_norm_g = (const float*)d_in[k++];
    a.out = (float*)d_out; a.ws = (unsigned char*)d_ws; a.ph_lo = 0; a.ph_hi = N_PHASES;
    return a;
}
#undef WIN_T
#undef WOA_T
#undef WOB_T
#undef WOUT_T
#undef WUQ_T
#undef WUKV_T
#undef WCQ_T
#undef WCKV_T
#undef WCO_T
#undef XN
#undef QM
#undef MG
#undef QD
#undef KD
#undef VD
#undef CQ
#undef CKV
#undef SGA
#undef SGB
#undef KM
#undef VM
#undef OB
#undef MEMN
#undef KVC
#undef HB
#undef QC
#undef OC
#undef WGU_T
#undef WD_T
#undef HID
#undef Y
#undef SS_CQ
#undef SS_CKV
#undef SS_H1
#undef ROPE_D
#undef ROPE_M
#undef WR_T
#undef TOKES
#undef TOKW
#undef SCAL
#undef LIST
#undef LISTR
}
extern "C" void kernel_launch(void* const* d_in, const int* in_sizes, int n_in, void* d_out, int out_size, void* d_ws, size_t ws_size, hipStream_t stream) {
    if (n_in != 31 || out_size != mk::NTOK * mk::DM) { fprintf(stderr, "kernel_launch: unexpected n_in %d / out_size %d\n", n_in, out_size); return; }
    const mk::Args a = mk::make_args(d_in, d_out, d_ws);
    if (hipMemsetAsync((char*)d_ws + mk::WS_CTL, 0, mk::CTL_ZERO_BYTES, stream) != hipSuccess) return;
    mk::launch_fused(a, 0, mk::N_PHASES, stream, ws_size);
}
```

```cpp
#include <hip/hip_runtime.h>
#include <stdint.h>
#include <stdio.h>
namespace pg8 {
constexpr int MIXED_SA = 0x7c7c7c7c, MIXED_SB = 0x79797979;
#define PG8_LAS __attribute__((address_space(3)))
typedef unsigned short bf16_t;
typedef short bf16x8 __attribute__((ext_vector_type(8)));
typedef float f32x4 __attribute__((ext_vector_type(4)));
typedef float f32x2 __attribute__((ext_vector_type(2)));
typedef unsigned u32x4 __attribute__((ext_vector_type(4)));
typedef unsigned u32x2 __attribute__((ext_vector_type(2)));
typedef int i32x4 __attribute__((ext_vector_type(4)));
typedef int i32x8 __attribute__((ext_vector_type(8)));
constexpr int BM = 256, BK = 64, HALF = 128, HTB = HALF * BK * 2  , STAGE_BYTES = 8 * HTB, NXCD = 8, WGM = 8;

__host__ __device__ __forceinline__ int lds_byte(int r, int c) { const int st = (r >> 4) * 2 + (c >> 5), rr = r & 15, cc = c & 31, ob = rr * 64 + cc * 2; return st * 1024 + (ob ^ (((ob >> 9) & 1) << 5)); }
__host__ __device__ __forceinline__ void stage_rc(int b, int& R, int& C) { const int st = b / 1024, sb = b % 1024, swz = sb ^ (((sb >> 9) & 1) << 5); R = (st >> 1) * 16 + swz / 64; C = (st & 1) * 32 + (swz % 64) / 2; }
__host__ __device__ __forceinline__ int perm32(int rho) { const int n = rho >> 4, i = rho & 15; return 8 * (i >> 2) + 4 * n + (i & 3); }

struct Unit { int pm, pn, z; };

struct TileOrder {
    int nM, nN, nwg, G, c;
    __host__ __device__ void init(int nM_, int nN_, int G_, int c_) { nM = nM_; nN = nN_; nwg = nM * nN; G = G_; c = c_; }
    __host__ __device__ bool tile(int i, int& pm, int& pn) const {
        const long L = (long)i * G + c; if (L >= nwg) return false;
        int wgid = (int)L; { const int q = nwg / NXCD, r = nwg % NXCD, xcd = wgid % NXCD, off = wgid / NXCD; wgid = (xcd < r ? xcd * (q + 1) : r * (q + 1) + (xcd - r) * q) + off; }
        const int nig = WGM * nN, gid = wgid / nig, fm = gid * WGM, gsz = (nM - fm) < WGM ? (nM - fm) : WGM;
        pm = fm + ((wgid % nig) % gsz); pn = (wgid % nig) / gsz; return true;
    }
};

typedef __bf16 bf16x2_hw __attribute__((ext_vector_type(2)));
__device__ __forceinline__ unsigned cvt_pk_bf16(float lo, float hi) { const f32x2 v = {lo, hi}; return __builtin_bit_cast(unsigned, __builtin_convertvector(v, bf16x2_hw)); }
__device__ __forceinline__ u32x4 pack8(const f32x4 a, const f32x4 b) { u32x4 w; w.x = cvt_pk_bf16(a[0], a[1]); w.y = cvt_pk_bf16(a[2], a[3]); w.z = cvt_pk_bf16(b[0], b[1]); w.w = cvt_pk_bf16(b[2], b[3]); return w; }
__device__ __forceinline__ unsigned pack4_fp8(float a, float b, float c, float d) { int w = __builtin_amdgcn_cvt_pk_fp8_f32(a, b, 0, false); w = __builtin_amdgcn_cvt_pk_fp8_f32(c, d, w, true); return (unsigned)w; }
__device__ __forceinline__ float bf_lo(unsigned w) { return __uint_as_float(w << 16); }
__device__ __forceinline__ float bf_hi(unsigned w) { return __uint_as_float(w & 0xffff0000u); }

template <class Epi, class Sched, bool GATHER = false, bool ALIGN_EPI = true, bool CHAIN = false, int EB = 2, bool MIXED = false, bool I8 = false>
__device__ __forceinline__ void gemm_phase(PG8_LAS unsigned char* lds, const int K, const int lda, const int ldb, const Sched& S, const Epi& E, const int tid_in, const bool skip_epi = false) {
    int tid = tid_in; asm volatile("" : "+v"(tid));
    const int wid = __builtin_amdgcn_readfirstlane(tid >> 6), lane = tid & 63, wr = wid >> 2, wc = wid & 3, fr = lane & 15, fq = lane >> 4;
    int nt = K * EB / (BK * 2); if constexpr (EB == 1) asm volatile("" : "+s"(nt));
    int sR[2], sC[2];
    unsigned voA[2][2], nvoA[2][2], voffB[2];
#pragma unroll
    for (int i = 0; i < 2; ++i) { int R, C; stage_rc(tid * 16 + i * 8192, R, C); sR[i] = R; sC[i] = C; const int Rb = Epi::PERM ? ((R & ~31) + perm32(R & 31)) : R;
        voffB[i] = (unsigned)(Rb * ldb * EB + C * 2);
#pragma unroll
        for (int h = 0; h < 2; ++h) { voA[h][i] = (unsigned)((R + h * HALF) * lda * EB + C * 2); nvoA[h][i] = voA[h][i]; } }
    const size_t kstep = (size_t)(BK * 2);
    const size_t hstepB = (size_t)HALF * ldb * EB;
    const unsigned ldsw = (unsigned)wid * 1024u;
    const int aoff = lds_byte(wr * 64 + fr, fq * 8), boff = lds_byte(wc * 32 + fr, fq * 8);
#define PG8_SA(b, h) (((b) * 2 + (h)) * HTB)
#define PG8_SB(b, h) ((4 + (b) * 2 + (h)) * HTB)
#define PG8_STAGEB(bufoff, gbase) do { _Pragma("unroll") for (int _i = 0; _i < 2; ++_i) \
        __builtin_amdgcn_global_load_lds((const unsigned*)((const char*)(gbase) + voffB[_i]), (PG8_LAS unsigned*)(lds + (bufoff) + ldsw + _i * 8192), 16, 0, 0); } while (0)
#define PG8_STAGEA(bufoff, gbase, h, nx) do { _Pragma("unroll") for (int _i = 0; _i < 2; ++_i) { const unsigned _vo = (GATHER && (nx)) ? nvoA[h][_i] : voA[h][_i]; \
        __builtin_amdgcn_global_load_lds((const unsigned*)((const char*)(gbase) + _vo), (PG8_LAS unsigned*)(lds + (bufoff) + ldsw + _i * 8192), 16, 0, 0); } } while (0)
#define PG8_LDA(dst, b, h) do { _Pragma("unroll") for (int m = 0; m < 4; ++m) _Pragma("unroll") for (int k = 0; k < 2; ++k) dst[m][k] = *(const PG8_LAS bf16x8*)(lds + PG8_SA(b, h) + aoff + m * 2048 + k * 1024); } while (0)
#define PG8_LDB(dst, b, h) do { _Pragma("unroll") for (int n = 0; n < 2; ++n) _Pragma("unroll") for (int k = 0; k < 2; ++k) dst[n][k] = *(const PG8_LAS bf16x8*)(lds + PG8_SB(b, h) + boff + n * 2048 + k * 1024); } while (0)
#define PG8_MMAF(F8, ai, bj, At, Bt) do { __builtin_amdgcn_s_setprio(1); if constexpr (F8 && I8) { _Pragma("unroll") for (int m = 0; m < 4; ++m) _Pragma("unroll") for (int n = 0; n < 2; ++n) { _Pragma("unroll") for (int k = 0; k < 2; ++k) \
            acc[ai][bj][m][n] = __builtin_bit_cast(f32x4, __builtin_amdgcn_mfma_i32_16x16x64_i8(__builtin_bit_cast(i32x4, Bt[n][k]), __builtin_bit_cast(i32x4, At[m][k]), __builtin_bit_cast(i32x4, acc[ai][bj][m][n]), 0, 0, 0)); } \
          _Pragma("unroll") for (int m = 0; m < 4; ++m) _Pragma("unroll") for (int n = 0; n < 2; ++n) asm volatile("" : "+v"(acc[ai][bj][m][n])); } \
      else if constexpr (F8) { _Pragma("unroll") for (int m = 0; m < 4; ++m) _Pragma("unroll") for (int n = 0; n < 2; ++n) { i32x8 _a, _b; \
            { const i32x4 _b0 = __builtin_bit_cast(i32x4, Bt[n][0]), _b1 = __builtin_bit_cast(i32x4, Bt[n][1]), _a0 = __builtin_bit_cast(i32x4, At[m][0]), _a1 = __builtin_bit_cast(i32x4, At[m][1]); \
              _b = (i32x8){_b0[0], _b0[1], _b0[2], _b0[3], _b1[0], _b1[1], _b1[2], _b1[3]}; _a = (i32x8){_a0[0], _a0[1], _a0[2], _a0[3], _a1[0], _a1[1], _a1[2], _a1[3]}; } \
            acc[ai][bj][m][n] = __builtin_amdgcn_mfma_scale_f32_16x16x128_f8f6f4(_b, _a, acc[ai][bj][m][n], 0, 0, 0, MIXED ? MIXED_SB : 0x7f7f7f7f, 0, MIXED ? MIXED_SA : 0x7f7f7f7f); } \
          _Pragma("unroll") for (int m = 0; m < 4; ++m) _Pragma("unroll") for (int n = 0; n < 2; ++n) asm volatile("" : "+v"(acc[ai][bj][m][n])); }     \
        else { _Pragma("unroll") for (int m = 0; m < 4; ++m) _Pragma("unroll") for (int n = 0; n < 2; ++n) { _Pragma("unroll") for (int k = 0; k < 2; ++k) acc[ai][bj][m][n] = __builtin_amdgcn_mfma_f32_16x16x32_bf16(Bt[n][k], At[m][k], acc[ai][bj][m][n], 0, 0, 0); } } \
        __builtin_amdgcn_s_setprio(0); } while (0)
#define PG8_KLOOP(F8, NTU) \
        for (int t = 0; t < (NTU); t += 2) { \
            const bool last = (t == (NTU) - 2); \
            const char* a1 = cA + (size_t)(t + 1) * kstep; \
            const char* a2 = last ? nA : cA + (size_t)(t + 2) * kstep; const char* b2 = last ? nB : cB + (size_t)(t + 2) * kstep; \
            const char* a3 = a2 + kstep; const char* b3 = b2 + kstep; \
            PG8_LDB(B0, 0, 0); PG8_LDB(B1, 0, 1); PG8_SCHED; PG8_LDA(At, 0, 0); PG8_STAGEA(PG8_SA(1, 1), a1, 1, false); \
            PG8_WAIT_V(8); PG8_WAIT_L(0); PG8_BAR; PG8_MMAF(F8, 0, 0, At, B0); PG8_MMAF(F8, 0, 1, At, B1); PG8_BAR; PG8_SCHED; \
            PG8_LDA(At, 0, 1); PG8_STAGEB(PG8_SB(0, 0), b2); PG8_STAGEB(PG8_SB(0, 1), b2 + hstepB); PG8_STAGEA(PG8_SA(0, 0), a2, 0, last); \
            PG8_WAIT_V(8); PG8_WAIT_L(0); PG8_BAR; PG8_MMAF(F8, 1, 0, At, B0); PG8_MMAF(F8, 1, 1, At, B1); PG8_BAR; PG8_SCHED; \
            PG8_LDB(B0, 1, 0); PG8_LDB(B1, 1, 1); PG8_SCHED; PG8_LDA(At, 1, 0); PG8_STAGEA(PG8_SA(0, 1), a2, 1, last); \
            PG8_WAIT_V(8); PG8_WAIT_L(0); PG8_BAR; PG8_MMAF(F8, 0, 0, At, B0); PG8_MMAF(F8, 0, 1, At, B1); PG8_BAR; PG8_SCHED; \
            PG8_LDA(At, 1, 1); PG8_STAGEB(PG8_SB(1, 0), b3); PG8_STAGEB(PG8_SB(1, 1), b3 + hstepB); PG8_STAGEA(PG8_SA(1, 0), a3, 0, last); \
            PG8_WAIT_V(8); PG8_WAIT_L(0); PG8_BAR; PG8_MMAF(F8, 1, 0, At, B0); PG8_MMAF(F8, 1, 1, At, B1); PG8_BAR; PG8_SCHED; \
        }
#define PG8_WAIT_V(n) asm volatile("s_waitcnt vmcnt(" #n ")" ::: "memory")
#define PG8_WAIT_L(n) asm volatile("s_waitcnt lgkmcnt(" #n ")" ::: "memory")
#define PG8_BAR __builtin_amdgcn_s_barrier()
#define PG8_SCHED __builtin_amdgcn_sched_barrier(0)
#define PG8_GATHER_OFFS(dst, unit) do { if constexpr (GATHER) { _Pragma("unroll") for (int _i = 0; _i < 2; ++_i) _Pragma("unroll") for (int _h = 0; _h < 2; ++_h) \
        dst[_h][_i] = (unsigned)(S.arow(unit, sR[_i] + _h * HALF) * lda * EB + sC[_i] * 2); } } while (0)
    Unit cur, nxt; int ui = 0;
    if (!S.next(0, cur)) return;
    f32x4 acc[2][2][4][2];
#pragma unroll
    for (int a = 0; a < 2; ++a)
#pragma unroll
        for (int b = 0; b < 2; ++b)
#pragma unroll
            for (int m = 0; m < 4; ++m)
#pragma unroll
                for (int n = 0; n < 2; ++n) acc[a][b][m][n] = (f32x4){0.f, 0.f, 0.f, 0.f};
    bf16x8 At[4][2], B0[2][2], B1[2][2];
    const char* cA = S.A(cur); const char* cB = S.B(cur);
    PG8_GATHER_OFFS(voA, cur);
    PG8_STAGEB(PG8_SB(0, 0), cB); PG8_STAGEB(PG8_SB(0, 1), cB + hstepB); PG8_STAGEA(PG8_SA(0, 0), cA, 0, false); PG8_STAGEA(PG8_SA(0, 1), cA, 1, false);
    if (wr == 1) PG8_BAR;
    PG8_WAIT_V(2); PG8_BAR;
    PG8_STAGEB(PG8_SB(1, 0), cB + kstep); PG8_STAGEA(PG8_SA(1, 0), cA + kstep, 0, false); PG8_STAGEB(PG8_SB(1, 1), cB + hstepB + kstep);
    PG8_WAIT_V(6); PG8_BAR;
    if constexpr (MIXED) {
      for (;;) {
        { const bool has_next = S.next(ui + 1, nxt); const char* nA = has_next ? S.A(nxt) : cA; const char* nB = has_next ? S.B(nxt) : cB;
          PG8_KLOOP(false, nt)
          if (wr == 0) PG8_BAR;
          { int le = lane; asm volatile("" : "+v"(le)); E.mid(acc, cur, wr, wc, le & 15, le >> 4); }
          cur = nxt; cA = nA; cB = nB; ++ui;
          if (wr == 1) PG8_BAR; }
        { const bool has_next = S.next(ui + 1, nxt); const char* nA = has_next ? S.A(nxt) : cA; const char* nB = has_next ? S.B(nxt) : cB;
          int nth = nt >> 1; asm volatile("" : "+s"(nth));
          PG8_KLOOP(true, nth)
          if (wr == 0) PG8_BAR;
          { int le = lane; asm volatile("" : "+v"(le)); E(acc, cur, wr, wc, le & 15, le >> 4); }
          if (!has_next) break;
#pragma unroll
          for (int a = 0; a < 2; ++a)
#pragma unroll
            for (int b = 0; b < 2; ++b)
#pragma unroll
                for (int m = 0; m < 4; ++m)
#pragma unroll
                    for (int n = 0; n < 2; ++n) acc[a][b][m][n] = (f32x4){0.f, 0.f, 0.f, 0.f};
          cur = nxt; cA = nA; cB = nB; ++ui;
          if (wr == 1) PG8_BAR; }
      }
    } else
    for (;;) {
        const bool has_next = S.next(ui + 1, nxt);
        const char* nA = has_next ? S.A(nxt) : cA; const char* nB = has_next ? S.B(nxt) : cB;
        if constexpr (GATHER) { if (has_next) { PG8_GATHER_OFFS(nvoA, nxt); } else {
#pragma unroll
            for (int i = 0; i < 2; ++i)
#pragma unroll
                for (int h = 0; h < 2; ++h) nvoA[h][i] = voA[h][i]; } }
        PG8_KLOOP(EB == 1, nt)
        if constexpr (ALIGN_EPI) { if (wr == 0) PG8_BAR; }
        const bool chained = CHAIN && cur.z == 0;
        { int le = lane; asm volatile("" : "+v"(le));
          if (!skip_epi) { if constexpr (CHAIN) { if (chained) E.mid(acc, cur, wr, wc, le & 15, le >> 4); else E(acc, cur, wr, wc, le & 15, le >> 4); } else E(acc, cur, wr, wc, le & 15, le >> 4); }
          else { _Pragma("unroll") for (int a = 0; a < 2; ++a) _Pragma("unroll") for (int b = 0; b < 2; ++b) _Pragma("unroll") for (int m = 0; m < 4; ++m) _Pragma("unroll") for (int n = 0; n < 2; ++n) asm volatile("" :: "v"(acc[a][b][m][n])); } }
        if (!has_next) break;
        if (!chained) {
#pragma unroll
        for (int a = 0; a < 2; ++a)
#pragma unroll
            for (int b = 0; b < 2; ++b)
#pragma unroll
                for (int m = 0; m < 4; ++m)
#pragma unroll
                    for (int n = 0; n < 2; ++n) acc[a][b][m][n] = (f32x4){0.f, 0.f, 0.f, 0.f};
        }
        cur = nxt; cA = nA; cB = nB; ++ui;
        if constexpr (GATHER) {
#pragma unroll
            for (int i = 0; i < 2; ++i)
#pragma unroll
                for (int h = 0; h < 2; ++h) voA[h][i] = nvoA[h][i]; }
        if constexpr (ALIGN_EPI) { if (wr == 1) PG8_BAR; }
    }
    PG8_WAIT_V(0);
    if constexpr (!ALIGN_EPI) { if (wr == 0) PG8_BAR; }
    PG8_BAR;
#undef PG8_SA
#undef PG8_SB
#undef PG8_STAGEA
#undef PG8_STAGEB
#undef PG8_LDA
#undef PG8_LDB
#undef PG8_MMAF
#undef PG8_KLOOP
#undef PG8_WAIT_V
#undef PG8_WAIT_L
#undef PG8_BAR
#undef PG8_SCHED
#undef PG8_GATHER_OFFS
}
}
namespace att {
using bf16x8 = __attribute__((ext_vector_type(8))) short;
using s16x4  = __attribute__((ext_vector_type(4))) short;
using f32x16 = __attribute__((ext_vector_type(16))) float;
using u32x4  = __attribute__((ext_vector_type(4))) unsigned;
typedef unsigned short bf16_t;
constexpr int NW = 8, QBLK = 32, KVBLK = 64, DV = 128;
constexpr float THR2 = 8.f * 1.4426950408889634f;
#define ATT_SBAR() __builtin_amdgcn_sched_barrier(0)
#ifndef ATT_QKT_SB
#define ATT_QKT_SB 0
#endif
__device__ __forceinline__ int crow(int r, int hi) { return (r & 3) + 8 * (r >> 2) + 4 * hi; }
__device__ __forceinline__ unsigned cvtpk(float lo, float hi) { return pg8::cvt_pk_bf16(lo, hi); }

template <int DQK> __device__ __forceinline__ int kswz(int row, int chunk) {
    if constexpr (DQK == 128) return row * 256 + ((chunk ^ (row & 7)) << 4);
    else return row * (2 * DQK) + ((chunk ^ ((row >> 1) & 7)) << 4);
}
constexpr size_t SHM_V = KVBLK * DV * 2;
template <int DQK> constexpr size_t shm_k() { return (size_t)KVBLK * DQK * 2; }
template <int DQK> constexpr size_t shm_bytes() { return 2 * SHM_V + 2 * shm_k<DQK>() + NW * 64 * 4; }

__device__ __forceinline__ void partialSM(f32x16& p0, f32x16& p1, float& m_reg, float& mn, float& alpha) {
    float pmax = p0[0];
#pragma unroll
    for (int r = 1; r < 16; ++r) pmax = fmaxf(pmax, p0[r]);
#pragma unroll
    for (int r = 0; r < 16; ++r) pmax = fmaxf(pmax, p1[r]);
    { auto rr = __builtin_amdgcn_permlane32_swap(__float_as_uint(pmax), __float_as_uint(pmax), false, false);
      pmax = fmaxf(__uint_as_float(rr[0]), __uint_as_float(rr[1])); }
    if (__builtin_expect(__all(pmax - m_reg <= THR2), 1)) { mn = m_reg; alpha = 1.f; }
    else { mn = fmaxf(m_reg, pmax); alpha = __builtin_amdgcn_exp2f(m_reg - mn); m_reg = mn; }
#pragma unroll
    for (int r = 0; r < 16; ++r) p0[r] = p0[r] - mn;
#pragma unroll
    for (int r = 0; r < 16; ++r) p1[r] = p1[r] - mn;
#pragma unroll
    for (int r = 0; r < 16; ++r) p0[r] = __builtin_amdgcn_exp2f(p0[r]);
}
__device__ __forceinline__ void finishSM(f32x16& p0, f32x16& p1, float alpha, float& l_reg, bf16x8& pa0, bf16x8& pa1, bf16x8& pa2, bf16x8& pa3) {
#pragma unroll
    for (int r = 0; r < 16; ++r) p1[r] = __builtin_amdgcn_exp2f(p1[r]);
    float ps = 0;
#pragma unroll
    for (int r = 0; r < 16; ++r) ps += p0[r];
#pragma unroll
    for (int r = 0; r < 16; ++r) ps += p1[r];
    { auto rr = __builtin_amdgcn_permlane32_swap(__float_as_uint(ps), __float_as_uint(ps), false, false);
      ps = __uint_as_float(rr[0]) + __uint_as_float(rr[1]); }
    l_reg = l_reg * alpha + ps;
#define ATT_PK4(P, BASE, OUT) do { unsigned a0 = cvtpk(P[BASE + 0], P[BASE + 1]), a1 = cvtpk(P[BASE + 2], P[BASE + 3]);   \
    unsigned b0 = cvtpk(P[BASE + 4], P[BASE + 5]), b1 = cvtpk(P[BASE + 6], P[BASE + 7]);                              \
    auto r0 = __builtin_amdgcn_permlane32_swap(a0, b0, false, false); auto r1 = __builtin_amdgcn_permlane32_swap(a1, b1, false, false); \
    u32x4 w = {r0[0], r1[0], r0[1], r1[1]}; OUT = *reinterpret_cast<bf16x8*>(&w); } while (0)
    ATT_PK4(p0, 0, pa0); ATT_PK4(p0, 8, pa1); ATT_PK4(p1, 0, pa2); ATT_PK4(p1, 8, pa3);
#undef ATT_PK4
}
#define ATT_LAS __attribute__((address_space(3)))
template <int DQK, int NQR> __device__ __forceinline__ void qkt(f32x16& p0, f32x16& p1, const unsigned (&kb)[4], const int bufoff, const bf16x8* qr, const unsigned (&qlds)[4]) {
    p0 = f32x16{}; p1 = f32x16{};
#pragma unroll
    for (int d0 = 0; d0 < DQK / 16; ++d0) {
        const bf16x8 b0 = *(const ATT_LAS bf16x8*)(uintptr_t)(kb[d0 & 3] + (unsigned)(bufoff + 128 * (d0 >> 2)));
        const bf16x8 b1 = *(const ATT_LAS bf16x8*)(uintptr_t)(kb[d0 & 3] + (unsigned)(bufoff + 128 * (d0 >> 2) + 32 * 2 * DQK));
        bf16x8 q;
        if constexpr (NQR < DQK / 16) { if (d0 < NQR) q = qr[d0 < NQR ? d0 : 0]; else q = *(const ATT_LAS bf16x8*)(uintptr_t)qlds[(d0 - NQR) & 3]; }
        else q = qr[d0];
        p0 = __builtin_amdgcn_mfma_f32_32x32x16_bf16(b0, q, p0, 0, 0, 0);
        p1 = __builtin_amdgcn_mfma_f32_32x32x16_bf16(b1, q, p1, 0, 0, 0); }
}
__device__ __forceinline__ int v_st(int k, int c) { const int kk = (k & ~0xC) | ((k & 4) << 1) | ((k & 8) >> 1); return ((kk >> 3) * 4 + (c >> 5)) * 512 + ((kk & 7) * 32 + (c & 31)) * 2; }
__device__ __forceinline__ int v_rd_base(int lane) { return ((lane & 3) << 3) | (((lane >> 2) & 3) << 6) | (((lane >> 4) & 1) << 5) | (((lane >> 5) & 1) << 8); }
constexpr int v_rd_off(int d0, int ks, int half) { return d0 * 512 + ks * 4096 + half * 2048; }
template <int OFF> __device__ __forceinline__ s16x4 tr_read(int vb) {
    s16x4 r; asm volatile("ds_read_b64_tr_b16 %0, %1 offset:%2" : "=&v"(r) : "v"(vb), "i"(OFF) : "memory"); return r;
}
template <int D0> __device__ __forceinline__ void pv_one(f32x16& od, int vb, bf16x8 pa0, bf16x8 pa1, bf16x8 pa2, bf16x8 pa3) {
    const s16x4 l0 = tr_read<v_rd_off(D0, 0, 0)>(vb), h0 = tr_read<v_rd_off(D0, 0, 1)>(vb), l1 = tr_read<v_rd_off(D0, 1, 0)>(vb), h1 = tr_read<v_rd_off(D0, 1, 1)>(vb);
    const s16x4 l2 = tr_read<v_rd_off(D0, 2, 0)>(vb), h2 = tr_read<v_rd_off(D0, 2, 1)>(vb), l3 = tr_read<v_rd_off(D0, 3, 0)>(vb), h3 = tr_read<v_rd_off(D0, 3, 1)>(vb);
    asm volatile("s_waitcnt lgkmcnt(0)" ::: "memory"); ATT_SBAR();
#define ATT_PK(L, H) (bf16x8){L[0], L[1], L[2], L[3], H[0], H[1], H[2], H[3]}
    od = __builtin_amdgcn_mfma_f32_32x32x16_bf16(pa0, ATT_PK(l0, h0), od, 0, 0, 0);
    od = __builtin_amdgcn_mfma_f32_32x32x16_bf16(pa1, ATT_PK(l1, h1), od, 0, 0, 0);
    od = __builtin_amdgcn_mfma_f32_32x32x16_bf16(pa2, ATT_PK(l2, h2), od, 0, 0, 0);
    od = __builtin_amdgcn_mfma_f32_32x32x16_bf16(pa3, ATT_PK(l3, h3), od, 0, 0, 0);
#undef ATT_PK
}
struct VFrag { s16x4 l0, h0, l1, h1, l2, h2, l3, h3; };
template <int D0> __device__ __forceinline__ void v_rd(VFrag& f, int vb) {
    f.l0 = tr_read<v_rd_off(D0, 0, 0)>(vb); f.h0 = tr_read<v_rd_off(D0, 0, 1)>(vb); f.l1 = tr_read<v_rd_off(D0, 1, 0)>(vb); f.h1 = tr_read<v_rd_off(D0, 1, 1)>(vb);
    f.l2 = tr_read<v_rd_off(D0, 2, 0)>(vb); f.h2 = tr_read<v_rd_off(D0, 2, 1)>(vb); f.l3 = tr_read<v_rd_off(D0, 3, 0)>(vb); f.h3 = tr_read<v_rd_off(D0, 3, 1)>(vb);
}
__device__ __forceinline__ void pv_mm(f32x16& od, const VFrag& f, bf16x8 pa0, bf16x8 pa1, bf16x8 pa2, bf16x8 pa3) {
#define ATT_PK(L, H) (bf16x8){L[0], L[1], L[2], L[3], H[0], H[1], H[2], H[3]}
    od = __builtin_amdgcn_mfma_f32_32x32x16_bf16(pa0, ATT_PK(f.l0, f.h0), od, 0, 0, 0);
    od = __builtin_amdgcn_mfma_f32_32x32x16_bf16(pa1, ATT_PK(f.l1, f.h1), od, 0, 0, 0);
    od = __builtin_amdgcn_mfma_f32_32x32x16_bf16(pa2, ATT_PK(f.l2, f.h2), od, 0, 0, 0);
    od = __builtin_amdgcn_mfma_f32_32x32x16_bf16(pa3, ATT_PK(f.l3, f.h3), od, 0, 0, 0);
#undef ATT_PK
}
__device__ __forceinline__ void pv_d0(f32x16* o, int vb, bf16x8 pa0, bf16x8 pa1, bf16x8 pa2, bf16x8 pa3) {
    VFrag A, B;
    v_rd<0>(A, vb);
    v_rd<1>(B, vb); asm volatile("s_waitcnt lgkmcnt(8)" ::: "memory"); ATT_SBAR(); pv_mm(o[0], A, pa0, pa1, pa2, pa3); ATT_SBAR();
    v_rd<2>(A, vb); asm volatile("s_waitcnt lgkmcnt(8)" ::: "memory"); ATT_SBAR(); pv_mm(o[1], B, pa0, pa1, pa2, pa3); ATT_SBAR();
    v_rd<3>(B, vb); asm volatile("s_waitcnt lgkmcnt(8)" ::: "memory"); ATT_SBAR(); pv_mm(o[2], A, pa0, pa1, pa2, pa3); ATT_SBAR();
    asm volatile("s_waitcnt lgkmcnt(0)" ::: "memory"); ATT_SBAR(); pv_mm(o[3], B, pa0, pa1, pa2, pa3);
}

template <int DQK, int SDEPTH>
__device__ __forceinline__ void attn_core(const bf16_t* __restrict__ Qb, int ldq, const bf16_t* __restrict__ Kh, int ldk, const bf16_t* __restrict__ Vh, int ldv, int seq, char* lds, f32x16 (&o)[4], const int tid, const bf16_t* __restrict__ Kpe = nullptr) {
    constexpr int NP = DQK / 64, CPR = DQK / 8;
    constexpr size_t SHM_K = shm_k<DQK>();
    const int wid = tid >> 6, lane = tid & 63, r32 = lane & 31, hi = lane >> 5;
    char* V_lds = lds; char* K_lds = lds + 2 * SHM_V;
    float* ws = (float*)(lds + 2 * SHM_V + 2 * SHM_K) + wid * 64; float* li_l = ws; float* al_l = ws + 32;
    if (__builtin_amdgcn_readfirstlane(wid) >= 4) __builtin_amdgcn_s_setprio(1);
    float m_reg, l_reg = 0; asm volatile("v_mov_b32 %0, 0xf149f2ca" : "=v"(m_reg));
#pragma unroll
    for (int d = 0; d < 4; ++d) o[d] = f32x16{};
    constexpr int NQR = (DQK == 192) ? 8 : DQK / 16;
    bf16x8 qr[NQR]; unsigned qlds[4] = {0u, 0u, 0u, 0u};
    const bf16_t* Qw = Qb + (long)(wid * QBLK + r32) * ldq + hi * 8;
#pragma unroll
    for (int d0 = 0; d0 < NQR; ++d0) qr[d0] = *reinterpret_cast<const bf16x8*>(Qw + d0 * 16);
    if constexpr (NQR < DQK / 16) {
        const unsigned qbase = (unsigned)(uintptr_t)(lds + 2 * SHM_V + 2 * SHM_K + NW * 64 * 4) + (unsigned)(wid * 4096 + r32 * 128);
#pragma unroll
        for (int j = 0; j < 4; ++j) { qlds[j] = qbase + (unsigned)(((2 * j + hi) ^ ((r32 >> 1) & 7)) << 4);
            *(ATT_LAS bf16x8*)(uintptr_t)qlds[j] = *reinterpret_cast<const bf16x8*>(Qw + (NQR + j) * 16); }
    }
    const int sr = tid >> 4, sc = (tid & 15) * 8, vst0 = v_st(sr, sc), vst1 = v_st(32 + sr, sc);
    int krow[NP], kch[NP];
#pragma unroll
    for (int i = 0; i < NP; ++i) {
        if constexpr (DQK == 192) { if (i < 2) { const int p = tid + i * 512; krow[i] = p >> 4; kch[i] = p & 15; } else { krow[i] = tid >> 3; kch[i] = 16 + (tid & 7); } }
        else { const int p = tid + i * 512; krow[i] = p / CPR; kch[i] = p % CPR; } }
    const int vb0 = (int)(uintptr_t)V_lds + v_rd_base(lane);
    unsigned kb[4];
#pragma unroll
    for (int t = 0; t < 4; ++t) kb[t] = (unsigned)(uintptr_t)K_lds + (unsigned)kswz<DQK>(r32, 2 * t + hi);
    struct { bf16x8 vs0, vs1; bf16x8 ks[NP]; } sr_[SDEPTH];
    const unsigned vgo0 = (unsigned)(sr * ldv + sc) * 2u, vgo1 = (unsigned)((32 + sr) * ldv + sc) * 2u; unsigned kgo[NP];
#pragma unroll
    for (int i = 0; i < NP; ++i) kgo[i] = (DQK == 192 && i == 2) ? (unsigned)(krow[i] * 64 + (kch[i] - 16) * 8) * 2u : (unsigned)(krow[i] * ldk + kch[i] * 8) * 2u;
#define ATT_RSRC(P) __builtin_amdgcn_make_buffer_rsrc((void*)(uintptr_t)(((unsigned long long)(unsigned)__builtin_amdgcn_readfirstlane((unsigned)((unsigned long long)(uintptr_t)(P) >> 32)) << 32) | (unsigned long long)(unsigned)__builtin_amdgcn_readfirstlane((unsigned)(unsigned long long)(uintptr_t)(P))), 0, 0x7fffffff, 0x00027000)
    const __amdgpu_buffer_rsrc_t rK = ATT_RSRC(Kh), rV = ATT_RSRC(Vh), rP = ATT_RSRC(DQK == 192 ? Kpe : Kh);
#define ATT_BL(R, VO, SO_) __builtin_bit_cast(bf16x8, __builtin_amdgcn_raw_buffer_load_b128(R, VO, SO_, 0))
#define ATT_SLOAD(i, k0) do { const int vso_ = (k0) * ldv * 2, kso_ = (k0) * ldk * 2; sr_[i].vs0 = ATT_BL(rV, vgo0, vso_); sr_[i].vs1 = ATT_BL(rV, vgo1, vso_); \
    _Pragma("unroll") for (int _p = 0; _p < NP; ++_p) { if (DQK == 192 && _p == 2) sr_[i].ks[_p] = ATT_BL(rP, kgo[_p], (k0) * 128); else sr_[i].ks[_p] = ATT_BL(rK, kgo[_p], kso_); } } while (0)
#define ATT_SWRITE(b, i) do { *(bf16x8*)(V_lds + (b) * SHM_V + vst0) = sr_[i].vs0; *(bf16x8*)(V_lds + (b) * SHM_V + vst1) = sr_[i].vs1; \
    _Pragma("unroll") for (int _p = 0; _p < NP; ++_p) *(bf16x8*)(K_lds + (b) * SHM_K + kswz<DQK>(krow[_p], kch[_p])) = sr_[i].ks[_p]; } while (0)
#define ATT_SWAIT() do { if constexpr (SDEPTH == 2) asm volatile("s_waitcnt vmcnt(%0)" :: "n"(2 + NP) : "memory"); else asm volatile("s_waitcnt vmcnt(0)" ::: "memory"); } while (0)
#define ATT_RESC(a) do { if (__any((a) < 1.f)) { if (hi == 0) al_l[r32] = (a); asm volatile("s_waitcnt lgkmcnt(0)" ::: "memory"); \
    _Pragma("unroll") for (int d = 0; d < 4; ++d) _Pragma("unroll") for (int r = 0; r < 16; ++r) o[d][r] *= al_l[crow(r, hi)]; } } while (0)
    f32x16 pA0, pA1, pB0, pB1; float mnA, mnB, alA, alB; bf16x8 pa0, pa1, pa2, pa3; const int NT = seq / KVBLK;
    constexpr int SE = 0, SO = SDEPTH - 1;
    ATT_SLOAD(SE, 0); asm volatile("s_waitcnt vmcnt(0)" ::: "memory"); ATT_SWRITE(0, SE); __syncthreads();
    qkt<DQK, NQR>(pA0, pA1, kb, 0, qr, qlds); partialSM(pA0, pA1, m_reg, mnA, alA);
    ATT_SLOAD(SO, KVBLK); if constexpr (SDEPTH == 2) { if (2 < NT) ATT_SLOAD(SE, 2 * KVBLK); }
    ATT_SWAIT(); ATT_SWRITE(1, SO); __syncthreads();
    for (int j = 1; j + 1 < NT; j += 2) {
        ATT_SBAR(); qkt<DQK, NQR>(pB0, pB1, kb, (int)SHM_K, qr, qlds);
        finishSM(pA0, pA1, alA, l_reg, pa0, pa1, pa2, pa3); ATT_SBAR();
        ATT_SLOAD(SO, (j + SDEPTH) * KVBLK); ATT_SBAR();
        pv_d0(o, vb0, pa0, pa1, pa2, pa3); partialSM(pB0, pB1, m_reg, mnB, alB);
        __syncthreads(); ATT_SWAIT(); ATT_SWRITE(0, SE);
        ATT_RESC(alB); __syncthreads();
        ATT_SBAR(); qkt<DQK, NQR>(pA0, pA1, kb, 0, qr, qlds);
        finishSM(pB0, pB1, alB, l_reg, pa0, pa1, pa2, pa3); ATT_SBAR();
        if (SDEPTH == 1 || j + 3 < NT) ATT_SLOAD(SE, (j + 1 + SDEPTH) * KVBLK); ATT_SBAR();
        pv_d0(o, vb0 + (int)SHM_V, pa0, pa1, pa2, pa3); partialSM(pA0, pA1, m_reg, mnA, alA);
        __syncthreads(); ATT_SWAIT(); ATT_SWRITE(1, SO);
        ATT_RESC(alA); __syncthreads();
    }
    ATT_SBAR(); qkt<DQK, NQR>(pB0, pB1, kb, (int)SHM_K, qr, qlds);
    finishSM(pA0, pA1, alA, l_reg, pa0, pa1, pa2, pa3); ATT_SBAR();
    pv_d0(o, vb0, pa0, pa1, pa2, pa3); partialSM(pB0, pB1, m_reg, mnB, alB);
    __syncthreads(); ATT_RESC(alB);
    finishSM(pB0, pB1, alB, l_reg, pa0, pa1, pa2, pa3); ATT_SBAR();
    pv_d0(o, vb0 + (int)SHM_V, pa0, pa1, pa2, pa3);
    if (hi == 0) li_l[r32] = l_reg; asm volatile("s_waitcnt lgkmcnt(0)" ::: "memory");
#pragma unroll
    for (int r = 0; r < 16; ++r) { const float rl = __builtin_amdgcn_rcpf(li_l[crow(r, hi)]);
#pragma unroll
        for (int d0 = 0; d0 < 4; ++d0) o[d0][r] *= rl; }
    __builtin_amdgcn_s_setprio(0);
    __syncthreads();
#undef ATT_SLOAD
#undef ATT_BL
#undef ATT_RSRC
#undef ATT_SWRITE
#undef ATT_SWAIT
#undef ATT_RESC
}
using i32x4a = __attribute__((ext_vector_type(4))) int;
using i32x8a = __attribute__((ext_vector_type(8))) int;
constexpr int MLA8_SHM_K = KVBLK * 256;
template <int NS> __device__ __forceinline__ void qkt8(f32x16& p0, f32x16& p1, const unsigned (&ka)[NS][2], const int bufoff, const i32x8a (&qf)[NS], const int sca, const int scb) {
    p0 = f32x16{}; p1 = f32x16{};
#pragma unroll
    for (int s = 0; s < NS; ++s) {
        const i32x4a a00 = *(const ATT_LAS i32x4a*)(uintptr_t)(ka[s][0] + (unsigned)bufoff), a01 = *(const ATT_LAS i32x4a*)(uintptr_t)(ka[s][1] + (unsigned)bufoff);
        const i32x4a a10 = *(const ATT_LAS i32x4a*)(uintptr_t)(ka[s][0] + (unsigned)(bufoff + 32 * 256)), a11 = *(const ATT_LAS i32x4a*)(uintptr_t)(ka[s][1] + (unsigned)(bufoff + 32 * 256));
        const i32x8a a0 = {a00[0], a00[1], a00[2], a00[3], a01[0], a01[1], a01[2], a01[3]}, a1 = {a10[0], a10[1], a10[2], a10[3], a11[0], a11[1], a11[2], a11[3]};
        p0 = __builtin_amdgcn_mfma_scale_f32_32x32x64_f8f6f4(a0, qf[s], p0, 0, 0, 0, sca, 0, scb);
        p1 = __builtin_amdgcn_mfma_scale_f32_32x32x64_f8f6f4(a1, qf[s], p1, 0, 0, 0, sca, 0, scb); }
}
__device__ __forceinline__ void attn_core_mla8(const unsigned char* __restrict__ Qb8, const unsigned char* __restrict__ Kn8, const unsigned char* __restrict__ Kpe8, const bf16_t* __restrict__ Vh, int ldv, int seq, char* lds, f32x16 (&o)[4], const int tid, const int sca, const int scb) {
    constexpr size_t SHM_K = MLA8_SHM_K;
    const int wid = tid >> 6, lane = tid & 63, r32 = lane & 31, hi = lane >> 5;
    char* V_lds = lds; char* K_lds = lds + 2 * SHM_V;
    float* ws = (float*)(lds + 2 * SHM_V + 2 * SHM_K) + wid * 64; float* li_l = ws; float* al_l = ws + 32;
    float m_reg, l_reg = 0; asm volatile("v_mov_b32 %0, 0xf149f2ca" : "=v"(m_reg));
#pragma unroll
    for (int d = 0; d < 4; ++d) o[d] = f32x16{};
    i32x8a qf[3];
    { const unsigned char* Qw = Qb8 + (long)(wid * QBLK + r32) * 1536 + hi * 32;
#pragma unroll
      for (int s_ = 0; s_ < 3; ++s_) { const i32x4a q0 = *reinterpret_cast<const i32x4a*>(Qw + 64 * s_), q1 = *reinterpret_cast<const i32x4a*>(Qw + 64 * s_ + 16); qf[s_] = (i32x8a){q0[0], q0[1], q0[2], q0[3], q1[0], q1[1], q1[2], q1[3]}; } }
    const int sr = tid >> 4, sc = (tid & 15) * 8, vst0 = v_st(sr, sc), vst1 = v_st(32 + sr, sc);
    const int kr0 = tid >> 3, kc0 = tid & 7, kr1 = (tid & 255) >> 2, kc1 = 8 + (tid & 3);
    const unsigned kw0 = (unsigned)(kr0 * 256 + ((kc0 ^ (kr0 & 15)) << 4)), kw1 = (unsigned)(kr1 * 256 + ((kc1 ^ (kr1 & 15)) << 4));
    const int vb0 = (int)(uintptr_t)V_lds + v_rd_base(lane);
    unsigned ka[3][2];
#pragma unroll
    for (int s_ = 0; s_ < 3; ++s_)
#pragma unroll
        for (int c = 0; c < 2; ++c) ka[s_][c] = (unsigned)(uintptr_t)K_lds + (unsigned)(r32 * 256 + (((4 * s_ + 2 * hi + c) ^ (r32 & 15)) << 4));
    const unsigned vgo0 = (unsigned)(sr * ldv + sc) * 2u, vgo1 = (unsigned)((32 + sr) * ldv + sc) * 2u, kgo0 = (unsigned)(kr0 * 1024 + kc0 * 16), kgo1 = (unsigned)(kr1 * 64 + (kc1 - 8) * 16);
#define ATT_RSRC(P) __builtin_amdgcn_make_buffer_rsrc((void*)(uintptr_t)(((unsigned long long)(unsigned)__builtin_amdgcn_readfirstlane((unsigned)((unsigned long long)(uintptr_t)(P) >> 32)) << 32) | (unsigned long long)(unsigned)__builtin_amdgcn_readfirstlane((unsigned)(unsigned long long)(uintptr_t)(P))), 0, 0x7fffffff, 0x00027000)
    const __amdgpu_buffer_rsrc_t rK = ATT_RSRC(Kn8), rV = ATT_RSRC(Vh), rP = ATT_RSRC(Kpe8);
    struct { bf16x8 vs0, vs1; u32x4 k0, k1; } sr_;
#define M8_SLOAD(kk) do { sr_.vs0 = __builtin_bit_cast(bf16x8, __builtin_amdgcn_raw_buffer_load_b128(rV, vgo0, (kk) * ldv * 2, 0)); sr_.vs1 = __builtin_bit_cast(bf16x8, __builtin_amdgcn_raw_buffer_load_b128(rV, vgo1, (kk) * ldv * 2, 0)); \
    sr_.k0 = __builtin_bit_cast(u32x4, __builtin_amdgcn_raw_buffer_load_b128(rK, kgo0, (kk) * 1024, 0)); sr_.k1 = __builtin_bit_cast(u32x4, __builtin_amdgcn_raw_buffer_load_b128(rP, kgo1, (kk) * 64, 0)); } while (0)
#define M8_SWRITE(b) do { *(bf16x8*)(V_lds + (b) * SHM_V + vst0) = sr_.vs0; *(bf16x8*)(V_lds + (b) * SHM_V + vst1) = sr_.vs1; \
    *(u32x4*)(K_lds + (b) * SHM_K + kw0) = sr_.k0; *(u32x4*)(K_lds + (b) * SHM_K + kw1) = sr_.k1; } while (0)
#define M8_SWAIT() asm volatile("s_waitcnt vmcnt(0)" ::: "memory")
#define M8_RESC(a) do { if (__any((a) < 1.f)) { if (hi == 0) al_l[r32] = (a); asm volatile("s_waitcnt lgkmcnt(0)" ::: "memory"); \
    _Pragma("unroll") for (int d = 0; d < 4; ++d) _Pragma("unroll") for (int r = 0; r < 16; ++r) o[d][r] *= al_l[crow(r, hi)]; } } while (0)
    f32x16 pA0, pA1, pB0, pB1; float mnA, mnB, alA, alB; bf16x8 pa0, pa1, pa2, pa3; const int NT = seq / KVBLK;
    M8_SLOAD(0); asm volatile("s_waitcnt vmcnt(0)" ::: "memory"); M8_SWRITE(0); __syncthreads();
    qkt8<3>(pA0, pA1, ka, 0, qf, sca, scb); partialSM(pA0, pA1, m_reg, mnA, alA);
    M8_SLOAD(KVBLK);
    M8_SWAIT(); M8_SWRITE(1); __syncthreads();
    for (int j = 1; j + 1 < NT; j += 2) {
        ATT_SBAR(); qkt8<3>(pB0, pB1, ka, (int)SHM_K, qf, sca, scb);
        finishSM(pA0, pA1, alA, l_reg, pa0, pa1, pa2, pa3); ATT_SBAR();
        M8_SLOAD((j + 1) * KVBLK); ATT_SBAR();
        pv_d0(o, vb0, pa0, pa1, pa2, pa3); partialSM(pB0, pB1, m_reg, mnB, alB);
        __syncthreads(); M8_SWAIT(); M8_SWRITE(0);
        M8_RESC(alB); __syncthreads();
        ATT_SBAR(); qkt8<3>(pA0, pA1, ka, 0, qf, sca, scb);
        finishSM(pB0, pB1, alB, l_reg, pa0, pa1, pa2, pa3); ATT_SBAR();
        M8_SLOAD((j + 2) * KVBLK); ATT_SBAR();
        pv_d0(o, vb0 + (int)SHM_V, pa0, pa1, pa2, pa3); partialSM(pA0, pA1, m_reg, mnA, alA);
        __syncthreads(); M8_SWAIT(); M8_SWRITE(1);
        M8_RESC(alA); __syncthreads();
    }
    ATT_SBAR(); qkt8<3>(pB0, pB1, ka, (int)SHM_K, qf, sca, scb);
    finishSM(pA0, pA1, alA, l_reg, pa0, pa1, pa2, pa3); ATT_SBAR();
    pv_d0(o, vb0, pa0, pa1, pa2, pa3); partialSM(pB0, pB1, m_reg, mnB, alB);
    __syncthreads(); M8_RESC(alB);
    finishSM(pB0, pB1, alB, l_reg, pa0, pa1, pa2, pa3); ATT_SBAR();
    pv_d0(o, vb0 + (int)SHM_V, pa0, pa1, pa2, pa3);
    if (hi == 0) li_l[r32] = l_reg; asm volatile("s_waitcnt lgkmcnt(0)" ::: "memory");
#pragma unroll
    for (int r = 0; r < 16; ++r) { const float rl = __builtin_amdgcn_rcpf(li_l[crow(r, hi)]);
#pragma unroll
        for (int d0 = 0; d0 < 4; ++d0) o[d0][r] *= rl; }
    __syncthreads();
#undef ATT_RSRC
#undef M8_SLOAD
#undef M8_SWRITE
#undef M8_SWAIT
#undef M8_RESC
}
using u32x2a = __attribute__((ext_vector_type(2))) unsigned;
constexpr int MLA8_SHM_V = KVBLK * 128;
constexpr float THR8 = 2.f;
template <int OFF> __device__ __forceinline__ u32x2a tr8_read(int va) { u32x2a r; asm volatile("ds_read_b64_tr_b8 %0, %1 offset:%2" : "=&v"(r) : "v"(va), "i"(OFF) : "memory"); return r; }
__device__ __forceinline__ unsigned pk4f8(float a, float b, float c, float d) { int w = __builtin_amdgcn_cvt_pk_fp8_f32(a, b, 0, false); w = __builtin_amdgcn_cvt_pk_fp8_f32(c, d, w, true); return (unsigned)w; }
__device__ __forceinline__ void partialSM8(f32x16& p0, f32x16& p1, float& m_reg, float& mn6, float& alpha) {
    float pmax = p0[0];
#pragma unroll
    for (int r = 1; r < 16; ++r) pmax = fmaxf(pmax, p0[r]);
#pragma unroll
    for (int r = 0; r < 16; ++r) pmax = fmaxf(pmax, p1[r]);
    { auto rr = __builtin_amdgcn_permlane32_swap(__float_as_uint(pmax), __float_as_uint(pmax), false, false);
      pmax = fmaxf(__uint_as_float(rr[0]), __uint_as_float(rr[1])); }
    float mn;
    if (__builtin_expect(__all(pmax - m_reg <= THR8), 1)) { mn = m_reg; alpha = 1.f; }
    else { mn = fmaxf(m_reg, pmax); alpha = __builtin_amdgcn_exp2f(m_reg - mn); m_reg = mn; }
    mn6 = mn - 6.f;
#pragma unroll
    for (int r = 0; r < 16; ++r) p0[r] = p0[r] - mn6;
#pragma unroll
    for (int r = 0; r < 16; ++r) p1[r] = p1[r] - mn6;
#pragma unroll
    for (int r = 0; r < 16; ++r) p0[r] = __builtin_amdgcn_exp2f(p0[r]);
}
__device__ __forceinline__ void finishSM8(f32x16& p0, f32x16& p1, float alpha, float& l_reg, i32x8a& pb) {
#pragma unroll
    for (int r = 0; r < 16; ++r) p1[r] = __builtin_amdgcn_exp2f(p1[r]);
    float ps = 0;
#pragma unroll
    for (int r = 0; r < 16; ++r) ps += p0[r];
#pragma unroll
    for (int r = 0; r < 16; ++r) ps += p1[r];
    { auto rr = __builtin_amdgcn_permlane32_swap(__float_as_uint(ps), __float_as_uint(ps), false, false);
      ps = __uint_as_float(rr[0]) + __uint_as_float(rr[1]); }
    l_reg = l_reg * alpha + ps;
#pragma unroll
    for (int w = 0; w < 4; ++w) { pb[w] = (int)pk4f8(p0[4 * w], p0[4 * w + 1], p0[4 * w + 2], p0[4 * w + 3]); pb[4 + w] = (int)pk4f8(p1[4 * w], p1[4 * w + 1], p1[4 * w + 2], p1[4 * w + 3]); }
}
template <int B> __device__ __forceinline__ void pv8(f32x16 (&o)[4], const int (&va)[4], const i32x8a pb, const int scv, const int scp) {
    u32x2a t[4][4];
#pragma unroll
    for (int d0 = 0; d0 < 4; ++d0) { t[d0][0] = tr8_read<B * MLA8_SHM_V + 0>(va[d0]); t[d0][1] = tr8_read<B * MLA8_SHM_V + 2048>(va[d0]); t[d0][2] = tr8_read<B * MLA8_SHM_V + 4096>(va[d0]); t[d0][3] = tr8_read<B * MLA8_SHM_V + 6144>(va[d0]); }
#define PV8_MM(D0) do { const i32x8a a_ = {(int)t[D0][0].x, (int)t[D0][0].y, (int)t[D0][1].x, (int)t[D0][1].y, (int)t[D0][2].x, (int)t[D0][2].y, (int)t[D0][3].x, (int)t[D0][3].y}; \
    o[D0] = __builtin_amdgcn_mfma_scale_f32_32x32x64_f8f6f4(a_, pb, o[D0], 0, 0, 0, scv, 0, scp); } while (0)
    asm volatile("s_waitcnt lgkmcnt(12)" ::: "memory"); ATT_SBAR(); PV8_MM(0); ATT_SBAR();
    asm volatile("s_waitcnt lgkmcnt(8)" ::: "memory"); ATT_SBAR(); PV8_MM(1); ATT_SBAR();
    asm volatile("s_waitcnt lgkmcnt(4)" ::: "memory"); ATT_SBAR(); PV8_MM(2); ATT_SBAR();
    asm volatile("s_waitcnt lgkmcnt(0)" ::: "memory"); ATT_SBAR(); PV8_MM(3);
#undef PV8_MM
}
template <int NS, bool ROPE>
__device__ __forceinline__ void attn_core_f8(const unsigned char* __restrict__ Qb8, const int ldq, const unsigned char* __restrict__ Kn8, const int ldk, const unsigned char* __restrict__ Kpe8, const unsigned char* __restrict__ Vh8, const int ldv, int seq, char* lds, f32x16 (&o)[4], const int tid, const int sca, const int scb, const int scv, const int scp) {
    constexpr size_t SHM_K = MLA8_SHM_K, SHM_V8 = MLA8_SHM_V;
    const int wid = tid >> 6, lane = tid & 63, r32 = lane & 31, hi = lane >> 5;
    if (__builtin_amdgcn_readfirstlane(wid) >= 4) __builtin_amdgcn_s_setprio(1);
    char* V_lds = lds; char* K_lds = lds + 2 * SHM_V8;
    float m_reg, l_reg = 0; asm volatile("v_mov_b32 %0, 0xf149f2ca" : "=v"(m_reg));
#pragma unroll
    for (int d = 0; d < 4; ++d) o[d] = f32x16{};
    i32x8a qf[NS];
    { const unsigned char* Qw = Qb8 + (long)(wid * QBLK + r32) * ldq + hi * 32;
#pragma unroll
      for (int s_ = 0; s_ < NS; ++s_) { const i32x4a q0 = *reinterpret_cast<const i32x4a*>(Qw + 64 * s_), q1 = *reinterpret_cast<const i32x4a*>(Qw + 64 * s_ + 16); qf[s_] = (i32x8a){q0[0], q0[1], q0[2], q0[3], q1[0], q1[1], q1[2], q1[3]}; } }
    const int vk = tid >> 3, vc = tid & 7;
    const unsigned vw = (unsigned)(vk * 128 + ((vc ^ ((((vk >> 1) & 1) << 1) | (((vk >> 3) & 1) << 2))) << 4));
    const int kr0 = tid >> 3, kc0 = tid & 7, kr1 = (tid & 255) >> 2, kc1 = 8 + (tid & 3);
    const unsigned kw0 = (unsigned)(kr0 * 256 + ((kc0 ^ (kr0 & 15)) << 4)), kw1 = (unsigned)(kr1 * 256 + ((kc1 ^ (kr1 & 15)) << 4));
    int va[4];
    { const int li = lane & 15, r = li >> 1, c = li & 1, gi = (lane >> 4) & 1, kl = 8 * (r >> 2) + 4 * hi + (r & 3), g = (((kl >> 1) & 1) << 1) | (((kl >> 3) & 1) << 2);
#pragma unroll
      for (int d0 = 0; d0 < 4; ++d0) va[d0] = (int)(uintptr_t)V_lds + kl * 128 + (((2 * d0 + gi) ^ g) << 4) + 8 * c; }
    unsigned ka[NS][2];
#pragma unroll
    for (int s_ = 0; s_ < NS; ++s_)
#pragma unroll
        for (int c = 0; c < 2; ++c) ka[s_][c] = (unsigned)(uintptr_t)K_lds + (unsigned)(r32 * 256 + (((4 * s_ + 2 * hi + c) ^ (r32 & 15)) << 4));
    const unsigned vgo = (unsigned)(vk * ldv + vc * 16), kgo0 = (unsigned)(kr0 * ldk + kc0 * 16), kgo1 = (unsigned)(kr1 * 64 + (kc1 - 8) * 16);
#define ATT_RSRC(P) __builtin_amdgcn_make_buffer_rsrc((void*)(uintptr_t)(((unsigned long long)(unsigned)__builtin_amdgcn_readfirstlane((unsigned)((unsigned long long)(uintptr_t)(P) >> 32)) << 32) | (unsigned long long)(unsigned)__builtin_amdgcn_readfirstlane((unsigned)(unsigned long long)(uintptr_t)(P))), 0, 0x7fffffff, 0x00027000)
    const __amdgpu_buffer_rsrc_t rK = ATT_RSRC(Kn8), rV = ATT_RSRC(Vh8), rP = ATT_RSRC(ROPE ? Kpe8 : Kn8);
    struct { u32x4 v, k0, k1; } sr_;
#define M8_SLOAD(kk) do { sr_.v = __builtin_bit_cast(u32x4, __builtin_amdgcn_raw_buffer_load_b128(rV, vgo, (kk) * ldv, 0)); \
    sr_.k0 = __builtin_bit_cast(u32x4, __builtin_amdgcn_raw_buffer_load_b128(rK, kgo0, (kk) * ldk, 0)); if constexpr (ROPE) sr_.k1 = __builtin_bit_cast(u32x4, __builtin_amdgcn_raw_buffer_load_b128(rP, kgo1, (kk) * 64, 0)); } while (0)
#define M8_SWRITE(b) do { *(u32x4*)(V_lds + (b) * SHM_V8 + vw) = sr_.v; *(u32x4*)(K_lds + (b) * SHM_K + kw0) = sr_.k0; if constexpr (ROPE) *(u32x4*)(K_lds + (b) * SHM_K + kw1) = sr_.k1; } while (0)
#define M8_SWAIT() asm volatile("s_waitcnt vmcnt(0)" ::: "memory")
#define M8_RESC(a) do { if (__any((a) < 1.f)) { _Pragma("unroll") for (int d = 0; d < 4; ++d) _Pragma("unroll") for (int r = 0; r < 16; ++r) o[d][r] *= (a); } } while (0)
    f32x16 pA0, pA1, pB0, pB1; float mnA, mnB, alA, alB; i32x8a pb; const int NT = seq / KVBLK;
    M8_SLOAD(0); asm volatile("s_waitcnt vmcnt(0)" ::: "memory"); M8_SWRITE(0); __syncthreads();
    qkt8<NS>(pA0, pA1, ka, 0, qf, sca, scb); partialSM8(pA0, pA1, m_reg, mnA, alA);
    M8_SLOAD(KVBLK);
    M8_SWAIT(); M8_SWRITE(1); __syncthreads();
    for (int j = 1; j + 1 < NT; j += 2) {
        ATT_SBAR(); qkt8<NS>(pB0, pB1, ka, (int)SHM_K, qf, sca, scb);
        finishSM8(pA0, pA1, alA, l_reg, pb); ATT_SBAR();
        M8_SLOAD((j + 1) * KVBLK); ATT_SBAR();
        pv8<0>(o, va, pb, scv, scp); partialSM8(pB0, pB1, m_reg, mnB, alB);
        __syncthreads(); M8_SWAIT(); M8_SWRITE(0);
        M8_RESC(alB); __syncthreads();
        ATT_SBAR(); qkt8<NS>(pA0, pA1, ka, 0, qf, sca, scb);
        finishSM8(pB0, pB1, alB, l_reg, pb); ATT_SBAR();
        M8_SLOAD((j + 2) * KVBLK); ATT_SBAR();
        pv8<1>(o, va, pb, scv, scp); partialSM8(pA0, pA1, m_reg, mnA, alA);
        __syncthreads(); M8_SWAIT(); M8_SWRITE(1);
        M8_RESC(alA); __syncthreads();
    }
    ATT_SBAR(); qkt8<NS>(pB0, pB1, ka, (int)SHM_K, qf, sca, scb);
    finishSM8(pA0, pA1, alA, l_reg, pb); ATT_SBAR();
    pv8<0>(o, va, pb, scv, scp); partialSM8(pB0, pB1, m_reg, mnB, alB);
    __syncthreads(); M8_RESC(alB);
    finishSM8(pB0, pB1, alB, l_reg, pb); ATT_SBAR();
    pv8<1>(o, va, pb, scv, scp);
    { const float rl = 64.f * __builtin_amdgcn_rcpf(l_reg);
#pragma unroll
      for (int d0 = 0; d0 < 4; ++d0)
#pragma unroll
          for (int r = 0; r < 16; ++r) o[d0][r] *= rl; }
    __builtin_amdgcn_s_setprio(0);
    __syncthreads();
#undef ATT_RSRC
#undef M8_SLOAD
#undef M8_SWRITE
#undef M8_SWAIT
#undef M8_RESC
}
}
namespace mk {
using pg8::f32x4; using pg8::u32x4; using pg8::u32x2; using pg8::Unit; using pg8::bf16x8;
typedef unsigned short bf16;
#define GAS __attribute__((address_space(1)))
#define LAS __attribute__((address_space(3)))
typedef GAS unsigned gu32;
#define RLX_AGENT __ATOMIC_RELAXED, __HIP_MEMORY_SCOPE_AGENT
#define LDS_WAIT() asm volatile("s_waitcnt lgkmcnt(0)" ::: "memory")
#define VM_WAIT() asm volatile("s_waitcnt vmcnt(0)" ::: "memory")

constexpr int NWAVES = 8;
constexpr int NTOK = 16384, DM = 2048, SEQ = 2048, NB = 8, MEML = 256;
constexpr int NPROJ = 8192;
constexpr float LOG2E = 1.4426950408889634f;
constexpr float C2D = 0.125f * LOG2E;
constexpr float C2M = 0.07216878364870322f * LOG2E;
constexpr float C2C = 0.08838834764831845f * LOG2E;
constexpr int C_DQ = 0, C_DK = 1024, C_DV = 2048, C_CQ = 3072, C_CKV = 3584, C_KPE = 3840, C_GA = 3904, C_GB = 5952, D_IN = 8000;
constexpr int MOE_MAXT = 160;
constexpr float WIN_SCALE = 64.f, HID_SCALE = 4.f, WD_SCALE = 32.f, WGU_SCALE = 64.f;

constexpr size_t MiB = 1u << 20;
constexpr size_t WS_CTL = 0, CTL_ZERO_BYTES = 1 * MiB;
constexpr float XN_I8 = 24.f, W_I8 = 1024.f;
constexpr float MG_SCALE = 48.f, WOUT_SCALE = 1024.f;
constexpr float Y_SCALE = 16.f;
constexpr float MLA_QS = 32.f, MLA_KS = 8.f;
constexpr int MLA_SCB = 0x7a7a7a7a, MLA_SCA = 0x7c7c7c7c;
constexpr float MLA_VS = 8.f; constexpr int MLA_SCV = 0x7c7c7c7c, MLA_SCP = 0x79797979;
constexpr size_t WS_KPE = 120 * MiB;
constexpr size_t WS_RSTDX = 11 * MiB + 768 * 1024;
constexpr size_t WS_SS_CQ = 11 * MiB, WS_SS_CKV = 11 * MiB + 512 * 1024, WS_SS_H1 = 508 * MiB;
constexpr size_t WS_ROPE_D = 1 * MiB, WS_ROPE_M = 2 * MiB;
constexpr size_t WS_WR_T = 6 * MiB;
constexpr size_t WS_TOKES = 6 * MiB + 512 * 1024, WS_TOKW = WS_TOKES + 128 * 1024, WS_SCAL = WS_TOKW + 128 * 1024;
constexpr size_t WS_LIST = 7 * MiB, WS_LISTR = 9 * MiB;
constexpr size_t WS_WIN_T = 12 * MiB, WS_WOA_T = 44 * MiB, WS_WOB_T = 48 * MiB, WS_WOUT_T = 52 * MiB, WS_WUQ_T = 60 * MiB, WS_WUKV_T = 62 * MiB, WS_WCQ_T = 63 * MiB,
                 WS_WCKV_T = 65 * MiB, WS_WCO_T = 69 * MiB;
constexpr size_t WS_XN = 72 * MiB, WS_QM = 72 * MiB, WS_MG = 72 * MiB;
constexpr size_t WS_QD = 136 * MiB, WS_KD = 168 * MiB, WS_VD = 200 * MiB, WS_CQ = 232 * MiB, WS_CKV = 248 * MiB, WS_SGA = 256 * MiB, WS_SGB = 320 * MiB, WS_KM = 384 * MiB, WS_VM = 432 * MiB,
                 WS_OB = 464 * MiB, WS_MEMN = 496 * MiB, WS_KVC = 504 * MiB, WS_HB = 512 * MiB, WS_QC = 576 * MiB, WS_OC = 592 * MiB;
constexpr size_t WS_WGU_T = 136 * MiB, WS_WD_T = 264 * MiB, WS_HID = 72 * MiB, WS_Y = 328 * MiB, WS_H8 = 200 * MiB, WS_XN8 = 464 * MiB, WS_WIN8 = 576 * MiB, WS_WCQ8 = 592 * MiB, WS_WCKV8 = 593 * MiB, WS_MEMN8 = 596 * MiB, WS_END = 608 * MiB;
constexpr int CW_TMO = 0, CW_CODE = 1, CW_BAR = 4096, CW_CNT = 8192;

constexpr int RING_OFF = 0, RING_BYTES = 131072;
constexpr int LDSCTL_OFF = RING_BYTES, MISC_OFF = LDSCTL_OFF + 320;
constexpr int LDS_BYTES = 147456;

#define XB_TMO      128
#define XB_XCNT(j)  (256  + 64 * (j))
#define XB_XSUB(j)  (1280 + 64 * (j))
#define XB_XGEN(j)  (2304 + 64 * (j))
#define XB_TOP      3328
#define XB_TOPGEN   3392
#define XCD_BAR_WORDS 3456
#define XB_SPIN_CAP (1u << 18)
__device__ __forceinline__ unsigned xb_ld(unsigned* p)              { return __hip_atomic_load(p, __ATOMIC_RELAXED, __HIP_MEMORY_SCOPE_AGENT); }
__device__ __forceinline__ unsigned xb_add(unsigned* p, unsigned v) { return __hip_atomic_fetch_add(p, v, __ATOMIC_RELAXED, __HIP_MEMORY_SCOPE_AGENT); }
__device__ __forceinline__ unsigned xb_xcc_id() { return (unsigned)__builtin_amdgcn_s_getreg((3 << 11) | 20) & 0xFu; }
#define XB_SPIN(cond, bar) do { unsigned _sp = 0; while (cond) { __builtin_amdgcn_s_sleep(1); \
    if ((++_sp & 255u) == 0u) { if (xb_ld(&(bar)[XB_TMO])) break; if (_sp > XB_SPIN_CAP) { atomicAdd(&(bar)[XB_TMO], 1u); break; } } } } while (0)
struct XcdBarrier { unsigned* bar; unsigned x; volatile LAS unsigned* st; };
__device__ __forceinline__ XcdBarrier xcd_barrier_post(unsigned* bar, volatile LAS unsigned* st) {
    XcdBarrier b; b.bar = bar; b.x = xb_xcc_id(); b.st = st;
    if (threadIdx.x == 0) (void)xb_add(&bar[XB_XCNT(b.x)], 1u);
    return b;
}
__device__ __forceinline__ void xcd_barrier_complete(unsigned* bar, unsigned x, unsigned& nloc, unsigned& nx) {
    const unsigned G = gridDim.x * gridDim.y * gridDim.z;
    unsigned sum, cnt, mine, sp = 0u;
    for (;;) {
        sum = 0u; cnt = 0u; mine = 0u;
#pragma unroll
        for (unsigned j = 0; j < 16; ++j) { const unsigned c = xb_ld(&bar[XB_XCNT(j)]); sum += c; cnt += (c > 0u) ? 1u : 0u; mine = (j == x) ? c : mine; }
        if (sum == G) break;
        __builtin_amdgcn_s_sleep(1);
        if ((++sp & 255u) == 0u) { if (xb_ld(&bar[XB_TMO])) break; if (sp > XB_SPIN_CAP) { atomicAdd(&bar[XB_TMO], 1u); break; } }
    }
    nloc = mine > 0u ? mine : 1u; nx = cnt > 0u ? cnt : 1u;
}
__device__ __forceinline__ void xcd_barrier(const XcdBarrier& b, const int tid_) {
    asm volatile("s_waitcnt vmcnt(0)" ::: "memory");
    __syncthreads();
    if (tid_ == 0) {
        unsigned* bar = b.bar;
        __builtin_amdgcn_s_waitcnt(0);
        unsigned nloc = b.st[0], nx = b.st[1];
        if (nloc == 0u) { xcd_barrier_complete(bar, b.x, nloc, nx); b.st[0] = nloc; b.st[1] = nx; }
        const unsigned old = xb_add(&bar[XB_XSUB(b.x)], 1u);
        const unsigned gen = old / nloc;
        if (old + 1u == (gen + 1u) * nloc) {
            __builtin_amdgcn_fence(__ATOMIC_RELEASE, "agent");
            asm volatile("s_waitcnt vmcnt(0)" ::: "memory");
            const unsigned og = xb_add(&bar[XB_TOP], 1u);
            const unsigned tg = og / nx;
            if (og + 1u == (tg + 1u) * nx) xb_add(&bar[XB_TOPGEN], 1u);
            else XB_SPIN(xb_ld(&bar[XB_TOPGEN]) == tg, bar);
            __builtin_amdgcn_fence(__ATOMIC_ACQUIRE, "agent");
            xb_add(&bar[XB_XGEN(b.x)], 1u);
            asm volatile("s_waitcnt vmcnt(0)" ::: "memory");
        } else {
            XB_SPIN(xb_ld(&bar[XB_XGEN(b.x)]) == gen, bar);
            __builtin_amdgcn_fence(__ATOMIC_ACQUIRE, "agent");
            asm volatile("s_waitcnt vmcnt(0)" ::: "memory");
        }
    }
    __syncthreads();
}

struct Args {
    const float *x, *mem; const int* positions; const float *attn_norm_g, *w_in, *lq1, *lk1, *lq2, *lk2, *subln_g, *w_o_diff, *mla_q_norm_g, *w_uq, *mla_kv_norm_g, *w_ukv, *w_o_mla, *w_out,
        *cross_norm_g, *mem_norm_g, *w_cq, *w_ckv, *w_co, *ffn_norm_g, *w_rg, *b_rg, *w_re, *b_re, *w_gate, *w_up, *w_down, *final_norm_g;
    float* out; unsigned char* ws; int ph_lo, ph_hi;
};

__device__ __forceinline__ float wave_sum(float v) {
#pragma unroll
    for (int o = 1; o < 64; o <<= 1) v += __shfl_xor(v, o);
    return v;
}
__device__ __forceinline__ float sigmoidf_fast(float x) { return __builtin_amdgcn_rcpf(1.f + __builtin_amdgcn_exp2f(-x * LOG2E)); }

__device__ __forceinline__ unsigned pack4_u8(float a, float b, float c, float d) { unsigned w = 0u; w = __builtin_amdgcn_cvt_pk_u8_f32(a, 0, w); w = __builtin_amdgcn_cvt_pk_u8_f32(b, 1, w); w = __builtin_amdgcn_cvt_pk_u8_f32(c, 2, w); w = __builtin_amdgcn_cvt_pk_u8_f32(d, 3, w); return w; }
__device__ __forceinline__ unsigned pack4_i8(float a, float b, float c, float d) { return pack4_u8(a + 128.f, b + 128.f, c + 128.f, d + 128.f) ^ 0x80808080u; }
__device__ __forceinline__ f32x4 acc_i2f(const f32x4& a) { return __builtin_convertvector(__builtin_bit_cast(pg8::i32x4, a), f32x4); }
template <bool FP8 = false> __device__ __forceinline__ void transpose_item(const float* W, int ldw, int srccol, const float* gain, int k0, bf16* WT, int ldt, int row0, LAS float* scr, int lane, float wscale = 1.f) {
    float v[32];
    const float* wp = W + (size_t)(k0 + (lane >> 5)) * ldw + (srccol >= 0 ? srccol : 0);
#pragma unroll
    for (int i = 0; i < 32; ++i) v[i] = __builtin_nontemporal_load(wp + (size_t)(2 * i) * ldw);
    if (gain) {
#pragma unroll
        for (int i = 0; i < 32; ++i) v[i] *= gain[k0 + 2 * i + (lane >> 5)]; }
    if (srccol < 0) {
#pragma unroll
        for (int i = 0; i < 32; ++i) v[i] = 0.f; }
#pragma unroll
    for (int i = 0; i < 32; ++i) scr[(2 * i + (lane >> 5)) * 33 + (lane & 31)] = v[i];
    LDS_WAIT(); asm volatile("" ::: "memory");
    const int c = lane & 7;
#pragma unroll
    for (int j = 0; j < 4; ++j) { const int n = (lane >> 3) + 8 * j; const LAS float* s = scr + (8 * c) * 33 + n;
        if constexpr (FP8) { u32x2 o; o.x = pg8::pack4_fp8(s[0 * 33] * wscale, s[1 * 33] * wscale, s[2 * 33] * wscale, s[3 * 33] * wscale); o.y = pg8::pack4_fp8(s[4 * 33] * wscale, s[5 * 33] * wscale, s[6 * 33] * wscale, s[7 * 33] * wscale);
            *(GAS u32x2*)((unsigned char*)WT + (size_t)(row0 + n) * ldt + k0 + 8 * c) = o; }
        else { u32x4 o; o.x = pg8::cvt_pk_bf16(s[0 * 33], s[1 * 33]); o.y = pg8::cvt_pk_bf16(s[2 * 33], s[3 * 33]); o.z = pg8::cvt_pk_bf16(s[4 * 33], s[5 * 33]); o.w = pg8::cvt_pk_bf16(s[6 * 33], s[7 * 33]);
            *(GAS u32x4*)(WT + (size_t)(row0 + n) * ldt + k0 + 8 * c) = o; } }
    LDS_WAIT(); asm volatile("" ::: "memory");
}
struct TItem { const float* wp; const float* gain; unsigned char* dst; int ldw, k0, ldt, fp8; float wscale; bool zero; };
__device__ __forceinline__ void tr_load(const TItem& t, float (&v)[32]) {
#pragma unroll
    for (int i = 0; i < 32; ++i) v[i] = __builtin_nontemporal_load(t.wp + (size_t)(2 * i) * t.ldw);
}
__device__ __forceinline__ void tr_finish(const TItem& t, float (&v)[32], LAS float* scr, int lane) {
    if (t.gain) {
#pragma unroll
        for (int i = 0; i < 32; ++i) v[i] *= t.gain[t.k0 + 2 * i + (lane >> 5)]; }
    if (t.zero) {
#pragma unroll
        for (int i = 0; i < 32; ++i) v[i] = 0.f; }
#pragma unroll
    for (int i = 0; i < 32; ++i) scr[(2 * i + (lane >> 5)) * 33 + (lane & 31)] = v[i];
    LDS_WAIT(); asm volatile("" ::: "memory");
    const int c = lane & 7;
#pragma unroll
    for (int j = 0; j < 4; ++j) { const int n = (lane >> 3) + 8 * j; const LAS float* q = scr + (8 * c) * 33 + n;
        if (t.fp8 == 2) { u32x2 o; o.x = pack4_i8(q[0 * 33] * t.wscale, q[1 * 33] * t.wscale, q[2 * 33] * t.wscale, q[3 * 33] * t.wscale); o.y = pack4_i8(q[4 * 33] * t.wscale, q[5 * 33] * t.wscale, q[6 * 33] * t.wscale, q[7 * 33] * t.wscale);
            *(GAS u32x2*)(t.dst + (size_t)n * t.ldt + 8 * c) = o; }
        else if (t.fp8) { u32x2 o; o.x = pg8::pack4_fp8(q[0 * 33] * t.wscale, q[1 * 33] * t.wscale, q[2 * 33] * t.wscale, q[3 * 33] * t.wscale); o.y = pg8::pack4_fp8(q[4 * 33] * t.wscale, q[5 * 33] * t.wscale, q[6 * 33] * t.wscale, q[7 * 33] * t.wscale);
            *(GAS u32x2*)(t.dst + (size_t)n * t.ldt + 8 * c) = o; }
        else { u32x4 o; o.x = pg8::cvt_pk_bf16(q[0 * 33], q[1 * 33]); o.y = pg8::cvt_pk_bf16(q[2 * 33], q[3 * 33]); o.z = pg8::cvt_pk_bf16(q[4 * 33], q[5 * 33]); o.w = pg8::cvt_pk_bf16(q[6 * 33], q[7 * 33]);
            *(GAS u32x4*)(t.dst + (size_t)n * t.ldt + 16 * c) = o; } }
    LDS_WAIT(); asm volatile("" ::: "memory");
}
__device__ __forceinline__ TItem tr_make(const float* W, int ldw, int srccol, const float* gain, int k0, void* WT, int ldt_elems, int row0, int lane, int fp8, float wscale = 1.f) {
    TItem t; t.wp = W + (size_t)(k0 + (lane >> 5)) * ldw + (srccol >= 0 ? srccol : 0); t.gain = gain; t.ldw = ldw; t.k0 = k0; t.fp8 = fp8; t.wscale = wscale; t.zero = srccol < 0;
    const int eb = fp8 ? 1 : 2; t.ldt = ldt_elems * eb; t.dst = (unsigned char*)WT + ((size_t)row0 * ldt_elems + k0) * eb; return t;
}
__device__ __forceinline__ int sigma16(int s) { return 8 * ((s >> 2) & 1) + 4 * (s >> 3) + (s & 3); }
__device__ __forceinline__ int sigma64(int s) { return 32 * ((s >> 2) & 1) + 4 * (s >> 3) + (s & 3); }
__device__ __forceinline__ int win_src(int n) {
    if (n < 2048) { const int base = n < 1024 ? C_DQ : C_DK, m = n & 1023, ch = m >> 6, s = m & 63; return base + ch * 64 + (s < 16 ? sigma16(s) : s); }
    if (n < 3072) return C_DV + (n - 2048);
    if (n < 3584) return C_CQ + (n - 3072);
    if (n < 3840) return C_CKV + (n - 3584);
    if (n < 5888) return C_GA + (n - 3840);
    if (n < 7936) return C_GB + (n - 5888);
    if (n < 8000) return C_KPE + sigma64(n - 7936);
    return -1;
}
__device__ __forceinline__ int wuq_src(int n) { const int h = n / 192, off = n - h * 192; return h * 192 + (off < 128 ? off : 128 + sigma64(off - 128)); }

__device__ __forceinline__ void rms_row_to_bf16(const float* xrow, const float* g, bf16* orow, int lane, unsigned char* orow8 = nullptr, bf16* xcopy = nullptr, float* rstd_out = nullptr, float i8scale = 0.f) {
    const GAS f32x4* xr = (const GAS f32x4*)xrow + lane; const GAS f32x4* gr = (const GAS f32x4*)g + lane;
    f32x4 v[8]; float s = 0.f;
#pragma unroll
    for (int j = 0; j < 8; ++j) { v[j] = __builtin_nontemporal_load(xr + 64 * j); s += (v[j].x * v[j].x + v[j].y * v[j].y) + (v[j].z * v[j].z + v[j].w * v[j].w); }
    const float rstd = rsqrtf(wave_sum(s) * (1.f / DM) + 1e-6f);
    GAS u32x2* o8 = (GAS u32x2*)orow + lane;
    if (rstd_out && lane == 0) *rstd_out = rstd;
    if (xcopy) { GAS u32x2* c8 = (GAS u32x2*)xcopy + lane;
#pragma unroll
        for (int j = 0; j < 8; ++j) { u32x2 w; w.x = pg8::cvt_pk_bf16(v[j].x, v[j].y); w.y = pg8::cvt_pk_bf16(v[j].z, v[j].w); c8[64 * j] = w; } }
#pragma unroll
    for (int j = 0; j < 8; ++j) { const f32x4 gg = gr[64 * j]; u32x2 w; w.x = pg8::cvt_pk_bf16(v[j].x * rstd * gg.x, v[j].y * rstd * gg.y); w.y = pg8::cvt_pk_bf16(v[j].z * rstd * gg.z, v[j].w * rstd * gg.w); if (orow) o8[64 * j] = w;
        if (orow8) ((GAS unsigned*)orow8)[lane + 64 * j] = i8scale != 0.f ? pack4_i8(v[j].x * rstd * gg.x * i8scale, v[j].y * rstd * gg.y * i8scale, v[j].z * rstd * gg.z * i8scale, v[j].w * rstd * gg.w * i8scale) : pg8::pack4_fp8(v[j].x * rstd * gg.x, v[j].y * rstd * gg.y, v[j].z * rstd * gg.z, v[j].w * rstd * gg.w); }
}

__device__ __forceinline__ void rms_rows2_x(const float* xa, const float* xb, const float* g, unsigned char* oa8, unsigned char* ob8, bf16* ca, bf16* cb, float* ra, float* rb, int lane) {
    const GAS f32x4* pa = (const GAS f32x4*)xa + lane; const GAS f32x4* pb = (const GAS f32x4*)xb + lane; const GAS f32x4* gr = (const GAS f32x4*)g + lane;
    f32x4 va[8], vb[8]; float sa = 0.f, sb = 0.f;
#pragma unroll
    for (int j = 0; j < 8; ++j) va[j] = __builtin_nontemporal_load(pa + 64 * j);
#pragma unroll
    for (int j = 0; j < 8; ++j) vb[j] = __builtin_nontemporal_load(pb + 64 * j);
#pragma unroll
    for (int j = 0; j < 8; ++j) sa += (va[j].x * va[j].x + va[j].y * va[j].y) + (va[j].z * va[j].z + va[j].w * va[j].w);
#pragma unroll
    for (int j = 0; j < 8; ++j) sb += (vb[j].x * vb[j].x + vb[j].y * vb[j].y) + (vb[j].z * vb[j].z + vb[j].w * vb[j].w);
    const float rsa = rsqrtf(wave_sum(sa) * (1.f / DM) + 1e-6f), rsb = rsqrtf(wave_sum(sb) * (1.f / DM) + 1e-6f);
    if (lane == 0) { *ra = rsa; *rb = rsb; }
    GAS u32x2* c8a = (GAS u32x2*)ca + lane; GAS u32x2* c8b = (GAS u32x2*)cb + lane;
#pragma unroll
    for (int j = 0; j < 8; ++j) { u32x2 w; w.x = pg8::cvt_pk_bf16(va[j].x, va[j].y); w.y = pg8::cvt_pk_bf16(va[j].z, va[j].w); c8a[64 * j] = w; w.x = pg8::cvt_pk_bf16(vb[j].x, vb[j].y); w.y = pg8::cvt_pk_bf16(vb[j].z, vb[j].w); c8b[64 * j] = w; }
#pragma unroll
    for (int j = 0; j < 8; ++j) { const f32x4 gg = gr[64 * j];
        ((GAS unsigned*)oa8)[lane + 64 * j] = pack4_i8(va[j].x * (rsa * XN_I8) * gg.x, va[j].y * (rsa * XN_I8) * gg.y, va[j].z * (rsa * XN_I8) * gg.z, va[j].w * (rsa * XN_I8) * gg.w);
        ((GAS unsigned*)ob8)[lane + 64 * j] = pack4_i8(vb[j].x * (rsb * XN_I8) * gg.x, vb[j].y * (rsb * XN_I8) * gg.y, vb[j].z * (rsb * XN_I8) * gg.z, vb[j].w * (rsb * XN_I8) * gg.w); }
}

struct SchedTile {
    pg8::TileOrder ord; const char* Ab; const char* Bb; size_t tA, tB;
    __device__ __forceinline__ bool next(int i, Unit& u) const { u.z = 0; return ord.tile(i, u.pm, u.pn); }
    __device__ __forceinline__ const char* A(const Unit& u) const { return Ab + (size_t)u.pm * tA; }
    __device__ __forceinline__ const char* B(const Unit& u) const { return Bb + (size_t)u.pn * tB; }
};
struct SchedProj {
    pg8::TileOrder ord; const char* Ab; const char* Bb; size_t tA, tB; int fp8;
    __device__ __forceinline__ bool next(int i, Unit& u) const { int pn; if (!ord.tile(i, u.pm, pn)) return false; u.z = pn;
        u.pn = fp8 ? (pn < 16 ? 15 + pn : (pn < 19 ? pn - 4 : 31)) : pn; return true; }
    __device__ __forceinline__ const char* A(const Unit& u) const { return Ab + (size_t)u.pm * tA; }
    __device__ __forceinline__ const char* B(const Unit& u) const { return Bb + (size_t)u.z * tB; }
};
struct SchedBal {
    int G, c; const char* Ab; const char* Bb; size_t tA, tB;
    __device__ __forceinline__ bool next(int i, Unit& u) const { int L;
        if (G == 256) { if (c < 128) { if (i > 0) return false; L = c; } else { if (i > 2) return false; L = 128 + (c - 128) + 128 * i; } }
        else { L = i * G + c; if (L >= 512) return false; }
        u.pm = L >> 3; u.pn = L & 7; u.z = 0; return true; }
    __device__ __forceinline__ const char* A(const Unit& u) const { return Ab + (size_t)u.pm * tA; }
    __device__ __forceinline__ const char* B(const Unit& u) const { return Bb + (size_t)u.pn * tB; }
};
struct SchedOff {
    int nN, n, c; const char* Ab; const char* Bb; size_t tA, tB;
    __device__ __forceinline__ bool next(int i, Unit& u) const { if (i > 0 || c < 0 || c >= n) return false; u.pm = c / nN; u.pn = c % nN; u.z = 0; return true; }
    __device__ __forceinline__ const char* A(const Unit& u) const { return Ab + (size_t)u.pm * tA; }
    __device__ __forceinline__ const char* B(const Unit& u) const { return Bb + (size_t)u.pn * tB; }
};
struct SchedGate {
    pg8::TileOrder ord; const char* A0; const char* A1; const char* B0; const char* B1; size_t tA, tB;
    __device__ __forceinline__ bool next(int j, Unit& u) const { u.z = j & 1; return ord.tile(j >> 1, u.pm, u.pn); }
    __device__ __forceinline__ const char* A(const Unit& u) const { return (u.z ? A1 : A0) + (size_t)u.pm * tA; }
    __device__ __forceinline__ const char* B(const Unit& u) const { return (u.z ? B1 : B0) + (size_t)u.pn * tB; }
};
struct MoeTab { const LAS int* tpre; const LAS int* cnt; };
__device__ __forceinline__ int moe_find(const MoeTab& t, int T) { int e = 0;
#pragma unroll 1
    for (int k = 1; k < 32; ++k) if (T >= t.tpre[k]) e = k;
    return e; }
struct SchedMoe1 {
    MoeTab tab; int G, vcu; const char* Ab; const char* Bb; const int* list;
    __device__ __forceinline__ bool next(int i, Unit& u) const { const int L = i * G + vcu; if (L >= tab.tpre[32] * 4) return false; u.pm = L >> 2; u.pn = L & 3; const int e = moe_find(tab, u.pm); u.z = e | ((u.pm - tab.tpre[e]) << 8); return true; }
    __device__ __forceinline__ const char* A(const Unit&) const { return Ab; }
    __device__ __forceinline__ const char* B(const Unit& u) const { return Bb + ((size_t)(u.z & 255) * 1024 + (size_t)u.pn * 256) * 2048; }
    __device__ __forceinline__ int arow(const Unit& u, int r) const { const int e = u.z & 255, c = tab.cnt[e]; int idx = (u.z >> 8) * 256 + r; idx = idx < c ? idx : c - 1; return list[e * NTOK + idx]; }
};
struct SchedMoe2 {
    MoeTab tab; int G, vcu; const char* Ab; const char* Bb;
    __device__ __forceinline__ bool next(int i, Unit& u) const { const int L = i * G + vcu; if (L >= tab.tpre[32] * 8) return false; u.pm = L >> 3; u.pn = L & 7; u.z = moe_find(tab, u.pm); return true; }
    __device__ __forceinline__ const char* A(const Unit& u) const { return Ab + (size_t)u.pm * (256 * 512); }
    __device__ __forceinline__ const char* B(const Unit& u) const { return Bb + ((size_t)u.z * 2048 + (size_t)u.pn * 256) * 512; }
};

#define EPI_ROWS_BEGIN  _Pragma("unroll") for (int ai = 0; ai < 2; ++ai) _Pragma("unroll") for (int m = 0; m < 4; ++m) { const int row = u.pm * 256 + ai * 128 + wr * 64 + m * 16 + fr;
#define EPI_ROWS_END    }
__device__ __forceinline__ f32x4 unpack4_u8(unsigned w) { return (f32x4){(float)(w & 0xffu), (float)((w >> 8) & 0xffu), (float)((w >> 16) & 0xffu), (float)(w >> 24)}; }
__device__ __forceinline__ void st16(bf16* p, const f32x4 a, const f32x4 b) { *(GAS u32x4*)p = pg8::pack8(a, b); }

struct EpiProj {
    static constexpr bool PERM = true;
    bf16 *QD, *KD, *VD; const float* rope_d; const float* rstd;
    __device__ __forceinline__ void operator()(f32x4 (&acc)[2][2][4][2], const Unit& u, int wr, int wc, int fr, int fq) const {
        const int pn = u.pn, colw = wc * 32 + 8 * fq;
        if (pn < 8) {
            bf16* dst = pn < 4 ? QD : KD; const float sc = pn < 4 ? C2D : 1.f; const bool rot = ((wc & 1) == 0) && fq < 2;
#pragma unroll
            for (int ai = 0; ai < 2; ++ai) {
                f32x4 cs[4][2]; float rs[4];
#pragma unroll
                for (int m = 0; m < 4; ++m) rs[m] = sc * (1.f / (XN_I8 * W_I8));
#pragma unroll
                for (int m = 0; m < 4; ++m) if (rot) { const int row = u.pm * 256 + ai * 128 + wr * 64 + m * 16 + fr; const GAS f32x4* t = (const GAS f32x4*)(rope_d + (size_t)row * 16 + fq * 8); cs[m][0] = t[0]; cs[m][1] = t[1]; }
#pragma unroll
                for (int m = 0; m < 4; ++m) { const int row = u.pm * 256 + ai * 128 + wr * 64 + m * 16 + fr;
#pragma unroll
                    for (int bj = 0; bj < 2; ++bj) { f32x4 v0 = acc_i2f(acc[ai][bj][m][0]), v1 = acc_i2f(acc[ai][bj][m][1]);
                        if (rot) {
#pragma unroll
                            for (int j = 0; j < 4; ++j) { const float c = cs[m][j >> 1][(j & 1) * 2], s = cs[m][j >> 1][(j & 1) * 2 + 1], x1 = v0[j], x2 = v1[j]; v0[j] = x1 * c - x2 * s; v1[j] = x2 * c + x1 * s; } }
                        st16(dst + (size_t)row * 1024 + (pn & 3) * 256 + bj * 128 + colw, v0 * rs[m], v1 * rs[m]); } }
            }
        } else if (pn < 12) {
            float rs[2][4];
#pragma unroll
            for (int ai = 0; ai < 2; ++ai)
#pragma unroll
                for (int m = 0; m < 4; ++m) rs[ai][m] = 1.f / (XN_I8 * W_I8);
            EPI_ROWS_BEGIN
#pragma unroll
                for (int bj = 0; bj < 2; ++bj) st16(VD + (size_t)row * 1024 + (pn - 8) * 256 + bj * 128 + colw, acc_i2f(acc[ai][bj][m][0]) * rs[ai][m], acc_i2f(acc[ai][bj][m][1]) * rs[ai][m]);
            EPI_ROWS_END
        }
    }
};
struct EpiGates {
    static constexpr bool PERM = true;
    bf16 *SGA, *SGB, *CQ, *CKV, *KM; float *ss_cq, *ss_ckv; const float* rope_m; float scale;
    __device__ __forceinline__ void operator()(f32x4 (&acc)[2][2][4][2], const Unit& u, int wr, int wc, int fr, int fq) const {
        const int pn = u.pn, colw = wc * 32 + 8 * fq;
        if (pn < 15) {
            unsigned char* dst = pn < 14 ? (unsigned char*)CQ + (pn - 12) * 256 : (unsigned char*)CKV; const int ld = pn < 14 ? 512 : 256; float* ss = pn < 14 ? ss_cq + (pn - 12) * 4 + wc : ss_ckv + wc; const int ssld = pn < 14 ? 8 : 4;
            EPI_ROWS_BEGIN
                float s = 0.f;
#pragma unroll
                for (int bj = 0; bj < 2; ++bj) { const f32x4 v0 = acc_i2f(acc[ai][bj][m][0]) * scale, v1 = acc_i2f(acc[ai][bj][m][1]) * scale;
                    s += (v0[0] * v0[0] + v0[1] * v0[1]) + (v0[2] * v0[2] + v0[3] * v0[3]) + (v1[0] * v1[0] + v1[1] * v1[1]) + (v1[2] * v1[2] + v1[3] * v1[3]);
                    u32x2 w; w.x = pg8::pack4_fp8(v0[0], v0[1], v0[2], v0[3]); w.y = pg8::pack4_fp8(v1[0], v1[1], v1[2], v1[3]);
                    *(GAS u32x2*)(dst + (size_t)row * ld + bj * 128 + colw) = w; }
                s += __shfl_xor(s, 16); s += __shfl_xor(s, 32);
                if (fq == 0) ss[(size_t)row * ssld] = s;
            EPI_ROWS_END
            return;
        }
        if (pn == 31) {
            if (wc < 2) {
                const int q = 4 * wc + fq;
#pragma unroll
                for (int ai = 0; ai < 2; ++ai) {
                    f32x4 cs[4][2];
#pragma unroll
                    for (int m = 0; m < 4; ++m) { const int row = u.pm * 256 + ai * 128 + wr * 64 + m * 16 + fr; const GAS f32x4* t = (const GAS f32x4*)(rope_m + (size_t)row * 64 + q * 8); cs[m][0] = t[0]; cs[m][1] = t[1]; }
#pragma unroll
                    for (int m = 0; m < 4; ++m) { const int row = u.pm * 256 + ai * 128 + wr * 64 + m * 16 + fr;
                        f32x4 v0 = acc_i2f(acc[ai][0][m][0]) * scale, v1 = acc_i2f(acc[ai][0][m][1]) * scale;
#pragma unroll
                        for (int j = 0; j < 4; ++j) { const float c = cs[m][j >> 1][(j & 1) * 2], s = cs[m][j >> 1][(j & 1) * 2 + 1], x1 = v0[j], x2 = v1[j]; v0[j] = x1 * c - x2 * s; v1[j] = x2 * c + x1 * s; }
                        u32x2 w; w.x = pg8::pack4_fp8(v0[0] * MLA_KS, v0[1] * MLA_KS, v0[2] * MLA_KS, v0[3] * MLA_KS); w.y = pg8::pack4_fp8(v1[0] * MLA_KS, v1[1] * MLA_KS, v1[2] * MLA_KS, v1[3] * MLA_KS);
                        *(GAS u32x2*)((unsigned char*)KM + (size_t)row * 64 + 8 * q) = w; }
                }
            }
            return;
        }
        unsigned char* dst = (unsigned char*)(pn < 23 ? SGA : SGB) + (pn < 23 ? pn - 15 : pn - 23) * 256;
        EPI_ROWS_BEGIN
#pragma unroll
            for (int bj = 0; bj < 2; ++bj) { f32x4 v0 = acc_i2f(acc[ai][bj][m][0]), v1 = acc_i2f(acc[ai][bj][m][1]);
#pragma unroll
                for (int j = 0; j < 4; ++j) { v0[j] = fmaxf(sigmoidf_fast(v0[j] * scale) * 255.f, 1.f); v1[j] = fmaxf(sigmoidf_fast(v1[j] * scale) * 255.f, 1.f); }
                u32x2 w; w.x = pack4_u8(v0[0], v0[1], v0[2], v0[3]); w.y = pack4_u8(v1[0], v1[1], v1[2], v1[3]);
                *(GAS u32x2*)(dst + (size_t)row * 2048 + bj * 128 + colw) = w; }
        EPI_ROWS_END
    }
};
struct EpiQup {
    static constexpr bool PERM = true;
    bf16* QM; const float* ss_cq; const float* rope_m;
    __device__ __forceinline__ void operator()(f32x4 (&acc)[2][2][4][2], const Unit& u, int wr, int wc, int fr, int fq) const {
        const int colw = wc * 32 + 8 * fq;
        int c0[2], hh[2], off[2];
#pragma unroll
        for (int bj = 0; bj < 2; ++bj) { c0[bj] = u.pn * 256 + bj * 128 + colw; hh[bj] = c0[bj] / 192; off[bj] = c0[bj] - hh[bj] * 192; }
#pragma unroll
        for (int ai = 0; ai < 2; ++ai)
#pragma unroll
            for (int mp = 0; mp < 2; ++mp) {
                f32x4 sa[2], sb[2], cs[2][2][2];
#pragma unroll
                for (int mm = 0; mm < 2; ++mm) { const int row = u.pm * 256 + ai * 128 + wr * 64 + (mp * 2 + mm) * 16 + fr; const GAS f32x4* sp = (const GAS f32x4*)(ss_cq + (size_t)row * 8); sa[mm] = sp[0]; sb[mm] = sp[1];
#pragma unroll
                    for (int bj = 0; bj < 2; ++bj) if (off[bj] >= 128) { const GAS f32x4* t = (const GAS f32x4*)(rope_m + (size_t)row * 64 + ((off[bj] - 128) >> 3) * 8); cs[mm][bj][0] = t[0]; cs[mm][bj][1] = t[1]; } }
#pragma unroll
                for (int mm = 0; mm < 2; ++mm) { const int m = mp * 2 + mm, row = u.pm * 256 + ai * 128 + wr * 64 + m * 16 + fr;
                    const float rs = rsqrtf((((sa[mm][0] + sa[mm][1]) + (sa[mm][2] + sa[mm][3])) + ((sb[mm][0] + sb[mm][1]) + (sb[mm][2] + sb[mm][3]))) * (1.f / 512.f) + 1e-6f) * (C2M * MLA_QS / WIN_SCALE);
#pragma unroll
                    for (int bj = 0; bj < 2; ++bj) { f32x4 v0 = acc[ai][bj][m][0] * rs, v1 = acc[ai][bj][m][1] * rs;
                        if (off[bj] >= 128) {
#pragma unroll
                            for (int j = 0; j < 4; ++j) { const float c = cs[mm][bj][j >> 1][(j & 1) * 2], s = cs[mm][bj][j >> 1][(j & 1) * 2 + 1], x1 = v0[j], x2 = v1[j]; v0[j] = x1 * c - x2 * s; v1[j] = x2 * c + x1 * s; } }
                        u32x2 w; w.x = pg8::pack4_fp8(v0[0], v0[1], v0[2], v0[3]); w.y = pg8::pack4_fp8(v1[0], v1[1], v1[2], v1[3]);
                        *(GAS u32x2*)((unsigned char*)QM + (size_t)row * 1536 + c0[bj]) = w; } }
            }
    }
};
struct EpiKVup {
    static constexpr bool PERM = true;
    bf16 *KM, *VM; const float* ss_ckv;
    __device__ __forceinline__ void operator()(f32x4 (&acc)[2][2][4][2], const Unit& u, int wr, int wc, int fr, int fq) const {
        const int colw = wc * 32 + 8 * fq, h = u.pn;
#pragma unroll
        for (int ai = 0; ai < 2; ++ai) {
            f32x4 sa[4];
#pragma unroll
            for (int m = 0; m < 4; ++m) { const int row = u.pm * 256 + ai * 128 + wr * 64 + m * 16 + fr; sa[m] = *(const GAS f32x4*)(ss_ckv + (size_t)row * 4); }
#pragma unroll
            for (int m = 0; m < 4; ++m) { const int row = u.pm * 256 + ai * 128 + wr * 64 + m * 16 + fr;
                const float rs = rsqrtf(((sa[m][0] + sa[m][1]) + (sa[m][2] + sa[m][3])) * (1.f / 256.f) + 1e-6f) * (1.f / WIN_SCALE);
                { const f32x4 k0 = acc[ai][0][m][0] * (rs * MLA_KS), k1 = acc[ai][0][m][1] * (rs * MLA_KS); u32x2 w; w.x = pg8::pack4_fp8(k0[0], k0[1], k0[2], k0[3]); w.y = pg8::pack4_fp8(k1[0], k1[1], k1[2], k1[3]);
                  *(GAS u32x2*)((unsigned char*)KM + (size_t)row * 1024 + h * 128 + colw) = w; }
                { const f32x4 v0 = acc[ai][1][m][0] * (rs * MLA_VS), v1 = acc[ai][1][m][1] * (rs * MLA_VS); u32x2 w; w.x = pg8::pack4_fp8(v0[0], v0[1], v0[2], v0[3]); w.y = pg8::pack4_fp8(v1[0], v1[1], v1[2], v1[3]);
                  *(GAS u32x2*)((unsigned char*)VM + (size_t)row * 1024 + h * 128 + colw) = w; } }
        }
    }
};
struct EpiPlain {
    static constexpr bool PERM = true;
    bf16* O; int ldc; const float* ss; float ssn_inv, scale; int f8;
    __device__ __forceinline__ void operator()(f32x4 (&acc)[2][2][4][2], const Unit& u, int wr, int wc, int fr, int fq) const {
        const int colw = wc * 32 + 8 * fq;
        float rsv[2][4];
#pragma unroll
        for (int ai = 0; ai < 2; ++ai)
#pragma unroll
            for (int m = 0; m < 4; ++m) rsv[ai][m] = scale;
        if (ss) {
#pragma unroll
            for (int ai = 0; ai < 2; ++ai)
#pragma unroll
                for (int mp = 0; mp < 2; ++mp) { f32x4 q[2][8];
#pragma unroll
                    for (int mm = 0; mm < 2; ++mm) { const int row = u.pm * 256 + ai * 128 + wr * 64 + (mp * 2 + mm) * 16 + fr; const GAS f32x4* sp = (const GAS f32x4*)(ss + (size_t)row * 32);
#pragma unroll
                        for (int i = 0; i < 8; ++i) q[mm][i] = sp[i]; }
#pragma unroll
                    for (int mm = 0; mm < 2; ++mm) { float t = 0.f;
#pragma unroll
                        for (int i = 0; i < 8; ++i) t += (q[mm][i][0] + q[mm][i][1]) + (q[mm][i][2] + q[mm][i][3]);
                        rsv[ai][mp * 2 + mm] = rsqrtf(t * ssn_inv + 1e-6f) * scale; } }
        }
        EPI_ROWS_BEGIN
            const float rs = rsv[ai][m];
#pragma unroll
            for (int bj = 0; bj < 2; ++bj) { const f32x4 v0 = acc[ai][bj][m][0] * rs, v1 = acc[ai][bj][m][1] * rs;
                u32x2 w; w.x = pg8::pack4_fp8(v0[0], v0[1], v0[2], v0[3]); w.y = pg8::pack4_fp8(v1[0], v1[1], v1[2], v1[3]); *(GAS u32x2*)((unsigned char*)O + (size_t)row * ldc + u.pn * 256 + bj * 128 + colw) = w; }
        EPI_ROWS_END
    }
};
struct EpiDown {
    static constexpr bool PERM = true;
    bf16* O; MoeTab tab; float scale;
    __device__ __forceinline__ void operator()(f32x4 (&acc)[2][2][4][2], const Unit& u, int wr, int wc, int fr, int fq) const {
        const int colw = wc * 32 + 8 * fq, nvalid = tab.cnt[u.z] - (u.pm - tab.tpre[u.z]) * 256;
        EPI_ROWS_BEGIN
            if (ai * 128 + wr * 64 + m * 16 + fr < nvalid) {
#pragma unroll
                for (int bj = 0; bj < 2; ++bj) { const f32x4 v0 = acc[ai][bj][m][0] * scale, v1 = acc[ai][bj][m][1] * scale; u32x2 w; w.x = pg8::pack4_fp8(v0[0], v0[1], v0[2], v0[3]); w.y = pg8::pack4_fp8(v1[0], v1[1], v1[2], v1[3]);
                    *(GAS u32x2*)((unsigned char*)O + (size_t)row * 2048 + u.pn * 256 + bj * 128 + colw) = w; } }
        EPI_ROWS_END
    }
};
struct EpiGate {
    static constexpr bool PERM = true;
    const bf16 *SGA, *SGB; bf16* MG;
    __device__ __forceinline__ void mid(f32x4 (&acc)[2][2][4][2], const Unit& u, int wr, int wc, int fr, int fq) const {
        const int colw = wc * 32 + 8 * fq; const unsigned char* A8 = (const unsigned char*)SGA; const unsigned char* B8 = (const unsigned char*)SGB;
        EPI_ROWS_BEGIN
#pragma unroll
            for (int bj = 0; bj < 2; ++bj) { const size_t off = (size_t)row * 2048 + u.pn * 256 + bj * 128 + colw;
                const u32x2 a = *(const GAS u32x2*)(A8 + off), b = *(const GAS u32x2*)(B8 + off);
                const f32x4 a0 = unpack4_u8(a.x), a1 = unpack4_u8(a.y), b0 = unpack4_u8(b.x), b1 = unpack4_u8(b.y);
                f32x4& v0 = acc[ai][bj][m][0]; f32x4& v1 = acc[ai][bj][m][1];
#pragma unroll
                for (int j = 0; j < 4; ++j) { v0[j] *= a0[j] * __builtin_amdgcn_rcpf(b0[j]); v1[j] *= a1[j] * __builtin_amdgcn_rcpf(b1[j]); } }
        EPI_ROWS_END
    }
    __device__ __forceinline__ void operator()(f32x4 (&acc)[2][2][4][2], const Unit& u, int wr, int wc, int fr, int fq) const {
        const int colw = wc * 32 + 8 * fq; const unsigned char* B8 = (const unsigned char*)SGB;
#pragma unroll
        for (int ai = 0; ai < 2; ++ai) {
            u32x2 g[4][2];
#pragma unroll
            for (int m = 0; m < 4; ++m)
#pragma unroll
                for (int bj = 0; bj < 2; ++bj) { const int row = u.pm * 256 + ai * 128 + wr * 64 + m * 16 + fr; g[m][bj] = *(const GAS u32x2*)(B8 + (size_t)row * 2048 + u.pn * 256 + bj * 128 + colw); }
#pragma unroll
            for (int m = 0; m < 4; ++m)
#pragma unroll
                for (int bj = 0; bj < 2; ++bj) { const int row = u.pm * 256 + ai * 128 + wr * 64 + m * 16 + fr; const size_t off = (size_t)row * 2048 + u.pn * 256 + bj * 128 + colw;
                    const f32x4 g0 = unpack4_u8(g[m][bj].x) * (MG_SCALE / 255.f), g1 = unpack4_u8(g[m][bj].y) * (MG_SCALE / 255.f);
                    { const f32x4 v0 = acc[ai][bj][m][0] * g0, v1 = acc[ai][bj][m][1] * g1; u32x2 w; w.x = pack4_i8(v0[0], v0[1], v0[2], v0[3]); w.y = pack4_i8(v1[0], v1[1], v1[2], v1[3]); *(GAS u32x2*)((unsigned char*)MG + off) = w; } }
        }
    }
};
template <bool BASE_BF16, bool I32ACC = false> struct EpiResid {
    static constexpr bool PERM = true;
    const void* base; bf16* HB; float* ss; unsigned char* H8; float ascale;
    __device__ __forceinline__ void operator()(f32x4 (&acc)[2][2][4][2], const Unit& u, int wr, int wc, int fr, int fq) const {
        const int colw = wc * 32 + 8 * fq;
#pragma unroll
        for (int ai = 0; ai < 2; ++ai) {
            if constexpr (BASE_BF16) {
#pragma unroll
                for (int m = 0; m < 4; ++m)
#pragma unroll
                    for (int bj = 0; bj < 2; ++bj) { const int row = u.pm * 256 + ai * 128 + wr * 64 + m * 16 + fr; const u32x4 g = *(const GAS u32x4*)((const bf16*)base + (size_t)row * 2048 + u.pn * 256 + bj * 128 + colw);
                        f32x4& v0 = acc[ai][bj][m][0]; f32x4& v1 = acc[ai][bj][m][1];
                        if constexpr (I32ACC) { v0 = __builtin_convertvector(__builtin_bit_cast(pg8::i32x4, v0), f32x4); v1 = __builtin_convertvector(__builtin_bit_cast(pg8::i32x4, v1), f32x4); }
                        v0[0] = v0[0] * ascale + pg8::bf_lo(g.x); v0[1] = v0[1] * ascale + pg8::bf_hi(g.x); v0[2] = v0[2] * ascale + pg8::bf_lo(g.y); v0[3] = v0[3] * ascale + pg8::bf_hi(g.y); v1[0] = v1[0] * ascale + pg8::bf_lo(g.z); v1[1] = v1[1] * ascale + pg8::bf_hi(g.z); v1[2] = v1[2] * ascale + pg8::bf_lo(g.w); v1[3] = v1[3] * ascale + pg8::bf_hi(g.w); }
            } else {
#pragma unroll
                for (int m = 0; m < 4; ++m)
#pragma unroll
                    for (int bj = 0; bj < 2; ++bj) { const int row = u.pm * 256 + ai * 128 + wr * 64 + m * 16 + fr; const size_t off = (size_t)row * 2048 + u.pn * 256 + bj * 128 + colw;
                        acc[ai][bj][m][0] += *(const GAS f32x4*)((const float*)base + off); acc[ai][bj][m][1] += *(const GAS f32x4*)((const float*)base + off + 4); }
            }
#pragma unroll
            for (int m = 0; m < 4; ++m) { const int row = u.pm * 256 + ai * 128 + wr * 64 + m * 16 + fr; float s = 0.f;
#pragma unroll
                for (int bj = 0; bj < 2; ++bj) { const size_t off = (size_t)row * 2048 + u.pn * 256 + bj * 128 + colw; const f32x4 v0 = acc[ai][bj][m][0], v1 = acc[ai][bj][m][1];
                    st16(HB + off, v0, v1);
                    if (H8) { u32x2 w; w.x = pg8::pack4_fp8(v0[0], v0[1], v0[2], v0[3]); w.y = pg8::pack4_fp8(v1[0], v1[1], v1[2], v1[3]); *(GAS u32x2*)(H8 + off) = w; }
                    s += (v0[0] * v0[0] + v0[1] * v0[1]) + (v0[2] * v0[2] + v0[3] * v0[3]) + (v1[0] * v1[0] + v1[1] * v1[1]) + (v1[2] * v1[2] + v1[3] * v1[3]); }
                if (ss) { s += __shfl_xor(s, 16); s += __shfl_xor(s, 32); if (fq == 0) ss[(size_t)row * 32 + u.pn * 4 + wc] = s; } }
        }
    }
};
struct EpiHid {
    static constexpr bool PERM = true;
    bf16* HID; const float* listr; const LAS int* cnt;
    __device__ __forceinline__ void operator()(f32x4 (&acc)[2][2][4][2], const Unit& u, int wr, int wc, int fr, int fq) const {
        const int colw = wc * 32 + 8 * fq, e = u.z & 255, tl = u.z >> 8, c = cnt[e];
        float rsv[2][4];
#pragma unroll
        for (int ai = 0; ai < 2; ++ai)
#pragma unroll
            for (int m = 0; m < 4; ++m) { const int r = ai * 128 + wr * 64 + m * 16 + fr; int idx = tl * 256 + r; idx = idx < c ? idx : c - 1; rsv[ai][m] = listr[e * NTOK + idx]; }
#pragma unroll
        for (int ai = 0; ai < 2; ++ai)
#pragma unroll
            for (int m = 0; m < 4; ++m) { const int r = ai * 128 + wr * 64 + m * 16 + fr;
                const float rs = rsv[ai][m] * (1.f / WGU_SCALE);
                f32x4 o0, o1;
#pragma unroll
                for (int j = 0; j < 4; ++j) { const float g0 = acc[ai][0][m][0][j] * rs, u0 = acc[ai][1][m][0][j] * rs, g1 = acc[ai][0][m][1][j] * rs, u1 = acc[ai][1][m][1][j] * rs;
                    o0[j] = g0 * sigmoidf_fast(g0) * u0; o1[j] = g1 * sigmoidf_fast(g1) * u1; }
                u32x2 w; w.x = pg8::pack4_fp8(o0[0] * HID_SCALE, o0[1] * HID_SCALE, o0[2] * HID_SCALE, o0[3] * HID_SCALE); w.y = pg8::pack4_fp8(o1[0] * HID_SCALE, o1[1] * HID_SCALE, o1[2] * HID_SCALE, o1[3] * HID_SCALE);
                *(GAS u32x2*)((unsigned char*)HID + (size_t)(u.pm * 256 + r) * 512 + u.pn * 128 + colw) = w; }
    }
};

__device__ __forceinline__ void store_o_bf16(const att::f32x16 (&o)[4], bf16* O, int ldo, int wid, int r32, int hi) {
#pragma unroll
    for (int r = 0; r < 16; ++r) { bf16* rowp = O + (size_t)(wid * 32 + att::crow(r, hi)) * ldo + r32;
#pragma unroll
        for (int d0 = 0; d0 < 4; ++d0) rowp[d0 * 32] = (bf16)(pg8::cvt_pk_bf16(o[d0][r], 0.f) & 0xffffu); }
}
__device__ __forceinline__ void store_ot_bf16(const att::f32x16 (&o)[4], bf16* O, int ldo, int wid, int r32, int hi) {
    bf16* rowp = O + (size_t)(wid * 32 + r32) * ldo + 4 * hi;
#pragma unroll
    for (int d0 = 0; d0 < 4; ++d0)
#pragma unroll
        for (int rg = 0; rg < 4; ++rg) { u32x2 w; w.x = pg8::cvt_pk_bf16(o[d0][4 * rg], o[d0][4 * rg + 1]); w.y = pg8::cvt_pk_bf16(o[d0][4 * rg + 2], o[d0][4 * rg + 3]); *(GAS u32x2*)(rowp + 32 * d0 + 8 * rg) = w; }
}
__device__ __forceinline__ void store_ot_fp8(const att::f32x16 (&o)[4], unsigned char* O8, int ldo_bytes, int wid, int r32, int hi, float scale) {
    unsigned char* rowp = O8 + (size_t)(wid * 32 + r32) * ldo_bytes + 4 * hi;
#pragma unroll
    for (int d0 = 0; d0 < 4; ++d0)
#pragma unroll
        for (int rg = 0; rg < 4; ++rg) *(GAS unsigned*)(rowp + 32 * d0 + 8 * rg) = pg8::pack4_fp8(o[d0][4 * rg] * scale, o[d0][4 * rg + 1] * scale, o[d0][4 * rg + 2] * scale, o[d0][4 * rg + 3] * scale);
}
}
namespace mk {
constexpr int N_PHASES = 13;
#define WIN_T ((bf16*)(ws + WS_WIN_T))
#define WOA_T ((bf16*)(ws + WS_WOA_T))
#define WOB_T ((bf16*)(ws + WS_WOB_T))
#define WOUT_T ((bf16*)(ws + WS_WOUT_T))
#define WUQ_T ((bf16*)(ws + WS_WUQ_T))
#define WUKV_T ((bf16*)(ws + WS_WUKV_T))
#define WCQ_T ((bf16*)(ws + WS_WCQ_T))
#define WCKV_T ((bf16*)(ws + WS_WCKV_T))
#define WCO_T ((bf16*)(ws + WS_WCO_T))
#define XN ((bf16*)(ws + WS_XN))
#define QM ((bf16*)(ws + WS_QM))
#define MG ((bf16*)(ws + WS_MG))
#define QD ((bf16*)(ws + WS_QD))
#define KD ((bf16*)(ws + WS_KD))
#define VD ((bf16*)(ws + WS_VD))
#define CQ ((bf16*)(ws + WS_CQ))
#define CKV ((bf16*)(ws + WS_CKV))
#define SGA ((bf16*)(ws + WS_SGA))
#define SGB ((bf16*)(ws + WS_SGB))
#define KM ((bf16*)(ws + WS_KM))
#define VM ((bf16*)(ws + WS_VM))
#define OB ((bf16*)(ws + WS_OB))
#define MEMN ((bf16*)(ws + WS_MEMN))
#define KVC ((bf16*)(ws + WS_KVC))
#define HB ((bf16*)(ws + WS_HB))
#define QC ((bf16*)(ws + WS_QC))
#define OC ((bf16*)(ws + WS_OC))
#define WGU_T ((bf16*)(ws + WS_WGU_T))
#define WD_T ((bf16*)(ws + WS_WD_T))
#define HID ((bf16*)(ws + WS_HID))
#define Y ((bf16*)(ws + WS_Y))
#define SS_CQ ((float*)(ws + WS_SS_CQ))
#define SS_CKV ((float*)(ws + WS_SS_CKV))
#define SS_H1 ((float*)(ws + WS_SS_H1))
#define ROPE_D ((float*)(ws + WS_ROPE_D))
#define ROPE_M ((float*)(ws + WS_ROPE_M))
#define WR_T ((float*)(ws + WS_WR_T))
#define TOKES ((int*)(ws + WS_TOKES))
#define TOKW ((float*)(ws + WS_TOKW))
#define SCAL ((float*)(ws + WS_SCAL))
#define LIST ((int*)(ws + WS_LIST))
#define LISTR ((float*)(ws + WS_LISTR))


__device__ __forceinline__ int mk_lane_now() { int t; asm volatile("v_mbcnt_lo_u32_b32 %0, -1, 0\n\tv_mbcnt_hi_u32_b32 %0, -1, %0" : "=v"(t)); return t; }
typedef const __attribute__((address_space(4))) Args* ArgP;
constexpr int MOE_I_GU = (2048 / 64) * (1024 / 32), MOE_I_DN = (512 / 64) * (2048 / 32), MOE_I_E = MOE_I_GU + MOE_I_DN, MOE_CONV_ITEMS = 32 * MOE_I_E;
constexpr int MOE_N_GU = 32 * MOE_I_GU, MOE_N_DN = 32 * MOE_I_DN, MOE_GU_P5 = MOE_N_GU - 4424;
constexpr int MOE_CONV_P5 = (MOE_CONV_ITEMS * 91 / 100) / 8 * 8;
__device__ __forceinline__ void moe_conv_item(int it, ArgP ap, unsigned char* ws, LAS float* scr, int lane) {
    const int e = it / MOE_I_E; int r = it - e * MOE_I_E; const int nl = lane & 31;
    if (r < MOE_I_GU) { const int nblk = 1024 / 32, kb = r / nblk, nb = r % nblk, n = nb * 32, pn = n >> 8, half = (n >> 7) & 1, j = n & 127;
        const float* src = (half ? ap->w_up : ap->w_gate) + (size_t)e * 2048 * 512;
        transpose_item<true>(src, 512, pn * 128 + j + nl, ap->ffn_norm_g, kb * 64, (bf16*)((unsigned char*)WGU_T + (size_t)e * 1024 * 2048), 2048, n, scr, lane, WGU_SCALE); }
    else { r -= MOE_I_GU; const int nblk = 2048 / 32, kb = r / nblk, nb = r % nblk;
        transpose_item<true>(ap->w_down + (size_t)e * 512 * 2048, 2048, nb * 32 + nl, nullptr, kb * 64, (bf16*)((unsigned char*)WD_T + (size_t)e * 2048 * 512), 512, nb * 32, scr, lane, WD_SCALE); }
}
__device__ __forceinline__ TItem moe_item(int it, ArgP ap, unsigned char* ws, int lane) {
    const int e = it / MOE_I_E; int r = it - e * MOE_I_E; const int nl = lane & 31;
    if (r < MOE_I_GU) { const int nblk = 1024 / 32, kb = r / nblk, nb = r % nblk, n = nb * 32, pn = n >> 8, half = (n >> 7) & 1, j = n & 127;
        const float* src = (half ? ap->w_up : ap->w_gate) + (size_t)e * 2048 * 512;
        return tr_make(src, 512, pn * 128 + j + nl, ap->ffn_norm_g, kb * 64, (unsigned char*)WGU_T + (size_t)e * 1024 * 2048, 2048, n, lane, true, WGU_SCALE); }
    r -= MOE_I_GU; const int nblk = 2048 / 32, kb = r / nblk, nb = r % nblk;
    return tr_make(ap->w_down + (size_t)e * 512 * 2048, 2048, nb * 32 + nl, nullptr, kb * 64, (unsigned char*)WD_T + (size_t)e * 2048 * 512, 512, nb * 32, lane, true, WD_SCALE);
}
template <int KIND> __device__ __forceinline__ int moe_map(int i) { return KIND == 0 ? (i / MOE_I_GU) * MOE_I_E + i % MOE_I_GU : (i / MOE_I_DN) * MOE_I_E + MOE_I_GU + i % MOE_I_DN; }
template <int KIND> __device__ __forceinline__ void moe_conv_run(int first, int limit, int stride, ArgP ap, unsigned char* ws, LAS float* scr, int lane) {
    if (first >= limit) return;
    TItem cur = moe_item(moe_map<KIND>(first), ap, ws, lane); float v[32]; tr_load(cur, v);
    for (int it = first; ; ) { const int nx = it + stride; const bool has = nx < limit; TItem nt_; float w[32];
        if (has) { nt_ = moe_item(moe_map<KIND>(nx), ap, ws, lane); tr_load(nt_, w); }
        tr_finish(cur, v, scr, lane);
        if (!has) break;
        cur = nt_; it = nx;
#pragma unroll
        for (int i = 0; i < 32; ++i) v[i] = w[i]; }
}
__device__ __forceinline__ ArgP argp() { ArgP p = (ArgP)__builtin_amdgcn_kernarg_segment_ptr(); asm volatile("" : "+s"(p)); return p; }
__global__ void __launch_bounds__(NWAVES * 64, 2) fused_fwd(Args a_kernarg) {
    extern __shared__ __attribute__((aligned(16))) unsigned char lds_raw[];
    LAS unsigned char* lds = (LAS unsigned char*)lds_raw;
    volatile LAS unsigned* MISC = (volatile LAS unsigned*)(lds + MISC_OFF);
    const int tid0 = threadIdx.x;
    const int wave0 = __builtin_amdgcn_readfirstlane(tid0 >> 6);
#define MK_TID() (wave0 * 64 + mk_lane_now())
    const int G = gridDim.x, bx = blockIdx.x, vcu = (G % 8 == 0) ? (bx % 8) * (G / 8) + bx / 8 : bx;
    for (int u = tid0; u < (LDS_BYTES - LDSCTL_OFF) / 4; u += NWAVES * 64) ((LAS unsigned*)(lds + LDSCTL_OFF))[u] = 0u;
    __syncthreads();
    (void)xcd_barrier_post((unsigned*)((gu32*)argp()->ws + CW_BAR), MISC + 8);
#define MK_BAR() XcdBarrier{(unsigned*)((gu32*)argp()->ws + CW_BAR), xb_xcc_id(), (volatile LAS unsigned*)(lds + MISC_OFF) + 8}
    const int lo = argp()->ph_lo, hi = argp()->ph_hi & 0xffff;
#ifdef MK_PROBE_SKIP
    const bool skip_epi = (argp()->ph_hi >> 16) & 1;
#else
    constexpr bool skip_epi = false;
#endif
#ifndef MK_P3_DIFF
#define MK_P3_DIFF 1
#endif
#ifndef MK_P3_MLA
#define MK_P3_MLA 1
#endif
#ifndef MK_PHASE_MASK
#define MK_PHASE_MASK 0xFFFF
#endif
#define IN(k) (((MK_PHASE_MASK >> (k)) & 1) && lo <= (k) && (k) < hi)
#define PHASE_IDS() int tid = MK_TID(); asm volatile("" : "+v"(tid)); const int lane = tid & 63, wave = __builtin_amdgcn_readfirstlane(tid >> 6), gw = vcu * NWAVES + wave; \
    LAS float* scr = (LAS float*)(lds + RING_OFF + wave * 16384); const ArgP ap = argp(); unsigned char* const ws = ap->ws; gu32* const ctl = (gu32*)ws; (void)lane; (void)gw; (void)scr; (void)ap; (void)ctl
#define SEAM(k) do { if (IN(k) && IN((k) + 1)) { const XcdBarrier bar_ = MK_BAR(); xcd_barrier(bar_, MK_TID()); } } while (0)
    const int NGW = G * NWAVES;

    if (IN(0)) { asm volatile("; MKPHASE 0" ::: "memory"); PHASE_IDS();
        constexpr int I_IN = (2048 / 64) * (NPROJ / 32), I_OA = (1024 / 64) * (2048 / 32), I_OUT = (2048 / 64) * (2048 / 32), I_UQ = (512 / 64) * (1536 / 32), I_UKV = (256 / 64) * (2048 / 32),
                      I_CQ = (2048 / 64) * (512 / 32), I_CKV = (2048 / 64) * (1024 / 32), I_CO = (512 / 64) * (2048 / 32);
        constexpr int NITEMS = I_IN + 2 * I_OA + I_OUT + I_UQ + I_UKV + I_CQ + I_CKV + I_CO;
        auto p0_item = [&](int it) -> TItem { int r = it; const int nl = lane & 31;
            if (r < I_IN) { const int nblk = NPROJ / 32, kb = r / nblk, nb = r % nblk, n0 = nb * 32;
                if (n0 >= 3072) { const int r8 = n0 < 3840 ? n0 - 3072 + 4096 : (n0 < 7936 ? n0 - 3840 : n0 - 7936 + 4864);
                    return tr_make(ap->w_in, D_IN, win_src(n0 + nl), nullptr, kb * 64, ws + WS_WIN8, 2048, r8, lane, 2, W_I8); }
                return tr_make(ap->w_in, D_IN, win_src(n0 + nl), nullptr, kb * 64, WIN_T, 2048, n0, lane, 2, W_I8); }
            r -= I_IN;
            if (r < I_OA) { const int nblk = 2048 / 32, kb = r / nblk, nb = r % nblk; return tr_make(ap->w_o_diff, 2048, nb * 32 + nl, nullptr, kb * 64, WOA_T, 1024, nb * 32, lane, false); } r -= I_OA;
            if (r < I_OA) { const int nblk = 2048 / 32, kb = r / nblk, nb = r % nblk; return tr_make(ap->w_o_mla, 2048, nb * 32 + nl, nullptr, kb * 64, WOB_T, 2048, nb * 32, lane, true, 64.f); } r -= I_OA;
            if (r < I_OUT) { const int nblk = 2048 / 32, kb = r / nblk, nb = r % nblk; return tr_make(ap->w_out, 2048, nb * 32 + nl, nullptr, kb * 64, WOUT_T, 2048, nb * 32, lane, 2, WOUT_SCALE); } r -= I_OUT;
            if (r < I_UQ) { const int nblk = 1536 / 32, kb = r / nblk, nb = r % nblk; return tr_make(ap->w_uq, 1536, wuq_src(nb * 32 + nl), ap->mla_q_norm_g, kb * 64, WUQ_T, 512, nb * 32, lane, true, WIN_SCALE); } r -= I_UQ;
            if (r < I_UKV) { const int nblk = 2048 / 32, kb = r / nblk, nb = r % nblk; return tr_make(ap->w_ukv, 2048, nb * 32 + nl, ap->mla_kv_norm_g, kb * 64, WUKV_T, 256, nb * 32, lane, true, WIN_SCALE); } r -= I_UKV;
            if (r < I_CQ) { const int nblk = 512 / 32, kb = r / nblk, nb = r % nblk; return tr_make(ap->w_cq, 512, nb * 32 + nl, ap->cross_norm_g, kb * 64, ws + WS_WCQ8, 2048, nb * 32, lane, true, WIN_SCALE); } r -= I_CQ;
            if (r < I_CKV) { const int nblk = 1024 / 32, kb = r / nblk, nb = r % nblk; return tr_make(ap->w_ckv, 1024, nb * 32 + nl, nullptr, kb * 64, ws + WS_WCKV8, 2048, nb * 32, lane, true, WIN_SCALE); } r -= I_CKV;
            { const int nblk = 2048 / 32, kb = r / nblk, nb = r % nblk; return tr_make(ap->w_co, 2048, nb * 32 + nl, nullptr, kb * 64, WCO_T, 512, nb * 32, lane, true, 64.f); } };
        if (gw < NITEMS) {
            TItem cur = p0_item(gw); float v[32]; tr_load(cur, v);
            for (int it = gw; ; ) { const int nx = it + NGW; const bool has = nx < NITEMS; TItem nt_; float w[32];
                if (has) { nt_ = p0_item(nx); tr_load(nt_, w); }
                tr_finish(cur, v, scr, lane);
                if (!has) break;
                cur = nt_; it = nx;
#pragma unroll
                for (int i = 0; i < 32; ++i) v[i] = w[i]; } }
        { int m = gw;
          for (; m + NGW < NTOK; m += 2 * NGW) { const int m2 = m + NGW;
              rms_rows2_x(ap->x + (size_t)m * DM, ap->x + (size_t)m2 * DM, ap->attn_norm_g, ws + WS_XN8 + (size_t)m * DM, ws + WS_XN8 + (size_t)m2 * DM, HB + (size_t)m * DM, HB + (size_t)m2 * DM, (float*)(ws + WS_RSTDX) + m, (float*)(ws + WS_RSTDX) + m2, lane); }
          if (m < NTOK) rms_row_to_bf16(ap->x + (size_t)m * DM, ap->attn_norm_g, nullptr, lane, ws + WS_XN8 + (size_t)m * DM, HB + (size_t)m * DM, (float*)(ws + WS_RSTDX) + m, XN_I8); }
        for (int m = gw; m < NB * MEML; m += NGW) rms_row_to_bf16(ap->mem + (size_t)m * DM, ap->mem_norm_g, MEMN + (size_t)m * DM, lane, ws + WS_MEMN8 + (size_t)m * DM);
        for (int idx = (vcu * NWAVES * 64) + tid; idx < NTOK * 40; idx += G * NWAVES * 64) { const int tok = idx / 40, j = idx - tok * 40; const float p = (float)ap->positions[tok];
            if (j < 8) { const float inv = powf(500000.0f, -(float)j * 2.0f / 16.0f), ang = p * inv; ROPE_D[(size_t)tok * 16 + j * 2] = cosf(ang); ROPE_D[(size_t)tok * 16 + j * 2 + 1] = sinf(ang); }
            else { const int i = j - 8; const float inv = powf(500000.0f, -(float)i * 2.0f / 64.0f), ang = p * inv; ROPE_M[(size_t)tok * 64 + i * 2] = cosf(ang); ROPE_M[(size_t)tok * 64 + i * 2 + 1] = sinf(ang); } }
        for (int idx = (vcu * NWAVES * 64) + tid; idx < 48 * DM; idx += G * NWAVES * 64) { const int j = idx / DM, k = idx - j * DM; float v = 0.f;
            if (j < 4) v = ap->w_rg[k * 4 + j] * ap->ffn_norm_g[k]; else if (j < 36) v = ap->w_re[k * 32 + (j - 4)] * ap->ffn_norm_g[k];
            const unsigned hi = pg8::cvt_pk_bf16(v, 0.f) & 0xffffu; const float r = v - __uint_as_float(hi << 16); const unsigned lo = pg8::cvt_pk_bf16(r, 0.f) & 0xffffu;
            ((bf16*)WR_T)[idx] = (bf16)hi; ((bf16*)WR_T)[48 * DM + idx] = (bf16)lo; }
        if (bx == 0 && wave == 0) { const float p1 = wave_sum(ap->lq1[lane] * ap->lk1[lane]), p2 = wave_sum(ap->lq2[lane] * ap->lk2[lane]); if (lane == 0) SCAL[0] = expf(p1) - expf(p2) + 0.2f; }
    }
    SEAM(0);

    if (IN(1)) { asm volatile("; MKPHASE 1" ::: "memory"); PHASE_IDS();
        { SchedProj S; S.ord.init(NTOK / 256, 12, G, bx); S.Ab = (const char*)(ws + WS_XN8); S.Bb = (const char*)WIN_T; S.tA = (size_t)256 * 2048; S.tB = (size_t)256 * 2048; S.fp8 = 0;
          EpiProj E{QD, KD, VD, ROPE_D, (const float*)(ws + WS_RSTDX)};
          pg8::gemm_phase<EpiProj, SchedProj, false, true, false, 1, false, true>(lds + RING_OFF, 2048, 2048, 2048, S, E, MK_TID(), skip_epi); }
        { SchedProj S; S.ord.init(NTOK / 256, 20, G, bx); S.Ab = (const char*)(ws + WS_XN8); S.Bb = (const char*)(ws + WS_WIN8); S.tA = (size_t)256 * 2048; S.tB = (size_t)256 * 2048; S.fp8 = 1;
          EpiGates E{SGA, SGB, CQ, CKV, (bf16*)(ws + WS_KPE), SS_CQ, SS_CKV, ROPE_M, 1.f / (XN_I8 * W_I8)};
          pg8::gemm_phase<EpiGates, SchedProj, false, true, false, 1, false, true>(lds + RING_OFF, 2048, 2048, 2048, S, E, MK_TID(), skip_epi); }
    }
    SEAM(1);

    if (IN(2)) { asm volatile("; MKPHASE 2" ::: "memory"); PHASE_IDS();
        { SchedTile S; S.ord.init(NTOK / 256, 1536 / 256, G, vcu); S.Ab = (const char*)CQ; S.Bb = (const char*)WUQ_T; S.tA = (size_t)256 * 512; S.tB = (size_t)256 * 512;
          EpiQup E{QM, SS_CQ, ROPE_M}; pg8::gemm_phase<EpiQup, SchedTile, false, true, false, 1>(lds + RING_OFF, 512, 512, 512, S, E, MK_TID(), skip_epi); }
        { SchedBal S{G, vcu, (const char*)CKV, (const char*)WUKV_T, (size_t)256 * 256, (size_t)256 * 256};
          EpiKVup E{KM, VM, SS_CKV}; pg8::gemm_phase<EpiKVup, SchedBal, false, true, false, 1>(lds + RING_OFF, 256, 256, 256, S, E, MK_TID(), skip_epi); }
    }
    SEAM(2);

    if (IN(3)) { asm volatile("; MKPHASE 3" ::: "memory"); PHASE_IDS();
        char* al = (char*)lds_raw + RING_OFF;
        const float lam = __uint_as_float(__builtin_amdgcn_readfirstlane(__hip_atomic_load((const unsigned*)SCAL, RLX_AGENT)));
        for (int L = vcu; L < 1024; L += G) {
            att::f32x16 o[4];
            if (MK_P3_DIFF && L < 512) {
                int tl = MK_TID(); asm volatile("" : "+v"(tl));
                const int bh = L >> 3, qb = L & 7, b = bh >> 3, h = bh & 7; const size_t tok0 = (size_t)b * SEQ + qb * 256;
                LAS unsigned* stash = (LAS unsigned*)(lds + 65536);
                att::attn_core<64, 2>(QD + tok0 * 1024 + (2 * h) * 64, 1024, KD + (size_t)b * SEQ * 1024 + (2 * h) * 64, 1024, VD + (size_t)b * SEQ * 1024 + h * 128, 1024, SEQ, al, o, tl);
#pragma unroll
                for (int d0 = 0; d0 < 4; ++d0)
#pragma unroll
                    for (int r = 0; r < 16; r += 2) stash[(d0 * 8 + (r >> 1)) * 512 + tl] = pg8::cvt_pk_bf16(o[d0][r], o[d0][r + 1]);
                int tl2 = tl; asm volatile("" : "+v"(tl2)); const int r32b = tl2 & 31, hhb = (tl2 >> 5) & 1, twb = tl2 >> 6;
                att::attn_core<64, 2>(QD + tok0 * 1024 + (2 * h + 1) * 64, 1024, KD + (size_t)b * SEQ * 1024 + (2 * h + 1) * 64, 1024, VD + (size_t)b * SEQ * 1024 + h * 128, 1024, SEQ, al, o, tl2);
                float q[16];
#pragma unroll
                for (int r = 0; r < 16; ++r) q[r] = 0.f;
#pragma unroll
                for (int d0 = 0; d0 < 4; ++d0)
#pragma unroll
                    for (int r = 0; r < 16; r += 2) { const unsigned w = stash[(d0 * 8 + (r >> 1)) * 512 + tl2];
                        o[d0][r] = pg8::bf_lo(w) - lam * o[d0][r]; o[d0][r + 1] = pg8::bf_hi(w) - lam * o[d0][r + 1]; q[r] += o[d0][r] * o[d0][r]; q[r + 1] += o[d0][r + 1] * o[d0][r + 1]; }
#pragma unroll
                for (int r = 0; r < 16; ++r) { float s = q[r];
#define SWZ_ADD(m) s += __int_as_float(__builtin_amdgcn_ds_swizzle(__float_as_int(s), ((m) << 10) | 0x1f))
                    SWZ_ADD(1); SWZ_ADD(2); SWZ_ADD(4); SWZ_ADD(8); SWZ_ADD(16);
#undef SWZ_ADD
                    q[r] = rsqrtf(s * (1.f / 128.f) + 1e-5f) * 0.8f; }
#pragma unroll
                for (int d0 = 0; d0 < 4; ++d0) { const float g = ap->subln_g[d0 * 32 + r32b];
#pragma unroll
                    for (int r = 0; r < 16; ++r) o[d0][r] *= q[r] * g; }
                store_o_bf16(o, QD + tok0 * 1024 + h * 128, 1024, twb, r32b, hhb);
                __syncthreads();
            } else if (MK_P3_MLA) {
                int tl = MK_TID(); asm volatile("" : "+v"(tl));
                const int L2 = L - 512, bh = L2 >> 3, qb = L2 & 7, b = bh >> 3, h = bh & 7; const size_t tok0 = (size_t)b * SEQ + qb * 256;
                att::attn_core_f8<3, true>((const unsigned char*)QM + tok0 * 1536 + h * 192, 1536, (const unsigned char*)KM + (size_t)b * SEQ * 1024 + h * 128, 1024, ws + WS_KPE + (size_t)b * SEQ * 64, (const unsigned char*)VM + (size_t)b * SEQ * 1024 + h * 128, 1024, SEQ, al, o, tl, MLA_SCA, MLA_SCB, MLA_SCV, MLA_SCP);
                int tl3 = tl; asm volatile("" : "+v"(tl3));
                store_ot_fp8(o, (unsigned char*)OB + tok0 * 2048 + h * 128, 2048, tl3 >> 6, tl3 & 31, (tl3 >> 5) & 1, 8.f);
            }
        }
    }
    SEAM(3);

    if (IN(4)) { asm volatile("; MKPHASE 4" ::: "memory"); PHASE_IDS();
        SchedGate S; S.ord.init(NTOK / 256, 2048 / 256, G, bx); S.A0 = (const char*)QD; S.A1 = (const char*)OB; S.B0 = (const char*)WOA_T; S.B1 = (const char*)WOB_T; S.tA = (size_t)256 * 1024 * 2; S.tB = (size_t)256 * 1024 * 2;
        EpiGate E{SGA, SGB, MG};
        pg8::gemm_phase<EpiGate, SchedGate, false, true, true, 2, true>(lds + RING_OFF, 1024, 1024, 1024, S, E, MK_TID(), skip_epi);
    }
    SEAM(4);

    if (IN(5)) { asm volatile("; MKPHASE 5" ::: "memory"); PHASE_IDS();
        const bool conv_first = (G != 256) || (((vcu >> 5) & 1) == 0);
        const int nconv = (G == 256) ? MOE_GU_P5 : MOE_N_GU;
        if (conv_first) { moe_conv_run<0>(gw, nconv, NGW, ap, ws, scr, lane); __syncthreads(); }
        { SchedTile S; S.ord.init(NTOK / 256, 2048 / 256, G, bx); S.Ab = (const char*)MG; S.Bb = (const char*)WOUT_T; S.tA = (size_t)256 * 2048; S.tB = (size_t)256 * 2048;
          EpiResid<true, true> E{HB, HB, SS_H1, ws + WS_H8, 1.f / (MG_SCALE * WOUT_SCALE)};
          pg8::gemm_phase<EpiResid<true, true>, SchedTile, false, true, false, 1, false, true>(lds + RING_OFF, 2048, 2048, 2048, S, E, MK_TID(), skip_epi); }
        if (!conv_first) { __syncthreads(); moe_conv_run<0>(gw, nconv, NGW, ap, ws, scr, lane); }
    }
    SEAM(5);

    if (IN(6)) { asm volatile("; MKPHASE 6" ::: "memory"); PHASE_IDS();
        if (bx < 128 || G != 256) {
            SchedTile S; S.ord.init(NTOK / 256, 512 / 256, G, bx); S.Ab = (const char*)(ws + WS_H8); S.Bb = (const char*)(ws + WS_WCQ8); S.tA = (size_t)256 * 2048; S.tB = (size_t)256 * 2048;
            EpiPlain E{QC, 512, SS_H1, 1.f / 2048.f, C2C * MLA_QS / WIN_SCALE, 1};
            pg8::gemm_phase<EpiPlain, SchedTile, false, true, false, 1>(lds + RING_OFF, 2048, 2048, 2048, S, E, MK_TID(), skip_epi);
        }
        if (G != 256 || (bx >= 128 && bx < 160)) {
            SchedOff S{1024 / 256, NB * MEML / 256 * 4, G == 256 ? bx - 128 : bx, (const char*)(ws + WS_MEMN8), (const char*)(ws + WS_WCKV8), (size_t)256 * 2048, (size_t)256 * 2048};
            EpiPlain E{KVC, 1024, nullptr, 0.f, MLA_KS / WIN_SCALE, 1}; pg8::gemm_phase<EpiPlain, SchedOff, false, true, false, 1>(lds + RING_OFF, 2048, 2048, 2048, S, E, MK_TID(), skip_epi);
        }
        if (G == 256 && bx >= 160) moe_conv_run<0>(MOE_GU_P5 + (bx - 160) * NWAVES + wave, MOE_N_GU, 96 * NWAVES, ap, ws, scr, lane);
    }
    SEAM(6);

    if (IN(7)) { asm volatile("; MKPHASE 7" ::: "memory"); PHASE_IDS();
        char* al = (char*)lds_raw + RING_OFF;
        for (int L = vcu; L < 256; L += G) {
            const int bh = L >> 3, qb = L & 7, b = bh >> 2, h = bh & 3; const size_t tok0 = (size_t)b * SEQ + qb * 256;
            att::f32x16 o[4]; int tl = MK_TID(); asm volatile("" : "+v"(tl));
            att::attn_core_f8<2, false>((const unsigned char*)QC + tok0 * 512 + h * 128, 512, (const unsigned char*)KVC + (size_t)b * MEML * 1024 + h * 128, 1024, nullptr, (const unsigned char*)KVC + (size_t)b * MEML * 1024 + 512 + h * 128, 1024, MEML, al, o, tl, MLA_SCA, MLA_SCB, MLA_SCV, MLA_SCP);
            int tl3 = tl; asm volatile("" : "+v"(tl3));
            store_ot_fp8(o, (unsigned char*)OC + tok0 * 512 + h * 128, 512, tl3 >> 6, tl3 & 31, (tl3 >> 5) & 1, 8.f);
        }
    }
    SEAM(7);

    if (IN(8)) { asm volatile("; MKPHASE 8" ::: "memory"); PHASE_IDS();
        SchedTile S; S.ord.init(NTOK / 256, 2048 / 256, G, bx); S.Ab = (const char*)OC; S.Bb = (const char*)WCO_T; S.tA = (size_t)256 * 512; S.tB = (size_t)256 * 512;
        EpiResid<true> E{HB, HB, nullptr, ws + WS_H8, 1.f / 512.f};
        pg8::gemm_phase<EpiResid<true>, SchedTile, false, true, false, 1>(lds + RING_OFF, 512, 512, 512, S, E, MK_TID(), skip_epi);
    }
    SEAM(8);

    if (IN(9)) { asm volatile("; MKPHASE 9" ::: "memory"); PHASE_IDS();
        const int tg = wave & 1, kq4 = wave >> 1;
        LAS float* rbias = (LAS float*)(lds + RING_OFF + 65536);
        if (wave == 0 && lane < 36) rbias[lane] = lane < 4 ? ap->b_rg[lane] : ap->b_re[lane - 4];
        LAS float* lgb = (LAS float*)(lds + RING_OFF + tg * 32768);
        LAS float* lg = lgb + kq4 * 1600;
        for (int grp = vcu * 2 + tg; grp < NTOK / 32; grp += G * 2) {
            const int row = lane & 15, kq = lane >> 4, tok0 = grp * 32;
            const GAS u32x4* hp0 = (const GAS u32x4*)(HB + (size_t)(tok0 + row) * DM + kq4 * (DM / 4)) + kq; const GAS u32x4* hp1 = hp0 + 16 * DM / 8;
            const GAS u32x4* wh = (const GAS u32x4*)((const bf16*)WR_T + (size_t)row * DM + kq4 * (DM / 4)) + kq;
            const GAS u32x4* wl = wh + 48 * DM / 8;
            f32x4 c[2][3]; float ss0 = 0.f, ss1 = 0.f;
#pragma unroll
            for (int i = 0; i < 2; ++i)
#pragma unroll
                for (int j = 0; j < 3; ++j) c[i][j] = (f32x4){0.f, 0.f, 0.f, 0.f};
#pragma unroll 4
            for (int ks = 0; ks < DM / 128; ++ks) { const u32x4 aw0 = hp0[ks * 4], aw1 = hp1[ks * 4];
                u32x4 bh[3], bl[3];
#pragma unroll
                for (int j = 0; j < 3; ++j) { bh[j] = wh[ks * 4 + j * 16 * DM / 8]; bl[j] = wl[ks * 4 + j * 16 * DM / 8]; }
#define SSQ(W) (((pg8::bf_lo(W.x) * pg8::bf_lo(W.x) + pg8::bf_hi(W.x) * pg8::bf_hi(W.x)) + (pg8::bf_lo(W.y) * pg8::bf_lo(W.y) + pg8::bf_hi(W.y) * pg8::bf_hi(W.y))) + ((pg8::bf_lo(W.z) * pg8::bf_lo(W.z) + pg8::bf_hi(W.z) * pg8::bf_hi(W.z)) + (pg8::bf_lo(W.w) * pg8::bf_lo(W.w) + pg8::bf_hi(W.w) * pg8::bf_hi(W.w))))
                ss0 += SSQ(aw0); ss1 += SSQ(aw1);
#undef SSQ
                const bf16x8 af0 = __builtin_bit_cast(bf16x8, aw0), af1 = __builtin_bit_cast(bf16x8, aw1);
#pragma unroll
                for (int j = 0; j < 3; ++j) { const bf16x8 fh = __builtin_bit_cast(bf16x8, bh[j]), fl = __builtin_bit_cast(bf16x8, bl[j]);
                    c[0][j] = __builtin_amdgcn_mfma_f32_16x16x32_bf16(af0, fh, c[0][j], 0, 0, 0); c[0][j] = __builtin_amdgcn_mfma_f32_16x16x32_bf16(af0, fl, c[0][j], 0, 0, 0);
                    c[1][j] = __builtin_amdgcn_mfma_f32_16x16x32_bf16(af1, fh, c[1][j], 0, 0, 0); c[1][j] = __builtin_amdgcn_mfma_f32_16x16x32_bf16(af1, fl, c[1][j], 0, 0, 0); } }
            ss0 += __shfl_xor(ss0, 16); ss0 += __shfl_xor(ss0, 32); ss1 += __shfl_xor(ss1, 16); ss1 += __shfl_xor(ss1, 32);
#pragma unroll
            for (int mb = 0; mb < 2; ++mb)
#pragma unroll
                for (int t = 0; t < 4; ++t) { const int i = 16 * mb + 4 * kq + t;
#pragma unroll
                    for (int j = 0; j < 3; ++j) lg[i * 48 + 16 * j + row] = c[mb][j][t]; }
            if (kq == 0) { lg[1536 + row] = ss0; lg[1536 + 16 + row] = ss1; }
            __syncthreads();
            if (kq4 == 0) {
                const int tl = lane & 31; const LAS float* l = lgb + tl * 48;
                const float rs = rsqrtf(((lgb[1536 + tl] + lgb[1600 + 1536 + tl]) + (lgb[3200 + 1536 + tl] + lgb[4800 + 1536 + tl])) * (1.f / DM) + 1e-6f);
#define LG(j) (((l[j] + l[1600 + (j)]) + (l[3200 + (j)] + l[4800 + (j)])) * rs)
                int g = 0; float gm = LG(0) + rbias[0];
                for (int j = 1; j < 4; ++j) { const float v = LG(j) + rbias[j]; if (v > gm) { gm = v; g = j; } }
                float gs = 0.f; for (int j = 0; j < 4; ++j) gs += expf(LG(j) + rbias[j] - gm); const float gp = 1.f / gs;
                int i0 = 0; float m0 = LG(4 + g * 8) + rbias[4 + g * 8];
                for (int j = 1; j < 8; ++j) { const float v = LG(4 + g * 8 + j) + rbias[4 + g * 8 + j]; if (v > m0) { m0 = v; i0 = j; } }
                int i1 = 0; float m1 = -3.0e38f;
                for (int j = 0; j < 8; ++j) { const float v = LG(4 + g * 8 + j) + rbias[4 + g * 8 + j]; if (j != i0 && v > m1) { m1 = v; i1 = j; } }
#undef LG
                const float p1 = expf(m1 - m0), w0 = 1.f / (1.f + p1), w1 = p1 / (1.f + p1);
                const int second = lane >> 5, e = g * 8 + (second ? i1 : i0), tk = tok0 + tl;
                int rank = 0, run = 0, lead = 0;
#pragma unroll 1
                for (int x = 0; x < 32; ++x) { const unsigned long long mk_ = __ballot(e == x);
                    if (e == x) { rank = __popcll(mk_ & ((1ull << lane) - 1ull)); run = __popcll(mk_); lead = __ffsll((long long)mk_) - 1; } }
                int base = 0; if (lane == lead) base = (int)__hip_atomic_fetch_add(ctl + CW_CNT + 16 * e, (unsigned)run, RLX_AGENT);
                base = __shfl(base, lead); const int slot = base + rank;
                LIST[e * NTOK + slot] = tk; LISTR[e * NTOK + slot] = rs;
                TOKES[tk * 2 + second] = (e << 16) | slot; TOKW[tk * 2 + second] = gp * (second ? w1 : w0);
            }
            __syncthreads();
        }
    }
    SEAM(9);
    LAS int* tpre = (LAS int*)(lds + LDSCTL_OFF); LAS int* ecnt = (LAS int*)(lds + LDSCTL_OFF + 160);
    if (hi > 10 && lo <= 12) { gu32* const ctl = (gu32*)argp()->ws;
        if (MK_TID() == 0) { int s = 0; for (int e = 0; e < 32; ++e) { const int c = (int)__hip_atomic_load(ctl + CW_CNT + 16 * e, RLX_AGENT); ecnt[e] = c; tpre[e] = s; s += (c + 255) >> 8; } tpre[32] = s; }
        __syncthreads();
    }
    const MoeTab tab{tpre, ecnt};

    if (IN(10)) { asm volatile("; MKPHASE 10" ::: "memory"); PHASE_IDS();
        SchedMoe1 S{tab, G, vcu, (const char*)(ws + WS_H8), (const char*)WGU_T, LIST};
        EpiHid E{HID, LISTR, ecnt};
        pg8::gemm_phase<EpiHid, SchedMoe1, true, true, false, 1>(lds + RING_OFF, 2048, 2048, 2048, S, E, MK_TID(), skip_epi);
        { const int U = tab.tpre[32] * 4, R = (U + G - 1) / G, first_light = U - (R - 1) * G, n_light = G - first_light;
          __syncthreads();
          if (n_light >= 32) { if (vcu >= first_light) moe_conv_run<1>((vcu - first_light) * NWAVES + wave, MOE_N_DN, n_light * NWAVES, ap, ws, scr, lane); }
          else moe_conv_run<1>(gw, MOE_N_DN, NGW, ap, ws, scr, lane); }
    }
    SEAM(10);

    if (IN(11)) { asm volatile("; MKPHASE 11" ::: "memory"); PHASE_IDS();
        SchedMoe2 S{tab, G, vcu, (const char*)HID, (const char*)WD_T};
        EpiDown E{Y, tab, Y_SCALE / (HID_SCALE * WD_SCALE)};
        pg8::gemm_phase<EpiDown, SchedMoe2, false, true, false, 1>(lds + RING_OFF, 512, 512, 512, S, E, MK_TID(), skip_epi);
    }
    SEAM(11);

    if (IN(12)) { asm volatile("; MKPHASE 12" ::: "memory"); PHASE_IDS();
        for (int tokA = gw; tokA < NTOK; tokA += 2 * NGW) {
            const int tokB = tokA + NGW; const bool hasB = tokB < NTOK; const int tb = hasB ? tokB : tokA;
            const int a0 = TOKES[tokA * 2], a1 = TOKES[tokA * 2 + 1], b0 = TOKES[tb * 2], b1 = TOKES[tb * 2 + 1];
            const float wa0 = TOKW[tokA * 2] * (1.f / Y_SCALE), wa1 = TOKW[tokA * 2 + 1] * (1.f / Y_SCALE), wb0 = TOKW[tb * 2] * (1.f / Y_SCALE), wb1 = TOKW[tb * 2 + 1] * (1.f / Y_SCALE);
            const size_t ra0 = (size_t)tpre[a0 >> 16] * 256 + (a0 & 0xffff), ra1 = (size_t)tpre[a1 >> 16] * 256 + (a1 & 0xffff), rb0 = (size_t)tpre[b0 >> 16] * 256 + (b0 & 0xffff), rb1 = (size_t)tpre[b1 >> 16] * 256 + (b1 & 0xffff);
            const GAS u32x2* hA = (const GAS u32x2*)(HB + (size_t)tokA * DM) + lane; const GAS unsigned* yA0 = (const GAS unsigned*)((const unsigned char*)Y + ra0 * DM) + lane; const GAS unsigned* yA1 = (const GAS unsigned*)((const unsigned char*)Y + ra1 * DM) + lane;
            const GAS u32x2* hB = (const GAS u32x2*)(HB + (size_t)tb * DM) + lane; const GAS unsigned* yB0 = (const GAS unsigned*)((const unsigned char*)Y + rb0 * DM) + lane; const GAS unsigned* yB1 = (const GAS unsigned*)((const unsigned char*)Y + rb1 * DM) + lane;
            const GAS f32x4* gp = (const GAS f32x4*)ap->final_norm_g + lane;
            u32x2 hwA[8], hwB[8]; unsigned pA[8], qA[8], pB[8], qB[8];
#pragma unroll
            for (int j = 0; j < 8; ++j) { hwA[j] = hA[64 * j]; pA[j] = yA0[64 * j]; qA[j] = yA1[64 * j]; }
#pragma unroll
            for (int j = 0; j < 8; ++j) { hwB[j] = hB[64 * j]; pB[j] = yB0[64 * j]; qB[j] = yB1[64 * j]; }
#define P12_ONE(TOK, HW, PP, QQ, W0, W1) do { f32x4 v[8]; float s_ = 0.f; \
            _Pragma("unroll") for (int j = 0; j < 8; ++j) { f32x4 t = {pg8::bf_lo(HW[j].x), pg8::bf_hi(HW[j].x), pg8::bf_lo(HW[j].y), pg8::bf_hi(HW[j].y)}; \
                { const auto p01 = __builtin_amdgcn_cvt_pk_f32_fp8((int)PP[j], false), p23 = __builtin_amdgcn_cvt_pk_f32_fp8((int)PP[j], true), q01 = __builtin_amdgcn_cvt_pk_f32_fp8((int)QQ[j], false), q23 = __builtin_amdgcn_cvt_pk_f32_fp8((int)QQ[j], true); \
                  t[0] += W0 * p01[0] + W1 * q01[0]; t[1] += W0 * p01[1] + W1 * q01[1]; t[2] += W0 * p23[0] + W1 * q23[0]; t[3] += W0 * p23[1] + W1 * q23[1]; } \
                v[j] = t; s_ += (t[0] * t[0] + t[1] * t[1]) + (t[2] * t[2] + t[3] * t[3]); } \
            const float rstd_ = rsqrtf(wave_sum(s_) * (1.f / DM) + 1e-6f); GAS f32x4* op_ = (GAS f32x4*)(ap->out + (size_t)(TOK) * DM) + lane; \
            _Pragma("unroll") for (int j = 0; j < 8; ++j) op_[64 * j] = v[j] * rstd_ * gp[64 * j]; } while (0)
            P12_ONE(tokA, hwA, pA, qA, wa0, wa1);
            if (hasB) P12_ONE(tokB, hwB, pB, qB, wb0, wb1);
#undef P12_ONE
        }
    }
#undef IN
#undef SEAM
}

static int g_grid = 0;
static bool launch_fused(const Args& a0, int ph_lo, int ph_hi, hipStream_t stream, size_t ws_size) {
    if (g_grid == 0) {
        int dev = 0, cus = 0, per_cu = 0;
        if (ws_size < WS_END) { fprintf(stderr, "kernel_launch: workspace too small: %zu < %zu\n", ws_size, (size_t)WS_END); g_grid = -1; return false; }
        if (hipGetDevice(&dev) != hipSuccess || hipDeviceGetAttribute(&cus, hipDeviceAttributeMultiprocessorCount, dev) != hipSuccess) { g_grid = -1; return false; }
        if (hipFuncSetAttribute((const void*)fused_fwd, hipFuncAttributeMaxDynamicSharedMemorySize, LDS_BYTES) != hipSuccess) { fprintf(stderr, "kernel_launch: hipFuncSetAttribute failed\n"); g_grid = -1; return false; }
        if (hipOccupancyMaxActiveBlocksPerMultiprocessor(&per_cu, (const void*)fused_fwd, NWAVES * 64, LDS_BYTES) != hipSuccess || per_cu < 1) { fprintf(stderr, "kernel_launch: occupancy query reports %d blocks per CU\n", per_cu); (void)hipGetLastError(); g_grid = -1; return false; }
        g_grid = cus;
    }
    if (g_grid < 0) return false;
    Args a = a0; a.ph_lo = ph_lo; a.ph_hi = ph_hi;
    hipLaunchKernelGGL(fused_fwd, dim3(g_grid), dim3(NWAVES * 64), LDS_BYTES, stream, a);
    return true;
}
static Args make_args(void* const* d_in, void* d_out, void* d_ws) {
    Args a{}; int k = 0;
    a.x = (const float*)d_in[k++]; a.mem = (const float*)d_in[k++]; a.positions = (const int*)d_in[k++]; a.attn_norm_g = (const float*)d_in[k++]; a.w_in = (const float*)d_in[k++];
    a.lq1 = (const float*)d_in[k++]; a.lk1 = (const float*)d_in[k++]; a.lq2 = (const float*)d_in[k++]; a.lk2 = (const float*)d_in[k++]; a.subln_g = (const float*)d_in[k++]; a.w_o_diff = (const float*)d_in[k++];
    a.mla_q_norm_g = (const float*)d_in[k++]; a.w_uq = (const float*)d_in[k++]; a.mla_kv_norm_g = (const float*)d_in[k++]; a.w_ukv = (const float*)d_in[k++]; a.w_o_mla = (const float*)d_in[k++]; a.w_out = (const float*)d_in[k++];
    a.cross_norm_g = (const float*)d_in[k++]; a.mem_norm_g = (const float*)d_in[k++]; a.w_cq = (const float*)d_in[k++]; a.w_ckv = (const float*)d_in[k++]; a.w_co = (const float*)d_in[k++];
    a.ffn_norm_g = (const float*)d_in[k++]; a.w_rg = (const float*)d_in[k++]; a.b_rg = (const float*)d_in[k++]; a.w_re = (const float*)d_in[k++]; a.b_re = (const float*)d_in[k++];
    a.w_gate = (const float*)d_in[k++]; a.w_up = (const float*)d_in[k++]; a.w_down = (const float*)d_in[k++]; a.final_norm_g = (const float*)d_in[k++];
    a.out = (float*)d_out; a.ws = (unsigned char*)d_ws; a.ph_lo = 0; a.ph_hi = N_PHASES;
    return a;
}
#undef WIN_T
#undef WOA_T
#undef WOB_T
#undef WOUT_T
#undef WUQ_T
#undef WUKV_T
#undef WCQ_T
#undef WCKV_T
#undef WCO_T
#undef XN
#undef QM
#undef MG
#undef QD
#undef KD
#undef VD
#undef CQ
#undef CKV
#undef SGA
#undef SGB
#undef KM
#undef VM
#undef OB
#undef MEMN
#undef KVC
#undef HB
#undef QC
#undef OC
#undef WGU_T
#undef WD_T
#undef HID
#undef Y
#undef SS_CQ
#undef SS_CKV
#undef SS_H1
#undef ROPE_D
#undef ROPE_M
#undef WR_T
#undef TOKES
#undef TOKW
#undef SCAL
#undef LIST
#undef LISTR
}
extern "C" void kernel_launch(void* const* d_in, const int* in_sizes, int n_in, void* d_out, int out_size, void* d_ws, size_t ws_size, hipStream_t stream) {
    if (n_in != 31 || out_size != mk::NTOK * mk::DM) { fprintf(stderr, "kernel_launch: unexpected n_in %d / out_size %d\n", n_in, out_size); return; }
    const mk::Args a = mk::make_args(d_in, d_out, d_ws);
    if (hipMemsetAsync((char*)d_ws + mk::WS_CTL, 0, mk::CTL_ZERO_BYTES, stream) != hipSuccess) return;
    mk::launch_fused(a, 0, mk::N_PHASES, stream, ws_size);
}
```

```cpp
#include <hip/hip_runtime.h>
#include <stdint.h>
#include <stdio.h>
namespace pg8 {
constexpr int MIXED_SA = 0x7c7c7c7c, MIXED_SB = 0x79797979;
#define PG8_LAS __attribute__((address_space(3)))
typedef unsigned short bf16_t;
typedef short bf16x8 __attribute__((ext_vector_type(8)));
typedef float f32x4 __attribute__((ext_vector_type(4)));
typedef float f32x2 __attribute__((ext_vector_type(2)));
typedef unsigned u32x4 __attribute__((ext_vector_type(4)));
typedef unsigned u32x2 __attribute__((ext_vector_type(2)));
typedef int i32x4 __attribute__((ext_vector_type(4)));
typedef int i32x8 __attribute__((ext_vector_type(8)));
constexpr int BM = 256, BK = 64, HALF = 128, HTB = HALF * BK * 2  , STAGE_BYTES = 8 * HTB, NXCD = 8, WGM = 8;

__host__ __device__ __forceinline__ int lds_byte(int r, int c) { const int st = (r >> 4) * 2 + (c >> 5), rr = r & 15, cc = c & 31, ob = rr * 64 + cc * 2; return st * 1024 + (ob ^ (((ob >> 9) & 1) << 5)); }
__host__ __device__ __forceinline__ void stage_rc(int b, int& R, int& C) { const int st = b / 1024, sb = b % 1024, swz = sb ^ (((sb >> 9) & 1) << 5); R = (st >> 1) * 16 + swz / 64; C = (st & 1) * 32 + (swz % 64) / 2; }
__host__ __device__ __forceinline__ int perm32(int rho) { const int n = rho >> 4, i = rho & 15; return 8 * (i >> 2) + 4 * n + (i & 3); }

struct Unit { int pm, pn, z; };

struct TileOrder {
    int nM, nN, nwg, G, c;
    __host__ __device__ void init(int nM_, int nN_, int G_, int c_) { nM = nM_; nN = nN_; nwg = nM * nN; G = G_; c = c_; }
    __host__ __device__ bool tile(int i, int& pm, int& pn) const {
        const long L = (long)i * G + c; if (L >= nwg) return false;
        int wgid = (int)L; { const int q = nwg / NXCD, r = nwg % NXCD, xcd = wgid % NXCD, off = wgid / NXCD; wgid = (xcd < r ? xcd * (q + 1) : r * (q + 1) + (xcd - r) * q) + off; }
        const int nig = WGM * nN, gid = wgid / nig, fm = gid * WGM, gsz = (nM - fm) < WGM ? (nM - fm) : WGM;
        pm = fm + ((wgid % nig) % gsz); pn = (wgid % nig) / gsz; return true;
    }
};

typedef __bf16 bf16x2_hw __attribute__((ext_vector_type(2)));
__device__ __forceinline__ unsigned cvt_pk_bf16(float lo, float hi) { const f32x2 v = {lo, hi}; return __builtin_bit_cast(unsigned, __builtin_convertvector(v, bf16x2_hw)); }
__device__ __forceinline__ u32x4 pack8(const f32x4 a, const f32x4 b) { u32x4 w; w.x = cvt_pk_bf16(a[0], a[1]); w.y = cvt_pk_bf16(a[2], a[3]); w.z = cvt_pk_bf16(b[0], b[1]); w.w = cvt_pk_bf16(b[2], b[3]); return w; }
__device__ __forceinline__ unsigned pack4_fp8(float a, float b, float c, float d) { int w = __builtin_amdgcn_cvt_pk_fp8_f32(a, b, 0, false); w = __builtin_amdgcn_cvt_pk_fp8_f32(c, d, w, true); return (unsigned)w; }
__device__ __forceinline__ float bf_lo(unsigned w) { return __uint_as_float(w << 16); }
__device__ __forceinline__ float bf_hi(unsigned w) { return __uint_as_float(w & 0xffff0000u); }

template <class Epi, class Sched, bool GATHER = false, bool ALIGN_EPI = true, bool CHAIN = false, int EB = 2, bool MIXED = false, bool I8 = false>
__device__ __forceinline__ void gemm_phase(PG8_LAS unsigned char* lds, const int K, const int lda, const int ldb, const Sched& S, const Epi& E, const int tid_in, const bool skip_epi = false) {
    int tid = tid_in; asm volatile("" : "+v"(tid));
    const int wid = __builtin_amdgcn_readfirstlane(tid >> 6), lane = tid & 63, wr = wid >> 2, wc = wid & 3, fr = lane & 15, fq = lane >> 4;
    int nt = K * EB / (BK * 2); if constexpr (EB == 1) asm volatile("" : "+s"(nt));
    int sR[2], sC[2];
    unsigned voA[2][2], nvoA[2][2], voffB[2];
#pragma unroll
    for (int i = 0; i < 2; ++i) { int R, C; stage_rc(tid * 16 + i * 8192, R, C); sR[i] = R; sC[i] = C; const int Rb = Epi::PERM ? ((R & ~31) + perm32(R & 31)) : R;
        voffB[i] = (unsigned)(Rb * ldb * EB + C * 2);
#pragma unroll
        for (int h = 0; h < 2; ++h) { voA[h][i] = (unsigned)((R + h * HALF) * lda * EB + C * 2); nvoA[h][i] = voA[h][i]; } }
    const size_t kstep = (size_t)(BK * 2);
    const size_t hstepB = (size_t)HALF * ldb * EB;
    const unsigned ldsw = (unsigned)wid * 1024u;
    const int aoff = lds_byte(wr * 64 + fr, fq * 8), boff = lds_byte(wc * 32 + fr, fq * 8);
#define PG8_SA(b, h) (((b) * 2 + (h)) * HTB)
#define PG8_SB(b, h) ((4 + (b) * 2 + (h)) * HTB)
#define PG8_STAGEB(bufoff, gbase) do { _Pragma("unroll") for (int _i = 0; _i < 2; ++_i) \
        __builtin_amdgcn_global_load_lds((const unsigned*)((const char*)(gbase) + voffB[_i]), (PG8_LAS unsigned*)(lds + (bufoff) + ldsw + _i * 8192), 16, 0, 0); } while (0)
#define PG8_STAGEA(bufoff, gbase, h, nx) do { _Pragma("unroll") for (int _i = 0; _i < 2; ++_i) { const unsigned _vo = (GATHER && (nx)) ? nvoA[h][_i] : voA[h][_i]; \
        __builtin_amdgcn_global_load_lds((const unsigned*)((const char*)(gbase) + _vo), (PG8_LAS unsigned*)(lds + (bufoff) + ldsw + _i * 8192), 16, 0, 0); } } while (0)
#define PG8_LDA(dst, b, h) do { _Pragma("unroll") for (int m = 0; m < 4; ++m) _Pragma("unroll") for (int k = 0; k < 2; ++k) dst[m][k] = *(const PG8_LAS bf16x8*)(lds + PG8_SA(b, h) + aoff + m * 2048 + k * 1024); } while (0)
#define PG8_LDB(dst, b, h) do { _Pragma("unroll") for (int n = 0; n < 2; ++n) _Pragma("unroll") for (int k = 0; k < 2; ++k) dst[n][k] = *(const PG8_LAS bf16x8*)(lds + PG8_SB(b, h) + boff + n * 2048 + k * 1024); } while (0)
#define PG8_MMAF(FL, ai, bj, At, Bt) do { __builtin_amdgcn_s_setprio(1); if constexpr ((FL) == 2) { _Pragma("unroll") for (int m = 0; m < 4; ++m) _Pragma("unroll") for (int n = 0; n < 2; ++n) { _Pragma("unroll") for (int k = 0; k < 2; ++k) \
            acc[ai][bj][m][n] = __builtin_bit_cast(f32x4, __builtin_amdgcn_mfma_i32_16x16x64_i8(__builtin_bit_cast(i32x4, Bt[n][k]), __builtin_bit_cast(i32x4, At[m][k]), __builtin_bit_cast(i32x4, acc[ai][bj][m][n]), 0, 0, 0)); } \
          _Pragma("unroll") for (int m = 0; m < 4; ++m) _Pragma("unroll") for (int n = 0; n < 2; ++n) asm volatile("" : "+v"(acc[ai][bj][m][n])); } \
      else if constexpr ((FL) == 1) { _Pragma("unroll") for (int m = 0; m < 4; ++m) _Pragma("unroll") for (int n = 0; n < 2; ++n) { i32x8 _a, _b; \
            { const i32x4 _b0 = __builtin_bit_cast(i32x4, Bt[n][0]), _b1 = __builtin_bit_cast(i32x4, Bt[n][1]), _a0 = __builtin_bit_cast(i32x4, At[m][0]), _a1 = __builtin_bit_cast(i32x4, At[m][1]); \
              _b = (i32x8){_b0[0], _b0[1], _b0[2], _b0[3], _b1[0], _b1[1], _b1[2], _b1[3]}; _a = (i32x8){_a0[0], _a0[1], _a0[2], _a0[3], _a1[0], _a1[1], _a1[2], _a1[3]}; } \
            acc[ai][bj][m][n] = __builtin_amdgcn_mfma_scale_f32_16x16x128_f8f6f4(_b, _a, acc[ai][bj][m][n], 0, 0, 0, MIXED ? MIXED_SB : 0x7f7f7f7f, 0, MIXED ? MIXED_SA : 0x7f7f7f7f); } \
          _Pragma("unroll") for (int m = 0; m < 4; ++m) _Pragma("unroll") for (int n = 0; n < 2; ++n) asm volatile("" : "+v"(acc[ai][bj][m][n])); }     \
        else { _Pragma("unroll") for (int m = 0; m < 4; ++m) _Pragma("unroll") for (int n = 0; n < 2; ++n) { _Pragma("unroll") for (int k = 0; k < 2; ++k) acc[ai][bj][m][n] = __builtin_amdgcn_mfma_f32_16x16x32_bf16(Bt[n][k], At[m][k], acc[ai][bj][m][n], 0, 0, 0); } } \
        __builtin_amdgcn_s_setprio(0); } while (0)
#define PG8_KLOOP(FL, NTU) \
        for (int t = 0; t < (NTU); t += 2) { \
            const bool last = (t == (NTU) - 2); \
            const char* a1 = cA + (size_t)(t + 1) * kstep; \
            const char* a2 = last ? nA : cA + (size_t)(t + 2) * kstep; const char* b2 = last ? nB : cB + (size_t)(t + 2) * kstep; \
            const char* a3 = a2 + kstep; const char* b3 = b2 + kstep; \
            PG8_LDB(B0, 0, 0); PG8_LDB(B1, 0, 1); PG8_SCHED; PG8_LDA(At, 0, 0); PG8_STAGEA(PG8_SA(1, 1), a1, 1, false); \
            PG8_WAIT_V(8); PG8_WAIT_L(0); PG8_BAR; PG8_MMAF(FL, 0, 0, At, B0); PG8_MMAF(FL, 0, 1, At, B1); PG8_BAR; PG8_SCHED; \
            PG8_LDA(At, 0, 1); PG8_STAGEB(PG8_SB(0, 0), b2); PG8_STAGEB(PG8_SB(0, 1), b2 + hstepB); PG8_STAGEA(PG8_SA(0, 0), a2, 0, last); \
            PG8_WAIT_V(8); PG8_WAIT_L(0); PG8_BAR; PG8_MMAF(FL, 1, 0, At, B0); PG8_MMAF(FL, 1, 1, At, B1); PG8_BAR; PG8_SCHED; \
            PG8_LDB(B0, 1, 0); PG8_LDB(B1, 1, 1); PG8_SCHED; PG8_LDA(At, 1, 0); PG8_STAGEA(PG8_SA(0, 1), a2, 1, last); \
            PG8_WAIT_V(8); PG8_WAIT_L(0); PG8_BAR; PG8_MMAF(FL, 0, 0, At, B0); PG8_MMAF(FL, 0, 1, At, B1); PG8_BAR; PG8_SCHED; \
            PG8_LDA(At, 1, 1); PG8_STAGEB(PG8_SB(1, 0), b3); PG8_STAGEB(PG8_SB(1, 1), b3 + hstepB); PG8_STAGEA(PG8_SA(1, 0), a3, 0, last); \
            PG8_WAIT_V(8); PG8_WAIT_L(0); PG8_BAR; PG8_MMAF(FL, 1, 0, At, B0); PG8_MMAF(FL, 1, 1, At, B1); PG8_BAR; PG8_SCHED; \
        }
#define PG8_WAIT_V(n) asm volatile("s_waitcnt vmcnt(" #n ")" ::: "memory")
#define PG8_WAIT_L(n) asm volatile("s_waitcnt lgkmcnt(" #n ")" ::: "memory")
#define PG8_BAR __builtin_amdgcn_s_barrier()
#define PG8_SCHED __builtin_amdgcn_sched_barrier(0)
#define PG8_GATHER_OFFS(dst, unit) do { if constexpr (GATHER) { _Pragma("unroll") for (int _i = 0; _i < 2; ++_i) _Pragma("unroll") for (int _h = 0; _h < 2; ++_h) \
        dst[_h][_i] = (unsigned)(S.arow(unit, sR[_i] + _h * HALF) * lda * EB + sC[_i] * 2); } } while (0)
    Unit cur, nxt; int ui = 0;
    if (!S.next(0, cur)) return;
    f32x4 acc[2][2][4][2];
#pragma unroll
    for (int a = 0; a < 2; ++a)
#pragma unroll
        for (int b = 0; b < 2; ++b)
#pragma unroll
            for (int m = 0; m < 4; ++m)
#pragma unroll
                for (int n = 0; n < 2; ++n) acc[a][b][m][n] = (f32x4){0.f, 0.f, 0.f, 0.f};
    bf16x8 At[4][2], B0[2][2], B1[2][2];
    const char* cA = S.A(cur); const char* cB = S.B(cur);
    PG8_GATHER_OFFS(voA, cur);
    PG8_STAGEB(PG8_SB(0, 0), cB); PG8_STAGEB(PG8_SB(0, 1), cB + hstepB); PG8_STAGEA(PG8_SA(0, 0), cA, 0, false); PG8_STAGEA(PG8_SA(0, 1), cA, 1, false);
    if (wr == 1) PG8_BAR;
    PG8_WAIT_V(2); PG8_BAR;
    PG8_STAGEB(PG8_SB(1, 0), cB + kstep); PG8_STAGEA(PG8_SA(1, 0), cA + kstep, 0, false); PG8_STAGEB(PG8_SB(1, 1), cB + hstepB + kstep);
    PG8_WAIT_V(6); PG8_BAR;
    if constexpr (MIXED) {
      for (;;) {
        { const bool has_next = S.next(ui + 1, nxt); const char* nA = has_next ? S.A(nxt) : cA; const char* nB = has_next ? S.B(nxt) : cB;
          if constexpr (I8) { int nth0 = nt >> 1; asm volatile("" : "+s"(nth0)); PG8_KLOOP(2, nth0) } else { PG8_KLOOP(0, nt) }
          if (wr == 0) PG8_BAR;
          { int le = lane; asm volatile("" : "+v"(le)); E.mid(acc, cur, wr, wc, le & 15, le >> 4); }
          cur = nxt; cA = nA; cB = nB; ++ui;
          if (wr == 1) PG8_BAR; }
        { const bool has_next = S.next(ui + 1, nxt); const char* nA = has_next ? S.A(nxt) : cA; const char* nB = has_next ? S.B(nxt) : cB;
          int nth = nt >> 1; asm volatile("" : "+s"(nth));
          PG8_KLOOP(1, nth)
          if (wr == 0) PG8_BAR;
          { int le = lane; asm volatile("" : "+v"(le)); E(acc, cur, wr, wc, le & 15, le >> 4); }
          if (!has_next) break;
#pragma unroll
          for (int a = 0; a < 2; ++a)
#pragma unroll
            for (int b = 0; b < 2; ++b)
#pragma unroll
                for (int m = 0; m < 4; ++m)
#pragma unroll
                    for (int n = 0; n < 2; ++n) acc[a][b][m][n] = (f32x4){0.f, 0.f, 0.f, 0.f};
          cur = nxt; cA = nA; cB = nB; ++ui;
          if (wr == 1) PG8_BAR; }
      }
    } else
    for (;;) {
        const bool has_next = S.next(ui + 1, nxt);
        const char* nA = has_next ? S.A(nxt) : cA; const char* nB = has_next ? S.B(nxt) : cB;
        if constexpr (GATHER) { if (has_next) { PG8_GATHER_OFFS(nvoA, nxt); } else {
#pragma unroll
            for (int i = 0; i < 2; ++i)
#pragma unroll
                for (int h = 0; h < 2; ++h) nvoA[h][i] = voA[h][i]; } }
        PG8_KLOOP((EB == 1 ? (I8 ? 2 : 1) : 0), nt)
        if constexpr (ALIGN_EPI) { if (wr == 0) PG8_BAR; }
        const bool chained = CHAIN && cur.z == 0;
        { int le = lane; asm volatile("" : "+v"(le));
          if (!skip_epi) { if constexpr (CHAIN) { if (chained) E.mid(acc, cur, wr, wc, le & 15, le >> 4); else E(acc, cur, wr, wc, le & 15, le >> 4); } else E(acc, cur, wr, wc, le & 15, le >> 4); }
          else { _Pragma("unroll") for (int a = 0; a < 2; ++a) _Pragma("unroll") for (int b = 0; b < 2; ++b) _Pragma("unroll") for (int m = 0; m < 4; ++m) _Pragma("unroll") for (int n = 0; n < 2; ++n) asm volatile("" :: "v"(acc[a][b][m][n])); } }
        if (!has_next) break;
        if (!chained) {
#pragma unroll
        for (int a = 0; a < 2; ++a)
#pragma unroll
            for (int b = 0; b < 2; ++b)
#pragma unroll
                for (int m = 0; m < 4; ++m)
#pragma unroll
                    for (int n = 0; n < 2; ++n) acc[a][b][m][n] = (f32x4){0.f, 0.f, 0.f, 0.f};
        }
        cur = nxt; cA = nA; cB = nB; ++ui;
        if constexpr (GATHER) {
#pragma unroll
            for (int i = 0; i < 2; ++i)
#pragma unroll
                for (int h = 0; h < 2; ++h) voA[h][i] = nvoA[h][i]; }
        if constexpr (ALIGN_EPI) { if (wr == 1) PG8_BAR; }
    }
    PG8_WAIT_V(0);
    if constexpr (!ALIGN_EPI) { if (wr == 0) PG8_BAR; }
    PG8_BAR;
#undef PG8_SA
#undef PG8_SB
#undef PG8_STAGEA
#undef PG8_STAGEB
#undef PG8_LDA
#undef PG8_LDB
#undef PG8_MMAF
#undef PG8_KLOOP
#undef PG8_WAIT_V
#undef PG8_WAIT_L
#undef PG8_BAR
#undef PG8_SCHED
#undef PG8_GATHER_OFFS
}
}
namespace att {
using bf16x8 = __attribute__((ext_vector_type(8))) short;
using s16x4  = __attribute__((ext_vector_type(4))) short;
using f32x16 = __attribute__((ext_vector_type(16))) float;
using u32x4  = __attribute__((ext_vector_type(4))) unsigned;
typedef unsigned short bf16_t;
constexpr int NW = 8, QBLK = 32, KVBLK = 64, DV = 128;
constexpr float THR2 = 8.f * 1.4426950408889634f;
#define ATT_SBAR() __builtin_amdgcn_sched_barrier(0)
#ifndef ATT_QKT_SB
#define ATT_QKT_SB 0
#endif
__device__ __forceinline__ int crow(int r, int hi) { return (r & 3) + 8 * (r >> 2) + 4 * hi; }
__device__ __forceinline__ unsigned cvtpk(float lo, float hi) { return pg8::cvt_pk_bf16(lo, hi); }

template <int DQK> __device__ __forceinline__ int kswz(int row, int chunk) {
    if constexpr (DQK == 128) return row * 256 + ((chunk ^ (row & 7)) << 4);
    else return row * (2 * DQK) + ((chunk ^ ((row >> 1) & 7)) << 4);
}
constexpr size_t SHM_V = KVBLK * DV * 2;
template <int DQK> constexpr size_t shm_k() { return (size_t)KVBLK * DQK * 2; }
template <int DQK> constexpr size_t shm_bytes() { return 2 * SHM_V + 2 * shm_k<DQK>() + NW * 64 * 4; }

__device__ __forceinline__ void partialSM(f32x16& p0, f32x16& p1, float& m_reg, float& mn, float& alpha) {
    float pmax = p0[0];
#pragma unroll
    for (int r = 1; r < 16; ++r) pmax = fmaxf(pmax, p0[r]);
#pragma unroll
    for (int r = 0; r < 16; ++r) pmax = fmaxf(pmax, p1[r]);
    { auto rr = __builtin_amdgcn_permlane32_swap(__float_as_uint(pmax), __float_as_uint(pmax), false, false);
      pmax = fmaxf(__uint_as_float(rr[0]), __uint_as_float(rr[1])); }
    if (__builtin_expect(__all(pmax - m_reg <= THR2), 1)) { mn = m_reg; alpha = 1.f; }
    else { mn = fmaxf(m_reg, pmax); alpha = __builtin_amdgcn_exp2f(m_reg - mn); m_reg = mn; }
#pragma unroll
    for (int r = 0; r < 16; ++r) p0[r] = p0[r] - mn;
#pragma unroll
    for (int r = 0; r < 16; ++r) p1[r] = p1[r] - mn;
#pragma unroll
    for (int r = 0; r < 16; ++r) p0[r] = __builtin_amdgcn_exp2f(p0[r]);
}
__device__ __forceinline__ void finishSM(f32x16& p0, f32x16& p1, float alpha, float& l_reg, bf16x8& pa0, bf16x8& pa1, bf16x8& pa2, bf16x8& pa3) {
#pragma unroll
    for (int r = 0; r < 16; ++r) p1[r] = __builtin_amdgcn_exp2f(p1[r]);
    float ps = 0;
#pragma unroll
    for (int r = 0; r < 16; ++r) ps += p0[r];
#pragma unroll
    for (int r = 0; r < 16; ++r) ps += p1[r];
    { auto rr = __builtin_amdgcn_permlane32_swap(__float_as_uint(ps), __float_as_uint(ps), false, false);
      ps = __uint_as_float(rr[0]) + __uint_as_float(rr[1]); }
    l_reg = l_reg * alpha + ps;
#define ATT_PK4(P, BASE, OUT) do { unsigned a0 = cvtpk(P[BASE + 0], P[BASE + 1]), a1 = cvtpk(P[BASE + 2], P[BASE + 3]);   \
    unsigned b0 = cvtpk(P[BASE + 4], P[BASE + 5]), b1 = cvtpk(P[BASE + 6], P[BASE + 7]);                              \
    auto r0 = __builtin_amdgcn_permlane32_swap(a0, b0, false, false); auto r1 = __builtin_amdgcn_permlane32_swap(a1, b1, false, false); \
    u32x4 w = {r0[0], r1[0], r0[1], r1[1]}; OUT = *reinterpret_cast<bf16x8*>(&w); } while (0)
    ATT_PK4(p0, 0, pa0); ATT_PK4(p0, 8, pa1); ATT_PK4(p1, 0, pa2); ATT_PK4(p1, 8, pa3);
#undef ATT_PK4
}
#define ATT_LAS __attribute__((address_space(3)))
template <int DQK, int NQR> __device__ __forceinline__ void qkt(f32x16& p0, f32x16& p1, const unsigned (&kb)[4], const int bufoff, const bf16x8* qr, const unsigned (&qlds)[4]) {
    p0 = f32x16{}; p1 = f32x16{};
#pragma unroll
    for (int d0 = 0; d0 < DQK / 16; ++d0) {
        const bf16x8 b0 = *(const ATT_LAS bf16x8*)(uintptr_t)(kb[d0 & 3] + (unsigned)(bufoff + 128 * (d0 >> 2)));
        const bf16x8 b1 = *(const ATT_LAS bf16x8*)(uintptr_t)(kb[d0 & 3] + (unsigned)(bufoff + 128 * (d0 >> 2) + 32 * 2 * DQK));
        bf16x8 q;
        if constexpr (NQR < DQK / 16) { if (d0 < NQR) q = qr[d0 < NQR ? d0 : 0]; else q = *(const ATT_LAS bf16x8*)(uintptr_t)qlds[(d0 - NQR) & 3]; }
        else q = qr[d0];
        p0 = __builtin_amdgcn_mfma_f32_32x32x16_bf16(b0, q, p0, 0, 0, 0);
        p1 = __builtin_amdgcn_mfma_f32_32x32x16_bf16(b1, q, p1, 0, 0, 0); }
}
__device__ __forceinline__ int v_st(int k, int c) { const int kk = (k & ~0xC) | ((k & 4) << 1) | ((k & 8) >> 1); return ((kk >> 3) * 4 + (c >> 5)) * 512 + ((kk & 7) * 32 + (c & 31)) * 2; }
__device__ __forceinline__ int v_rd_base(int lane) { return ((lane & 3) << 3) | (((lane >> 2) & 3) << 6) | (((lane >> 4) & 1) << 5) | (((lane >> 5) & 1) << 8); }
constexpr int v_rd_off(int d0, int ks, int half) { return d0 * 512 + ks * 4096 + half * 2048; }
template <int OFF> __device__ __forceinline__ s16x4 tr_read(int vb) {
    s16x4 r; asm volatile("ds_read_b64_tr_b16 %0, %1 offset:%2" : "=&v"(r) : "v"(vb), "i"(OFF) : "memory"); return r;
}
template <int D0> __device__ __forceinline__ void pv_one(f32x16& od, int vb, bf16x8 pa0, bf16x8 pa1, bf16x8 pa2, bf16x8 pa3) {
    const s16x4 l0 = tr_read<v_rd_off(D0, 0, 0)>(vb), h0 = tr_read<v_rd_off(D0, 0, 1)>(vb), l1 = tr_read<v_rd_off(D0, 1, 0)>(vb), h1 = tr_read<v_rd_off(D0, 1, 1)>(vb);
    const s16x4 l2 = tr_read<v_rd_off(D0, 2, 0)>(vb), h2 = tr_read<v_rd_off(D0, 2, 1)>(vb), l3 = tr_read<v_rd_off(D0, 3, 0)>(vb), h3 = tr_read<v_rd_off(D0, 3, 1)>(vb);
    asm volatile("s_waitcnt lgkmcnt(0)" ::: "memory"); ATT_SBAR();
#define ATT_PK(L, H) (bf16x8){L[0], L[1], L[2], L[3], H[0], H[1], H[2], H[3]}
    od = __builtin_amdgcn_mfma_f32_32x32x16_bf16(pa0, ATT_PK(l0, h0), od, 0, 0, 0);
    od = __builtin_amdgcn_mfma_f32_32x32x16_bf16(pa1, ATT_PK(l1, h1), od, 0, 0, 0);
    od = __builtin_amdgcn_mfma_f32_32x32x16_bf16(pa2, ATT_PK(l2, h2), od, 0, 0, 0);
    od = __builtin_amdgcn_mfma_f32_32x32x16_bf16(pa3, ATT_PK(l3, h3), od, 0, 0, 0);
#undef ATT_PK
}
struct VFrag { s16x4 l0, h0, l1, h1, l2, h2, l3, h3; };
template <int D0> __device__ __forceinline__ void v_rd(VFrag& f, int vb) {
    f.l0 = tr_read<v_rd_off(D0, 0, 0)>(vb); f.h0 = tr_read<v_rd_off(D0, 0, 1)>(vb); f.l1 = tr_read<v_rd_off(D0, 1, 0)>(vb); f.h1 = tr_read<v_rd_off(D0, 1, 1)>(vb);
    f.l2 = tr_read<v_rd_off(D0, 2, 0)>(vb); f.h2 = tr_read<v_rd_off(D0, 2, 1)>(vb); f.l3 = tr_read<v_rd_off(D0, 3, 0)>(vb); f.h3 = tr_read<v_rd_off(D0, 3, 1)>(vb);
}
__device__ __forceinline__ void pv_mm(f32x16& od, const VFrag& f, bf16x8 pa0, bf16x8 pa1, bf16x8 pa2, bf16x8 pa3) {
#define ATT_PK(L, H) (bf16x8){L[0], L[1], L[2], L[3], H[0], H[1], H[2], H[3]}
    od = __builtin_amdgcn_mfma_f32_32x32x16_bf16(pa0, ATT_PK(f.l0, f.h0), od, 0, 0, 0);
    od = __builtin_amdgcn_mfma_f32_32x32x16_bf16(pa1, ATT_PK(f.l1, f.h1), od, 0, 0, 0);
    od = __builtin_amdgcn_mfma_f32_32x32x16_bf16(pa2, ATT_PK(f.l2, f.h2), od, 0, 0, 0);
    od = __builtin_amdgcn_mfma_f32_32x32x16_bf16(pa3, ATT_PK(f.l3, f.h3), od, 0, 0, 0);
#undef ATT_PK
}
__device__ __forceinline__ void pv_d0(f32x16* o, int vb, bf16x8 pa0, bf16x8 pa1, bf16x8 pa2, bf16x8 pa3) {
    VFrag A, B;
    v_rd<0>(A, vb);
    v_rd<1>(B, vb); asm volatile("s_waitcnt lgkmcnt(8)" ::: "memory"); ATT_SBAR(); pv_mm(o[0], A, pa0, pa1, pa2, pa3); ATT_SBAR();
    v_rd<2>(A, vb); asm volatile("s_waitcnt lgkmcnt(8)" ::: "memory"); ATT_SBAR(); pv_mm(o[1], B, pa0, pa1, pa2, pa3); ATT_SBAR();
    v_rd<3>(B, vb); asm volatile("s_waitcnt lgkmcnt(8)" ::: "memory"); ATT_SBAR(); pv_mm(o[2], A, pa0, pa1, pa2, pa3); ATT_SBAR();
    asm volatile("s_waitcnt lgkmcnt(0)" ::: "memory"); ATT_SBAR(); pv_mm(o[3], B, pa0, pa1, pa2, pa3);
}

template <int DQK, int SDEPTH>
__device__ __forceinline__ void attn_core(const bf16_t* __restrict__ Qb, int ldq, const bf16_t* __restrict__ Kh, int ldk, const bf16_t* __restrict__ Vh, int ldv, int seq, char* lds, f32x16 (&o)[4], const int tid, const bf16_t* __restrict__ Kpe = nullptr) {
    constexpr int NP = DQK / 64, CPR = DQK / 8;
    constexpr size_t SHM_K = shm_k<DQK>();
    const int wid = tid >> 6, lane = tid & 63, r32 = lane & 31, hi = lane >> 5;
    char* V_lds = lds; char* K_lds = lds + 2 * SHM_V;
    float* ws = (float*)(lds + 2 * SHM_V + 2 * SHM_K) + wid * 64; float* li_l = ws; float* al_l = ws + 32;
    if (__builtin_amdgcn_readfirstlane(wid) >= 4) __builtin_amdgcn_s_setprio(1);
    float m_reg, l_reg = 0; asm volatile("v_mov_b32 %0, 0xf149f2ca" : "=v"(m_reg));
#pragma unroll
    for (int d = 0; d < 4; ++d) o[d] = f32x16{};
    constexpr int NQR = (DQK == 192) ? 8 : DQK / 16;
    bf16x8 qr[NQR]; unsigned qlds[4] = {0u, 0u, 0u, 0u};
    const bf16_t* Qw = Qb + (long)(wid * QBLK + r32) * ldq + hi * 8;
#pragma unroll
    for (int d0 = 0; d0 < NQR; ++d0) qr[d0] = *reinterpret_cast<const bf16x8*>(Qw + d0 * 16);
    if constexpr (NQR < DQK / 16) {
        const unsigned qbase = (unsigned)(uintptr_t)(lds + 2 * SHM_V + 2 * SHM_K + NW * 64 * 4) + (unsigned)(wid * 4096 + r32 * 128);
#pragma unroll
        for (int j = 0; j < 4; ++j) { qlds[j] = qbase + (unsigned)(((2 * j + hi) ^ ((r32 >> 1) & 7)) << 4);
            *(ATT_LAS bf16x8*)(uintptr_t)qlds[j] = *reinterpret_cast<const bf16x8*>(Qw + (NQR + j) * 16); }
    }
    const int sr = tid >> 4, sc = (tid & 15) * 8, vst0 = v_st(sr, sc), vst1 = v_st(32 + sr, sc);
    int krow[NP], kch[NP];
#pragma unroll
    for (int i = 0; i < NP; ++i) {
        if constexpr (DQK == 192) { if (i < 2) { const int p = tid + i * 512; krow[i] = p >> 4; kch[i] = p & 15; } else { krow[i] = tid >> 3; kch[i] = 16 + (tid & 7); } }
        else { const int p = tid + i * 512; krow[i] = p / CPR; kch[i] = p % CPR; } }
    const int vb0 = (int)(uintptr_t)V_lds + v_rd_base(lane);
    unsigned kb[4];
#pragma unroll
    for (int t = 0; t < 4; ++t) kb[t] = (unsigned)(uintptr_t)K_lds + (unsigned)kswz<DQK>(r32, 2 * t + hi);
    struct { bf16x8 vs0, vs1; bf16x8 ks[NP]; } sr_[SDEPTH];
    const unsigned vgo0 = (unsigned)(sr * ldv + sc) * 2u, vgo1 = (unsigned)((32 + sr) * ldv + sc) * 2u; unsigned kgo[NP];
#pragma unroll
    for (int i = 0; i < NP; ++i) kgo[i] = (DQK == 192 && i == 2) ? (unsigned)(krow[i] * 64 + (kch[i] - 16) * 8) * 2u : (unsigned)(krow[i] * ldk + kch[i] * 8) * 2u;
#define ATT_RSRC(P) __builtin_amdgcn_make_buffer_rsrc((void*)(uintptr_t)(((unsigned long long)(unsigned)__builtin_amdgcn_readfirstlane((unsigned)((unsigned long long)(uintptr_t)(P) >> 32)) << 32) | (unsigned long long)(unsigned)__builtin_amdgcn_readfirstlane((unsigned)(unsigned long long)(uintptr_t)(P))), 0, 0x7fffffff, 0x00027000)
    const __amdgpu_buffer_rsrc_t rK = ATT_RSRC(Kh), rV = ATT_RSRC(Vh), rP = ATT_RSRC(DQK == 192 ? Kpe : Kh);
#define ATT_BL(R, VO, SO_) __builtin_bit_cast(bf16x8, __builtin_amdgcn_raw_buffer_load_b128(R, VO, SO_, 0))
#define ATT_SLOAD(i, k0) do { const int vso_ = (k0) * ldv * 2, kso_ = (k0) * ldk * 2; sr_[i].vs0 = ATT_BL(rV, vgo0, vso_); sr_[i].vs1 = ATT_BL(rV, vgo1, vso_); \
    _Pragma("unroll") for (int _p = 0; _p < NP; ++_p) { if (DQK == 192 && _p == 2) sr_[i].ks[_p] = ATT_BL(rP, kgo[_p], (k0) * 128); else sr_[i].ks[_p] = ATT_BL(rK, kgo[_p], kso_); } } while (0)
#define ATT_SWRITE(b, i) do { *(bf16x8*)(V_lds + (b) * SHM_V + vst0) = sr_[i].vs0; *(bf16x8*)(V_lds + (b) * SHM_V + vst1) = sr_[i].vs1; \
    _Pragma("unroll") for (int _p = 0; _p < NP; ++_p) *(bf16x8*)(K_lds + (b) * SHM_K + kswz<DQK>(krow[_p], kch[_p])) = sr_[i].ks[_p]; } while (0)
#define ATT_SWAIT() do { if constexpr (SDEPTH == 2) asm volatile("s_waitcnt vmcnt(%0)" :: "n"(2 + NP) : "memory"); else asm volatile("s_waitcnt vmcnt(0)" ::: "memory"); } while (0)
#define ATT_RESC(a) do { if (__any((a) < 1.f)) { if (hi == 0) al_l[r32] = (a); asm volatile("s_waitcnt lgkmcnt(0)" ::: "memory"); \
    _Pragma("unroll") for (int d = 0; d < 4; ++d) _Pragma("unroll") for (int r = 0; r < 16; ++r) o[d][r] *= al_l[crow(r, hi)]; } } while (0)
    f32x16 pA0, pA1, pB0, pB1; float mnA, mnB, alA, alB; bf16x8 pa0, pa1, pa2, pa3; const int NT = seq / KVBLK;
    constexpr int SE = 0, SO = SDEPTH - 1;
    if constexpr (SDEPTH == 2) {
        ATT_SLOAD(SE, 0); ATT_SLOAD(SO, KVBLK); ATT_SWAIT(); ATT_SWRITE(0, SE); __syncthreads();
        qkt<DQK, NQR>(pA0, pA1, kb, 0, qr, qlds); partialSM(pA0, pA1, m_reg, mnA, alA);
        if (2 < NT) ATT_SLOAD(SE, 2 * KVBLK);
        ATT_SWAIT(); ATT_SWRITE(1, SO); __syncthreads();
    } else {
        ATT_SLOAD(SE, 0); asm volatile("s_waitcnt vmcnt(0)" ::: "memory"); ATT_SWRITE(0, SE); __syncthreads();
        qkt<DQK, NQR>(pA0, pA1, kb, 0, qr, qlds); partialSM(pA0, pA1, m_reg, mnA, alA);
        ATT_SLOAD(SO, KVBLK);
        ATT_SWAIT(); ATT_SWRITE(1, SO); __syncthreads();
    }
    for (int j = 1; j + 1 < NT; j += 2) {
        ATT_SBAR(); qkt<DQK, NQR>(pB0, pB1, kb, (int)SHM_K, qr, qlds);
        finishSM(pA0, pA1, alA, l_reg, pa0, pa1, pa2, pa3); ATT_SBAR();
        ATT_SLOAD(SO, (j + SDEPTH) * KVBLK); ATT_SBAR();
        pv_d0(o, vb0, pa0, pa1, pa2, pa3); partialSM(pB0, pB1, m_reg, mnB, alB);
        __syncthreads(); ATT_SWAIT(); ATT_SWRITE(0, SE);
        ATT_RESC(alB); __syncthreads();
        ATT_SBAR(); qkt<DQK, NQR>(pA0, pA1, kb, 0, qr, qlds);
        finishSM(pB0, pB1, alB, l_reg, pa0, pa1, pa2, pa3); ATT_SBAR();
        if (SDEPTH == 1 || j + 3 < NT) ATT_SLOAD(SE, (j + 1 + SDEPTH) * KVBLK); ATT_SBAR();
        pv_d0(o, vb0 + (int)SHM_V, pa0, pa1, pa2, pa3); partialSM(pA0, pA1, m_reg, mnA, alA);
        __syncthreads(); ATT_SWAIT(); ATT_SWRITE(1, SO);
        ATT_RESC(alA); __syncthreads();
    }
    ATT_SBAR(); qkt<DQK, NQR>(pB0, pB1, kb, (int)SHM_K, qr, qlds);
    finishSM(pA0, pA1, alA, l_reg, pa0, pa1, pa2, pa3); ATT_SBAR();
    pv_d0(o, vb0, pa0, pa1, pa2, pa3); partialSM(pB0, pB1, m_reg, mnB, alB);
    __syncthreads(); ATT_RESC(alB);
    finishSM(pB0, pB1, alB, l_reg, pa0, pa1, pa2, pa3); ATT_SBAR();
    pv_d0(o, vb0 + (int)SHM_V, pa0, pa1, pa2, pa3);
    if (hi == 0) li_l[r32] = l_reg; asm volatile("s_waitcnt lgkmcnt(0)" ::: "memory");
#pragma unroll
    for (int r = 0; r < 16; ++r) { const float rl = __builtin_amdgcn_rcpf(li_l[crow(r, hi)]);
#pragma unroll
        for (int d0 = 0; d0 < 4; ++d0) o[d0][r] *= rl; }
    __builtin_amdgcn_s_setprio(0);
    __syncthreads();
#undef ATT_SLOAD
#undef ATT_BL
#undef ATT_RSRC
#undef ATT_SWRITE
#undef ATT_SWAIT
#undef ATT_RESC
}
using i32x4a = __attribute__((ext_vector_type(4))) int;
using i32x8a = __attribute__((ext_vector_type(8))) int;
constexpr int MLA8_SHM_K = KVBLK * 256;
template <int NS> __device__ __forceinline__ void qkt8(f32x16& p0, f32x16& p1, const unsigned (&ka)[NS][2], const int bufoff, const i32x8a (&qf)[NS], const int sca, const int scb) {
    p0 = f32x16{}; p1 = f32x16{};
#pragma unroll
    for (int s = 0; s < NS; ++s) {
        const i32x4a a00 = *(const ATT_LAS i32x4a*)(uintptr_t)(ka[s][0] + (unsigned)bufoff), a01 = *(const ATT_LAS i32x4a*)(uintptr_t)(ka[s][1] + (unsigned)bufoff);
        const i32x4a a10 = *(const ATT_LAS i32x4a*)(uintptr_t)(ka[s][0] + (unsigned)(bufoff + 32 * 256)), a11 = *(const ATT_LAS i32x4a*)(uintptr_t)(ka[s][1] + (unsigned)(bufoff + 32 * 256));
        const i32x8a a0 = {a00[0], a00[1], a00[2], a00[3], a01[0], a01[1], a01[2], a01[3]}, a1 = {a10[0], a10[1], a10[2], a10[3], a11[0], a11[1], a11[2], a11[3]};
        p0 = __builtin_amdgcn_mfma_scale_f32_32x32x64_f8f6f4(a0, qf[s], p0, 0, 0, 0, sca, 0, scb);
        p1 = __builtin_amdgcn_mfma_scale_f32_32x32x64_f8f6f4(a1, qf[s], p1, 0, 0, 0, sca, 0, scb); }
}
__device__ __forceinline__ void attn_core_mla8(const unsigned char* __restrict__ Qb8, const unsigned char* __restrict__ Kn8, const unsigned char* __restrict__ Kpe8, const bf16_t* __restrict__ Vh, int ldv, int seq, char* lds, f32x16 (&o)[4], const int tid, const int sca, const int scb) {
    constexpr size_t SHM_K = MLA8_SHM_K;
    const int wid = tid >> 6, lane = tid & 63, r32 = lane & 31, hi = lane >> 5;
    char* V_lds = lds; char* K_lds = lds + 2 * SHM_V;
    float* ws = (float*)(lds + 2 * SHM_V + 2 * SHM_K) + wid * 64; float* li_l = ws; float* al_l = ws + 32;
    float m_reg, l_reg = 0; asm volatile("v_mov_b32 %0, 0xf149f2ca" : "=v"(m_reg));
#pragma unroll
    for (int d = 0; d < 4; ++d) o[d] = f32x16{};
    i32x8a qf[3];
    { const unsigned char* Qw = Qb8 + (long)(wid * QBLK + r32) * 1536 + hi * 32;
#pragma unroll
      for (int s_ = 0; s_ < 3; ++s_) { const i32x4a q0 = *reinterpret_cast<const i32x4a*>(Qw + 64 * s_), q1 = *reinterpret_cast<const i32x4a*>(Qw + 64 * s_ + 16); qf[s_] = (i32x8a){q0[0], q0[1], q0[2], q0[3], q1[0], q1[1], q1[2], q1[3]}; } }
    const int sr = tid >> 4, sc = (tid & 15) * 8, vst0 = v_st(sr, sc), vst1 = v_st(32 + sr, sc);
    const int kr0 = tid >> 3, kc0 = tid & 7, kr1 = (tid & 255) >> 2, kc1 = 8 + (tid & 3);
    const unsigned kw0 = (unsigned)(kr0 * 256 + ((kc0 ^ (kr0 & 15)) << 4)), kw1 = (unsigned)(kr1 * 256 + ((kc1 ^ (kr1 & 15)) << 4));
    const int vb0 = (int)(uintptr_t)V_lds + v_rd_base(lane);
    unsigned ka[3][2];
#pragma unroll
    for (int s_ = 0; s_ < 3; ++s_)
#pragma unroll
        for (int c = 0; c < 2; ++c) ka[s_][c] = (unsigned)(uintptr_t)K_lds + (unsigned)(r32 * 256 + (((4 * s_ + 2 * hi + c) ^ (r32 & 15)) << 4));
    const unsigned vgo0 = (unsigned)(sr * ldv + sc) * 2u, vgo1 = (unsigned)((32 + sr) * ldv + sc) * 2u, kgo0 = (unsigned)(kr0 * 1024 + kc0 * 16), kgo1 = (unsigned)(kr1 * 64 + (kc1 - 8) * 16);
#define ATT_RSRC(P) __builtin_amdgcn_make_buffer_rsrc((void*)(uintptr_t)(((unsigned long long)(unsigned)__builtin_amdgcn_readfirstlane((unsigned)((unsigned long long)(uintptr_t)(P) >> 32)) << 32) | (unsigned long long)(unsigned)__builtin_amdgcn_readfirstlane((unsigned)(unsigned long long)(uintptr_t)(P))), 0, 0x7fffffff, 0x00027000)
    const __amdgpu_buffer_rsrc_t rK = ATT_RSRC(Kn8), rV = ATT_RSRC(Vh), rP = ATT_RSRC(Kpe8);
    struct { bf16x8 vs0, vs1; u32x4 k0, k1; } sr_;
#define M8_SLOAD(kk) do { sr_.vs0 = __builtin_bit_cast(bf16x8, __builtin_amdgcn_raw_buffer_load_b128(rV, vgo0, (kk) * ldv * 2, 0)); sr_.vs1 = __builtin_bit_cast(bf16x8, __builtin_amdgcn_raw_buffer_load_b128(rV, vgo1, (kk) * ldv * 2, 0)); \
    sr_.k0 = __builtin_bit_cast(u32x4, __builtin_amdgcn_raw_buffer_load_b128(rK, kgo0, (kk) * 1024, 0)); sr_.k1 = __builtin_bit_cast(u32x4, __builtin_amdgcn_raw_buffer_load_b128(rP, kgo1, (kk) * 64, 0)); } while (0)
#define M8_SWRITE(b) do { *(bf16x8*)(V_lds + (b) * SHM_V + vst0) = sr_.vs0; *(bf16x8*)(V_lds + (b) * SHM_V + vst1) = sr_.vs1; \
    *(u32x4*)(K_lds + (b) * SHM_K + kw0) = sr_.k0; *(u32x4*)(K_lds + (b) * SHM_K + kw1) = sr_.k1; } while (0)
#define M8_SWAIT() asm volatile("s_waitcnt vmcnt(0)" ::: "memory")
#define M8_RESC(a) do { if (__any((a) < 1.f)) { if (hi == 0) al_l[r32] = (a); asm volatile("s_waitcnt lgkmcnt(0)" ::: "memory"); \
    _Pragma("unroll") for (int d = 0; d < 4; ++d) _Pragma("unroll") for (int r = 0; r < 16; ++r) o[d][r] *= al_l[crow(r, hi)]; } } while (0)
    f32x16 pA0, pA1, pB0, pB1; float mnA, mnB, alA, alB; bf16x8 pa0, pa1, pa2, pa3; const int NT = seq / KVBLK;
    M8_SLOAD(0); asm volatile("s_waitcnt vmcnt(0)" ::: "memory"); M8_SWRITE(0); __syncthreads();
    qkt8<3>(pA0, pA1, ka, 0, qf, sca, scb); partialSM(pA0, pA1, m_reg, mnA, alA);
    M8_SLOAD(KVBLK);
    M8_SWAIT(); M8_SWRITE(1); __syncthreads();
    for (int j = 1; j + 1 < NT; j += 2) {
        ATT_SBAR(); qkt8<3>(pB0, pB1, ka, (int)SHM_K, qf, sca, scb);
        finishSM(pA0, pA1, alA, l_reg, pa0, pa1, pa2, pa3); ATT_SBAR();
        M8_SLOAD((j + 1) * KVBLK); ATT_SBAR();
        pv_d0(o, vb0, pa0, pa1, pa2, pa3); partialSM(pB0, pB1, m_reg, mnB, alB);
        __syncthreads(); M8_SWAIT(); M8_SWRITE(0);
        M8_RESC(alB); __syncthreads();
        ATT_SBAR(); qkt8<3>(pA0, pA1, ka, 0, qf, sca, scb);
        finishSM(pB0, pB1, alB, l_reg, pa0, pa1, pa2, pa3); ATT_SBAR();
        M8_SLOAD((j + 2) * KVBLK); ATT_SBAR();
        pv_d0(o, vb0 + (int)SHM_V, pa0, pa1, pa2, pa3); partialSM(pA0, pA1, m_reg, mnA, alA);
        __syncthreads(); M8_SWAIT(); M8_SWRITE(1);
        M8_RESC(alA); __syncthreads();
    }
    ATT_SBAR(); qkt8<3>(pB0, pB1, ka, (int)SHM_K, qf, sca, scb);
    finishSM(pA0, pA1, alA, l_reg, pa0, pa1, pa2, pa3); ATT_SBAR();
    pv_d0(o, vb0, pa0, pa1, pa2, pa3); partialSM(pB0, pB1, m_reg, mnB, alB);
    __syncthreads(); M8_RESC(alB);
    finishSM(pB0, pB1, alB, l_reg, pa0, pa1, pa2, pa3); ATT_SBAR();
    pv_d0(o, vb0 + (int)SHM_V, pa0, pa1, pa2, pa3);
    if (hi == 0) li_l[r32] = l_reg; asm volatile("s_waitcnt lgkmcnt(0)" ::: "memory");
#pragma unroll
    for (int r = 0; r < 16; ++r) { const float rl = __builtin_amdgcn_rcpf(li_l[crow(r, hi)]);
#pragma unroll
        for (int d0 = 0; d0 < 4; ++d0) o[d0][r] *= rl; }
    __syncthreads();
#undef ATT_RSRC
#undef M8_SLOAD
#undef M8_SWRITE
#undef M8_SWAIT
#undef M8_RESC
}
using u32x2a = __attribute__((ext_vector_type(2))) unsigned;
constexpr int MLA8_SHM_V = KVBLK * 128;
constexpr float THR8 = 2.f;
template <int OFF> __device__ __forceinline__ u32x2a tr8_read(int va) { u32x2a r; asm volatile("ds_read_b64_tr_b8 %0, %1 offset:%2" : "=&v"(r) : "v"(va), "i"(OFF) : "memory"); return r; }
__device__ __forceinline__ unsigned pk4f8(float a, float b, float c, float d) { int w = __builtin_amdgcn_cvt_pk_fp8_f32(a, b, 0, false); w = __builtin_amdgcn_cvt_pk_fp8_f32(c, d, w, true); return (unsigned)w; }
__device__ __forceinline__ void partialSM8(f32x16& p0, f32x16& p1, float& m_reg, float& mn6, float& alpha) {
    float pmax = p0[0];
#pragma unroll
    for (int r = 1; r < 16; ++r) pmax = fmaxf(pmax, p0[r]);
#pragma unroll
    for (int r = 0; r < 16; ++r) pmax = fmaxf(pmax, p1[r]);
    { auto rr = __builtin_amdgcn_permlane32_swap(__float_as_uint(pmax), __float_as_uint(pmax), false, false);
      pmax = fmaxf(__uint_as_float(rr[0]), __uint_as_float(rr[1])); }
    float mn;
    if (__builtin_expect(__all(pmax - m_reg <= THR8), 1)) { mn = m_reg; alpha = 1.f; }
    else { mn = fmaxf(m_reg, pmax); alpha = __builtin_amdgcn_exp2f(m_reg - mn); m_reg = mn; }
    mn6 = mn - 6.f;
#pragma unroll
    for (int r = 0; r < 16; ++r) p0[r] = p0[r] - mn6;
#pragma unroll
    for (int r = 0; r < 16; ++r) p1[r] = p1[r] - mn6;
#pragma unroll
    for (int r = 0; r < 16; ++r) p0[r] = __builtin_amdgcn_exp2f(p0[r]);
}
__device__ __forceinline__ void finishSM8(f32x16& p0, f32x16& p1, float alpha, float& l_reg, i32x8a& pb) {
#pragma unroll
    for (int r = 0; r < 16; ++r) p1[r] = __builtin_amdgcn_exp2f(p1[r]);
    float ps = 0;
#pragma unroll
    for (int r = 0; r < 16; ++r) ps += p0[r];
#pragma unroll
    for (int r = 0; r < 16; ++r) ps += p1[r];
    { auto rr = __builtin_amdgcn_permlane32_swap(__float_as_uint(ps), __float_as_uint(ps), false, false);
      ps = __uint_as_float(rr[0]) + __uint_as_float(rr[1]); }
    l_reg = l_reg * alpha + ps;
#pragma unroll
    for (int w = 0; w < 4; ++w) { pb[w] = (int)pk4f8(p0[4 * w], p0[4 * w + 1], p0[4 * w + 2], p0[4 * w + 3]); pb[4 + w] = (int)pk4f8(p1[4 * w], p1[4 * w + 1], p1[4 * w + 2], p1[4 * w + 3]); }
}
template <int B> __device__ __forceinline__ void pv8(f32x16 (&o)[4], const int (&va)[4], const i32x8a pb, const int scv, const int scp) {
    u32x2a t[4][4];
#pragma unroll
    for (int d0 = 0; d0 < 4; ++d0) { t[d0][0] = tr8_read<B * MLA8_SHM_V + 0>(va[d0]); t[d0][1] = tr8_read<B * MLA8_SHM_V + 2048>(va[d0]); t[d0][2] = tr8_read<B * MLA8_SHM_V + 4096>(va[d0]); t[d0][3] = tr8_read<B * MLA8_SHM_V + 6144>(va[d0]); }
#define PV8_MM(D0) do { const i32x8a a_ = {(int)t[D0][0].x, (int)t[D0][0].y, (int)t[D0][1].x, (int)t[D0][1].y, (int)t[D0][2].x, (int)t[D0][2].y, (int)t[D0][3].x, (int)t[D0][3].y}; \
    o[D0] = __builtin_amdgcn_mfma_scale_f32_32x32x64_f8f6f4(a_, pb, o[D0], 0, 0, 0, scv, 0, scp); } while (0)
    asm volatile("s_waitcnt lgkmcnt(12)" ::: "memory"); ATT_SBAR(); PV8_MM(0); ATT_SBAR();
    asm volatile("s_waitcnt lgkmcnt(8)" ::: "memory"); ATT_SBAR(); PV8_MM(1); ATT_SBAR();
    asm volatile("s_waitcnt lgkmcnt(4)" ::: "memory"); ATT_SBAR(); PV8_MM(2); ATT_SBAR();
    asm volatile("s_waitcnt lgkmcnt(0)" ::: "memory"); ATT_SBAR(); PV8_MM(3);
#undef PV8_MM
}
template <int NS, bool ROPE>
__device__ __forceinline__ void attn_core_f8(const unsigned char* __restrict__ Qb8, const int ldq, const unsigned char* __restrict__ Kn8, const int ldk, const unsigned char* __restrict__ Kpe8, const unsigned char* __restrict__ Vh8, const int ldv, int seq, char* lds, f32x16 (&o)[4], const int tid, const int sca, const int scb, const int scv, const int scp) {
    constexpr size_t SHM_K = MLA8_SHM_K, SHM_V8 = MLA8_SHM_V;
    const int wid = tid >> 6, lane = tid & 63, r32 = lane & 31, hi = lane >> 5;
    if (__builtin_amdgcn_readfirstlane(wid) >= 4) __builtin_amdgcn_s_setprio(1);
    char* V_lds = lds; char* K_lds = lds + 2 * SHM_V8;
    float m_reg, l_reg = 0; asm volatile("v_mov_b32 %0, 0xf149f2ca" : "=v"(m_reg));
#pragma unroll
    for (int d = 0; d < 4; ++d) o[d] = f32x16{};
    i32x8a qf[NS];
    { const unsigned char* Qw = Qb8 + (long)(wid * QBLK + r32) * ldq + hi * 32;
#pragma unroll
      for (int s_ = 0; s_ < NS; ++s_) { const i32x4a q0 = *reinterpret_cast<const i32x4a*>(Qw + 64 * s_), q1 = *reinterpret_cast<const i32x4a*>(Qw + 64 * s_ + 16); qf[s_] = (i32x8a){q0[0], q0[1], q0[2], q0[3], q1[0], q1[1], q1[2], q1[3]}; } }
    const int vk = tid >> 3, vc = tid & 7;
    const unsigned vw = (unsigned)(vk * 128 + ((vc ^ ((((vk >> 1) & 1) << 1) | (((vk >> 3) & 1) << 2))) << 4));
    const int kr0 = tid >> 3, kc0 = tid & 7, kr1 = (tid & 255) >> 2, kc1 = 8 + (tid & 3);
    const unsigned kw0 = (unsigned)(kr0 * 256 + ((kc0 ^ (kr0 & 15)) << 4)), kw1 = (unsigned)(kr1 * 256 + ((kc1 ^ (kr1 & 15)) << 4));
    int va[4];
    { const int li = lane & 15, r = li >> 1, c = li & 1, gi = (lane >> 4) & 1, kl = 8 * (r >> 2) + 4 * hi + (r & 3), g = (((kl >> 1) & 1) << 1) | (((kl >> 3) & 1) << 2);
#pragma unroll
      for (int d0 = 0; d0 < 4; ++d0) va[d0] = (int)(uintptr_t)V_lds + kl * 128 + (((2 * d0 + gi) ^ g) << 4) + 8 * c; }
    unsigned ka[NS][2];
#pragma unroll
    for (int s_ = 0; s_ < NS; ++s_)
#pragma unroll
        for (int c = 0; c < 2; ++c) ka[s_][c] = (unsigned)(uintptr_t)K_lds + (unsigned)(r32 * 256 + (((4 * s_ + 2 * hi + c) ^ (r32 & 15)) << 4));
    const unsigned vgo = (unsigned)(vk * ldv + vc * 16), kgo0 = (unsigned)(kr0 * ldk + kc0 * 16), kgo1 = (unsigned)(kr1 * 64 + (kc1 - 8) * 16);
#define ATT_RSRC(P) __builtin_amdgcn_make_buffer_rsrc((void*)(uintptr_t)(((unsigned long long)(unsigned)__builtin_amdgcn_readfirstlane((unsigned)((unsigned long long)(uintptr_t)(P) >> 32)) << 32) | (unsigned long long)(unsigned)__builtin_amdgcn_readfirstlane((unsigned)(unsigned long long)(uintptr_t)(P))), 0, 0x7fffffff, 0x00027000)
    const __amdgpu_buffer_rsrc_t rK = ATT_RSRC(Kn8), rV = ATT_RSRC(Vh8), rP = ATT_RSRC(ROPE ? Kpe8 : Kn8);
    struct { u32x4 v, k0, k1; } sr_;
#define M8_SLOAD(kk) do { sr_.v = __builtin_bit_cast(u32x4, __builtin_amdgcn_raw_buffer_load_b128(rV, vgo, (kk) * ldv, 0)); \
    sr_.k0 = __builtin_bit_cast(u32x4, __builtin_amdgcn_raw_buffer_load_b128(rK, kgo0, (kk) * ldk, 0)); if constexpr (ROPE) sr_.k1 = __builtin_bit_cast(u32x4, __builtin_amdgcn_raw_buffer_load_b128(rP, kgo1, (kk) * 64, 0)); } while (0)
#define M8_SWRITE(b) do { *(u32x4*)(V_lds + (b) * SHM_V8 + vw) = sr_.v; *(u32x4*)(K_lds + (b) * SHM_K + kw0) = sr_.k0; if constexpr (ROPE) *(u32x4*)(K_lds + (b) * SHM_K + kw1) = sr_.k1; } while (0)
#define M8_SWAIT() asm volatile("s_waitcnt vmcnt(0)" ::: "memory")
#define M8_RESC(a) do { if (__any((a) < 1.f)) { _Pragma("unroll") for (int d = 0; d < 4; ++d) _Pragma("unroll") for (int r = 0; r < 16; ++r) o[d][r] *= (a); } } while (0)
    f32x16 pA0, pA1, pB0, pB1; float mnA, mnB, alA, alB; i32x8a pb; const int NT = seq / KVBLK;
    { M8_SLOAD(0);
      const u32x4 v1_ = __builtin_bit_cast(u32x4, __builtin_amdgcn_raw_buffer_load_b128(rV, vgo, KVBLK * ldv, 0)), k10_ = __builtin_bit_cast(u32x4, __builtin_amdgcn_raw_buffer_load_b128(rK, kgo0, KVBLK * ldk, 0));
      u32x4 k11_ = {0u, 0u, 0u, 0u}; if constexpr (ROPE) k11_ = __builtin_bit_cast(u32x4, __builtin_amdgcn_raw_buffer_load_b128(rP, kgo1, KVBLK * 64, 0));
      if constexpr (ROPE) asm volatile("s_waitcnt vmcnt(3)" ::: "memory"); else asm volatile("s_waitcnt vmcnt(2)" ::: "memory");
      M8_SWRITE(0); __syncthreads();
      qkt8<NS>(pA0, pA1, ka, 0, qf, sca, scb); partialSM8(pA0, pA1, m_reg, mnA, alA);
      asm volatile("s_waitcnt vmcnt(0)" ::: "memory");
      *(u32x4*)(V_lds + SHM_V8 + vw) = v1_; *(u32x4*)(K_lds + SHM_K + kw0) = k10_; if constexpr (ROPE) *(u32x4*)(K_lds + SHM_K + kw1) = k11_;
      __syncthreads(); }
    for (int j = 1; j + 1 < NT; j += 2) {
        ATT_SBAR(); qkt8<NS>(pB0, pB1, ka, (int)SHM_K, qf, sca, scb);
        finishSM8(pA0, pA1, alA, l_reg, pb); ATT_SBAR();
        M8_SLOAD((j + 1) * KVBLK); ATT_SBAR();
        pv8<0>(o, va, pb, scv, scp); partialSM8(pB0, pB1, m_reg, mnB, alB);
        __syncthreads(); M8_SWAIT(); M8_SWRITE(0);
        M8_RESC(alB); __syncthreads();
        ATT_SBAR(); qkt8<NS>(pA0, pA1, ka, 0, qf, sca, scb);
        finishSM8(pB0, pB1, alB, l_reg, pb); ATT_SBAR();
        M8_SLOAD((j + 2) * KVBLK); ATT_SBAR();
        pv8<1>(o, va, pb, scv, scp); partialSM8(pA0, pA1, m_reg, mnA, alA);
        __syncthreads(); M8_SWAIT(); M8_SWRITE(1);
        M8_RESC(alA); __syncthreads();
    }
    ATT_SBAR(); qkt8<NS>(pB0, pB1, ka, (int)SHM_K, qf, sca, scb);
    finishSM8(pA0, pA1, alA, l_reg, pb); ATT_SBAR();
    pv8<0>(o, va, pb, scv, scp); partialSM8(pB0, pB1, m_reg, mnB, alB);
    __syncthreads(); M8_RESC(alB);
    finishSM8(pB0, pB1, alB, l_reg, pb); ATT_SBAR();
    pv8<1>(o, va, pb, scv, scp);
    { const float rl = 64.f * __builtin_amdgcn_rcpf(l_reg);
#pragma unroll
      for (int d0 = 0; d0 < 4; ++d0)
#pragma unroll
          for (int r = 0; r < 16; ++r) o[d0][r] *= rl; }
    __builtin_amdgcn_s_setprio(0);
    __syncthreads();
#undef ATT_RSRC
#undef M8_SLOAD
#undef M8_SWRITE
#undef M8_SWAIT
#undef M8_RESC
}
}
namespace mk {
using pg8::f32x4; using pg8::u32x4; using pg8::u32x2; using pg8::Unit; using pg8::bf16x8;
typedef unsigned short bf16;
#define GAS __attribute__((address_space(1)))
#define LAS __attribute__((address_space(3)))
typedef GAS unsigned gu32;
#define RLX_AGENT __ATOMIC_RELAXED, __HIP_MEMORY_SCOPE_AGENT
#define LDS_WAIT() asm volatile("s_waitcnt lgkmcnt(0)" ::: "memory")
#define VM_WAIT() asm volatile("s_waitcnt vmcnt(0)" ::: "memory")

constexpr int NWAVES = 8;
constexpr int NTOK = 16384, DM = 2048, SEQ = 2048, NB = 8, MEML = 256;
constexpr int NPROJ = 8192;
constexpr float LOG2E = 1.4426950408889634f;
constexpr float C2D = 0.125f * LOG2E;
constexpr float C2M = 0.07216878364870322f * LOG2E;
constexpr float C2C = 0.08838834764831845f * LOG2E;
constexpr int C_DQ = 0, C_DK = 1024, C_DV = 2048, C_CQ = 3072, C_CKV = 3584, C_KPE = 3840, C_GA = 3904, C_GB = 5952, D_IN = 8000;
constexpr int MOE_MAXT = 160;
constexpr float WIN_SCALE = 64.f, HID_SCALE = 4.f, WD_SCALE = 32.f, WGU_SCALE = 64.f;

constexpr size_t MiB = 1u << 20;
constexpr size_t WS_CTL = 0, CTL_ZERO_BYTES = 64 * 1024;
constexpr float OA_I8 = 40.f, WOA_I8 = 1024.f;
constexpr float H_I8 = 24.f;
constexpr float XN_I8 = 32.f, W_I8 = 1408.f;
constexpr float MG_SCALE = 48.f, WOUT_SCALE = 1408.f;
constexpr float Y_SCALE = 16.f;
constexpr float MLA_QS = 32.f, MLA_KS = 8.f;
constexpr int MLA_SCB = 0x7a7a7a7a, MLA_SCA = 0x7c7c7c7c;
constexpr float MLA_VS = 8.f; constexpr int MLA_SCV = 0x7c7c7c7c, MLA_SCP = 0x79797979;
constexpr size_t WS_KPE = 120 * MiB;
constexpr size_t WS_RSTDX = 11 * MiB + 768 * 1024;
constexpr size_t WS_SS_CQ = 11 * MiB, WS_SS_CKV = 11 * MiB + 512 * 1024, WS_SS_H1 = 508 * MiB;
constexpr size_t WS_ROPE_D = 1 * MiB, WS_ROPE_M = 2 * MiB;
constexpr size_t WS_WR_T = 6 * MiB;
constexpr size_t WS_TOKES = 6 * MiB + 512 * 1024, WS_TOKW = WS_TOKES + 128 * 1024, WS_SCAL = WS_TOKW + 128 * 1024;
constexpr size_t WS_LIST = 7 * MiB, WS_LISTR = 9 * MiB;
constexpr size_t WS_WIN_T = 12 * MiB, WS_WOA_T = 44 * MiB, WS_WOB_T = 48 * MiB, WS_WOUT_T = 52 * MiB, WS_WUQ_T = 60 * MiB, WS_WUKV_T = 62 * MiB, WS_WCQ_T = 63 * MiB,
                 WS_WCKV_T = 65 * MiB, WS_WCO_T = 69 * MiB;
constexpr size_t WS_XN = 72 * MiB, WS_QM = 72 * MiB, WS_MG = 72 * MiB;
constexpr size_t WS_QD = 136 * MiB, WS_KD = 168 * MiB, WS_VD = 200 * MiB, WS_CQ = 232 * MiB, WS_CKV = 248 * MiB, WS_SGA = 256 * MiB, WS_SGB = 320 * MiB, WS_KM = 384 * MiB, WS_VM = 432 * MiB,
                 WS_OB = 464 * MiB, WS_MEMN = 496 * MiB, WS_KVC = 504 * MiB, WS_HB = 512 * MiB, WS_QC = 576 * MiB, WS_OC = 592 * MiB;
constexpr size_t WS_WGU_T = 136 * MiB, WS_WD_T = 264 * MiB, WS_HID = 72 * MiB, WS_Y = 328 * MiB, WS_H8 = 200 * MiB, WS_XN8 = 464 * MiB, WS_WIN8 = 576 * MiB, WS_WCQ8 = 592 * MiB, WS_WCKV8 = 593 * MiB, WS_MEMN8 = 596 * MiB, WS_END = 608 * MiB;
constexpr int CW_TMO = 0, CW_CODE = 1, CW_BAR = 4096, CW_CNT = 8192;

constexpr int RING_OFF = 0, RING_BYTES = 131072;
constexpr int LDSCTL_OFF = RING_BYTES, MISC_OFF = LDSCTL_OFF + 320;
constexpr int LDS_BYTES = 147456;

#define XB_TMO      128
#define XB_XCNT(j)  (256  + 64 * (j))
#define XB_XSUB(j)  (1280 + 64 * (j))
#define XB_XGEN(j)  (2304 + 64 * (j))
#define XB_TOP      3328
#define XB_TOPGEN   3392
#define XCD_BAR_WORDS 3456
#define XB_SPIN_CAP (1u << 18)
__device__ __forceinline__ unsigned xb_ld(unsigned* p)              { return __hip_atomic_load(p, __ATOMIC_RELAXED, __HIP_MEMORY_SCOPE_AGENT); }
__device__ __forceinline__ unsigned xb_add(unsigned* p, unsigned v) { return __hip_atomic_fetch_add(p, v, __ATOMIC_RELAXED, __HIP_MEMORY_SCOPE_AGENT); }
__device__ __forceinline__ unsigned xb_xcc_id() { return (unsigned)__builtin_amdgcn_s_getreg((3 << 11) | 20) & 0xFu; }
#define XB_SPIN(cond, bar) do { unsigned _sp = 0; while (cond) { __builtin_amdgcn_s_sleep(1); \
    if ((++_sp & 255u) == 0u) { if (xb_ld(&(bar)[XB_TMO])) break; if (_sp > XB_SPIN_CAP) { atomicAdd(&(bar)[XB_TMO], 1u); break; } } } } while (0)
struct XcdBarrier { unsigned* bar; unsigned x; volatile LAS unsigned* st; };
__device__ __forceinline__ XcdBarrier xcd_barrier_post(unsigned* bar, volatile LAS unsigned* st) {
    XcdBarrier b; b.bar = bar; b.x = xb_xcc_id(); b.st = st;
    if (threadIdx.x == 0) (void)xb_add(&bar[XB_XCNT(b.x)], 1u);
    return b;
}
__device__ __forceinline__ void xcd_barrier_complete(unsigned* bar, unsigned x, unsigned& nloc, unsigned& nx) {
    const unsigned G = gridDim.x * gridDim.y * gridDim.z;
    unsigned sum, cnt, mine, sp = 0u;
    for (;;) {
        sum = 0u; cnt = 0u; mine = 0u;
#pragma unroll
        for (unsigned j = 0; j < 16; ++j) { const unsigned c = xb_ld(&bar[XB_XCNT(j)]); sum += c; cnt += (c > 0u) ? 1u : 0u; mine = (j == x) ? c : mine; }
        if (sum == G) break;
        __builtin_amdgcn_s_sleep(1);
        if ((++sp & 255u) == 0u) { if (xb_ld(&bar[XB_TMO])) break; if (sp > XB_SPIN_CAP) { atomicAdd(&bar[XB_TMO], 1u); break; } }
    }
    nloc = mine > 0u ? mine : 1u; nx = cnt > 0u ? cnt : 1u;
}
__device__ __forceinline__ void xcd_barrier(const XcdBarrier& b, const int tid_) {
    asm volatile("s_waitcnt vmcnt(0)" ::: "memory");
    __syncthreads();
    if (tid_ == 0) {
        unsigned* bar = b.bar;
        __builtin_amdgcn_s_waitcnt(0);
        unsigned nloc = b.st[0], nx = b.st[1];
        if (nloc == 0u) { xcd_barrier_complete(bar, b.x, nloc, nx); b.st[0] = nloc; b.st[1] = nx; }
        const unsigned old = xb_add(&bar[XB_XSUB(b.x)], 1u);
        const unsigned gen = old / nloc;
        if (old + 1u == (gen + 1u) * nloc) {
            __builtin_amdgcn_fence(__ATOMIC_RELEASE, "agent");
            asm volatile("s_waitcnt vmcnt(0)" ::: "memory");
            const unsigned og = xb_add(&bar[XB_TOP], 1u);
            const unsigned tg = og / nx;
            if (og + 1u == (tg + 1u) * nx) xb_add(&bar[XB_TOPGEN], 1u);
            else XB_SPIN(xb_ld(&bar[XB_TOPGEN]) == tg, bar);
            __builtin_amdgcn_fence(__ATOMIC_ACQUIRE, "agent");
            xb_add(&bar[XB_XGEN(b.x)], 1u);
            asm volatile("s_waitcnt vmcnt(0)" ::: "memory");
        } else {
            XB_SPIN(xb_ld(&bar[XB_XGEN(b.x)]) == gen, bar);
            __builtin_amdgcn_fence(__ATOMIC_ACQUIRE, "agent");
            asm volatile("s_waitcnt vmcnt(0)" ::: "memory");
        }
    }
    __syncthreads();
}

struct Args {
    const float *x, *mem; const int* positions; const float *attn_norm_g, *w_in, *lq1, *lk1, *lq2, *lk2, *subln_g, *w_o_diff, *mla_q_norm_g, *w_uq, *mla_kv_norm_g, *w_ukv, *w_o_mla, *w_out,
        *cross_norm_g, *mem_norm_g, *w_cq, *w_ckv, *w_co, *ffn_norm_g, *w_rg, *b_rg, *w_re, *b_re, *w_gate, *w_up, *w_down, *final_norm_g;
    float* out; unsigned char* ws; int ph_lo, ph_hi;
};

__device__ __forceinline__ float wave_sum(float v) {
#pragma unroll
    for (int o = 1; o < 64; o <<= 1) v += __shfl_xor(v, o);
    return v;
}
__device__ __forceinline__ float sigmoidf_fast(float x) { return __builtin_amdgcn_rcpf(1.f + __builtin_amdgcn_exp2f(-x * LOG2E)); }

__device__ __forceinline__ unsigned pack4_u8(float a, float b, float c, float d) { unsigned w = 0u; w = __builtin_amdgcn_cvt_pk_u8_f32(a, 0, w); w = __builtin_amdgcn_cvt_pk_u8_f32(b, 1, w); w = __builtin_amdgcn_cvt_pk_u8_f32(c, 2, w); w = __builtin_amdgcn_cvt_pk_u8_f32(d, 3, w); return w; }
__device__ __forceinline__ unsigned pack4_i8(float a, float b, float c, float d) { return pack4_u8(a + 128.f, b + 128.f, c + 128.f, d + 128.f) ^ 0x80808080u; }
__device__ __forceinline__ f32x4 acc_i2f(const f32x4& a) { return __builtin_convertvector(__builtin_bit_cast(pg8::i32x4, a), f32x4); }
template <bool FP8 = false> __device__ __forceinline__ void transpose_item(const float* W, int ldw, int srccol, const float* gain, int k0, bf16* WT, int ldt, int row0, LAS float* scr, int lane, float wscale = 1.f) {
    float v[32];
    const float* wp = W + (size_t)(k0 + (lane >> 5)) * ldw + (srccol >= 0 ? srccol : 0);
#pragma unroll
    for (int i = 0; i < 32; ++i) v[i] = __builtin_nontemporal_load(wp + (size_t)(2 * i) * ldw);
    if (gain) {
#pragma unroll
        for (int i = 0; i < 32; ++i) v[i] *= gain[k0 + 2 * i + (lane >> 5)]; }
    if (srccol < 0) {
#pragma unroll
        for (int i = 0; i < 32; ++i) v[i] = 0.f; }
#pragma unroll
    for (int i = 0; i < 32; ++i) scr[(2 * i + (lane >> 5)) * 33 + (lane & 31)] = v[i];
    LDS_WAIT(); asm volatile("" ::: "memory");
    const int c = lane & 7;
#pragma unroll
    for (int j = 0; j < 4; ++j) { const int n = (lane >> 3) + 8 * j; const LAS float* s = scr + (8 * c) * 33 + n;
        if constexpr (FP8) { u32x2 o; o.x = pg8::pack4_fp8(s[0 * 33] * wscale, s[1 * 33] * wscale, s[2 * 33] * wscale, s[3 * 33] * wscale); o.y = pg8::pack4_fp8(s[4 * 33] * wscale, s[5 * 33] * wscale, s[6 * 33] * wscale, s[7 * 33] * wscale);
            *(GAS u32x2*)((unsigned char*)WT + (size_t)(row0 + n) * ldt + k0 + 8 * c) = o; }
        else { u32x4 o; o.x = pg8::cvt_pk_bf16(s[0 * 33], s[1 * 33]); o.y = pg8::cvt_pk_bf16(s[2 * 33], s[3 * 33]); o.z = pg8::cvt_pk_bf16(s[4 * 33], s[5 * 33]); o.w = pg8::cvt_pk_bf16(s[6 * 33], s[7 * 33]);
            *(GAS u32x4*)(WT + (size_t)(row0 + n) * ldt + k0 + 8 * c) = o; } }
    LDS_WAIT(); asm volatile("" ::: "memory");
}
struct TItem { const float* wp; const float* gain; unsigned char* dst; int ldw, k0, ldt, fp8; float wscale; bool zero; };
__device__ __forceinline__ void tr_load(const TItem& t, float (&v)[32]) {
#pragma unroll
    for (int i = 0; i < 32; ++i) v[i] = __builtin_nontemporal_load(t.wp + (size_t)(2 * i) * t.ldw);
}
__device__ __forceinline__ void tr_finish(const TItem& t, float (&v)[32], LAS float* scr, int lane) {
    if (t.gain) {
#pragma unroll
        for (int i = 0; i < 32; ++i) v[i] *= t.gain[t.k0 + 2 * i + (lane >> 5)]; }
    if (t.zero) {
#pragma unroll
        for (int i = 0; i < 32; ++i) v[i] = 0.f; }
#pragma unroll
    for (int i = 0; i < 32; ++i) scr[(2 * i + (lane >> 5)) * 33 + (lane & 31)] = v[i];
    LDS_WAIT(); asm volatile("" ::: "memory");
    const int c = lane & 7;
#pragma unroll
    for (int j = 0; j < 4; ++j) { const int n = (lane >> 3) + 8 * j; const LAS float* q = scr + (8 * c) * 33 + n;
        if (t.fp8 == 2) { u32x2 o; o.x = pack4_i8(q[0 * 33] * t.wscale, q[1 * 33] * t.wscale, q[2 * 33] * t.wscale, q[3 * 33] * t.wscale); o.y = pack4_i8(q[4 * 33] * t.wscale, q[5 * 33] * t.wscale, q[6 * 33] * t.wscale, q[7 * 33] * t.wscale);
            *(GAS u32x2*)(t.dst + (size_t)n * t.ldt + 8 * c) = o; }
        else if (t.fp8) { u32x2 o; o.x = pg8::pack4_fp8(q[0 * 33] * t.wscale, q[1 * 33] * t.wscale, q[2 * 33] * t.wscale, q[3 * 33] * t.wscale); o.y = pg8::pack4_fp8(q[4 * 33] * t.wscale, q[5 * 33] * t.wscale, q[6 * 33] * t.wscale, q[7 * 33] * t.wscale);
            *(GAS u32x2*)(t.dst + (size_t)n * t.ldt + 8 * c) = o; }
        else { u32x4 o; o.x = pg8::cvt_pk_bf16(q[0 * 33], q[1 * 33]); o.y = pg8::cvt_pk_bf16(q[2 * 33], q[3 * 33]); o.z = pg8::cvt_pk_bf16(q[4 * 33], q[5 * 33]); o.w = pg8::cvt_pk_bf16(q[6 * 33], q[7 * 33]);
            *(GAS u32x4*)(t.dst + (size_t)n * t.ldt + 16 * c) = o; } }
    LDS_WAIT(); asm volatile("" ::: "memory");
}
__device__ __forceinline__ TItem tr_make(const float* W, int ldw, int srccol, const float* gain, int k0, void* WT, int ldt_elems, int row0, int lane, int fp8, float wscale = 1.f) {
    TItem t; t.wp = W + (size_t)(k0 + (lane >> 5)) * ldw + (srccol >= 0 ? srccol : 0); t.gain = gain; t.ldw = ldw; t.k0 = k0; t.fp8 = fp8; t.wscale = wscale; t.zero = srccol < 0;
    const int eb = fp8 ? 1 : 2; t.ldt = ldt_elems * eb; t.dst = (unsigned char*)WT + ((size_t)row0 * ldt_elems + k0) * eb; return t;
}
__device__ __forceinline__ int sigma16(int s) { return 8 * ((s >> 2) & 1) + 4 * (s >> 3) + (s & 3); }
__device__ __forceinline__ int sigma64(int s) { return 32 * ((s >> 2) & 1) + 4 * (s >> 3) + (s & 3); }
__device__ __forceinline__ int win_src(int n) {
    if (n < 2048) { const int base = n < 1024 ? C_DQ : C_DK, m = n & 1023, ch = m >> 6, s = m & 63; return base + ch * 64 + (s < 16 ? sigma16(s) : s); }
    if (n < 3072) return C_DV + (n - 2048);
    if (n < 3584) return C_CQ + (n - 3072);
    if (n < 3840) return C_CKV + (n - 3584);
    if (n < 5888) return C_GA + (n - 3840);
    if (n < 7936) return C_GB + (n - 5888);
    if (n < 8000) return C_KPE + sigma64(n - 7936);
    return -1;
}
__device__ __forceinline__ int wuq_src(int n) { const int h = n / 192, off = n - h * 192; return h * 192 + (off < 128 ? off : 128 + sigma64(off - 128)); }

__device__ __forceinline__ void rms_row_to_bf16(const float* xrow, const float* g, bf16* orow, int lane, unsigned char* orow8 = nullptr, bf16* xcopy = nullptr, float* rstd_out = nullptr, float i8scale = 0.f) {
    const GAS f32x4* xr = (const GAS f32x4*)xrow + lane; const GAS f32x4* gr = (const GAS f32x4*)g + lane;
    f32x4 v[8]; float s = 0.f;
#pragma unroll
    for (int j = 0; j < 8; ++j) { v[j] = __builtin_nontemporal_load(xr + 64 * j); s += (v[j].x * v[j].x + v[j].y * v[j].y) + (v[j].z * v[j].z + v[j].w * v[j].w); }
    const float rstd = rsqrtf(wave_sum(s) * (1.f / DM) + 1e-6f);
    GAS u32x2* o8 = (GAS u32x2*)orow + lane;
    if (rstd_out && lane == 0) *rstd_out = rstd;
    if (xcopy) { GAS u32x2* c8 = (GAS u32x2*)xcopy + lane;
#pragma unroll
        for (int j = 0; j < 8; ++j) { u32x2 w; w.x = pg8::cvt_pk_bf16(v[j].x, v[j].y); w.y = pg8::cvt_pk_bf16(v[j].z, v[j].w); c8[64 * j] = w; } }
#pragma unroll
    for (int j = 0; j < 8; ++j) { const f32x4 gg = gr[64 * j]; u32x2 w; w.x = pg8::cvt_pk_bf16(v[j].x * rstd * gg.x, v[j].y * rstd * gg.y); w.y = pg8::cvt_pk_bf16(v[j].z * rstd * gg.z, v[j].w * rstd * gg.w); if (orow) o8[64 * j] = w;
        if (orow8) ((GAS unsigned*)orow8)[lane + 64 * j] = i8scale != 0.f ? pack4_i8(v[j].x * rstd * gg.x * i8scale, v[j].y * rstd * gg.y * i8scale, v[j].z * rstd * gg.z * i8scale, v[j].w * rstd * gg.w * i8scale) : pg8::pack4_fp8(v[j].x * rstd * gg.x, v[j].y * rstd * gg.y, v[j].z * rstd * gg.z, v[j].w * rstd * gg.w); }
}

__device__ __forceinline__ void rms_rows2_x(const float* xa, const float* xb, const float* g, unsigned char* oa8, unsigned char* ob8, bf16* ca, bf16* cb, float* ra, float* rb, int lane) {
    const GAS f32x4* pa = (const GAS f32x4*)xa + lane; const GAS f32x4* pb = (const GAS f32x4*)xb + lane; const GAS f32x4* gr = (const GAS f32x4*)g + lane;
    f32x4 va[8], vb[8]; float sa = 0.f, sb = 0.f;
#pragma unroll
    for (int j = 0; j < 8; ++j) va[j] = __builtin_nontemporal_load(pa + 64 * j);
#pragma unroll
    for (int j = 0; j < 8; ++j) vb[j] = __builtin_nontemporal_load(pb + 64 * j);
#pragma unroll
    for (int j = 0; j < 8; ++j) sa += (va[j].x * va[j].x + va[j].y * va[j].y) + (va[j].z * va[j].z + va[j].w * va[j].w);
#pragma unroll
    for (int j = 0; j < 8; ++j) sb += (vb[j].x * vb[j].x + vb[j].y * vb[j].y) + (vb[j].z * vb[j].z + vb[j].w * vb[j].w);
    const float rsa = rsqrtf(wave_sum(sa) * (1.f / DM) + 1e-6f), rsb = rsqrtf(wave_sum(sb) * (1.f / DM) + 1e-6f);
    if (lane == 0) { *ra = rsa; *rb = rsb; }
    GAS u32x2* c8a = (GAS u32x2*)ca + lane; GAS u32x2* c8b = (GAS u32x2*)cb + lane;
#pragma unroll
    for (int j = 0; j < 8; ++j) { u32x2 w; w.x = pg8::cvt_pk_bf16(va[j].x, va[j].y); w.y = pg8::cvt_pk_bf16(va[j].z, va[j].w); c8a[64 * j] = w; w.x = pg8::cvt_pk_bf16(vb[j].x, vb[j].y); w.y = pg8::cvt_pk_bf16(vb[j].z, vb[j].w); c8b[64 * j] = w; }
#pragma unroll
    for (int j = 0; j < 8; ++j) { const f32x4 gg = gr[64 * j];
        ((GAS unsigned*)oa8)[lane + 64 * j] = pack4_i8(va[j].x * (rsa * XN_I8) * gg.x, va[j].y * (rsa * XN_I8) * gg.y, va[j].z * (rsa * XN_I8) * gg.z, va[j].w * (rsa * XN_I8) * gg.w);
        ((GAS unsigned*)ob8)[lane + 64 * j] = pack4_i8(vb[j].x * (rsb * XN_I8) * gg.x, vb[j].y * (rsb * XN_I8) * gg.y, vb[j].z * (rsb * XN_I8) * gg.z, vb[j].w * (rsb * XN_I8) * gg.w); }
}

template<int NR> __device__ __forceinline__ void rms_rowsN_x(const float* x, const float* g, unsigned char* o8, bf16* c, float* rs, int m0, int ms, int lane) {
    const GAS f32x4* gr = (const GAS f32x4*)g + lane;
    f32x4 v[NR][8]; float s[NR];
#pragma unroll
    for (int r = 0; r < NR; ++r) { const GAS f32x4* p = (const GAS f32x4*)(x + (size_t)(m0 + r * ms) * DM) + lane;
#pragma unroll
        for (int j = 0; j < 8; ++j) v[r][j] = __builtin_nontemporal_load(p + 64 * j); }
#pragma unroll
    for (int r = 0; r < NR; ++r) { float a = 0.f;
#pragma unroll
        for (int j = 0; j < 8; ++j) a += (v[r][j].x * v[r][j].x + v[r][j].y * v[r][j].y) + (v[r][j].z * v[r][j].z + v[r][j].w * v[r][j].w);
        s[r] = a; }
#pragma unroll
    for (int r = 0; r < NR; ++r) s[r] = rsqrtf(wave_sum(s[r]) * (1.f / DM) + 1e-6f);
    if (lane == 0) {
#pragma unroll
        for (int r = 0; r < NR; ++r) rs[m0 + r * ms] = s[r]; }
#pragma unroll
    for (int r = 0; r < NR; ++r) { GAS u32x2* c8 = (GAS u32x2*)(c + (size_t)(m0 + r * ms) * DM) + lane;
#pragma unroll
        for (int j = 0; j < 8; ++j) { u32x2 w; w.x = pg8::cvt_pk_bf16(v[r][j].x, v[r][j].y); w.y = pg8::cvt_pk_bf16(v[r][j].z, v[r][j].w); c8[64 * j] = w; } }
#pragma unroll
    for (int j = 0; j < 8; ++j) { const f32x4 gg = gr[64 * j];
#pragma unroll
        for (int r = 0; r < NR; ++r) { const float k = s[r] * XN_I8;
            ((GAS unsigned*)(o8 + (size_t)(m0 + r * ms) * DM))[lane + 64 * j] = pack4_i8(v[r][j].x * k * gg.x, v[r][j].y * k * gg.y, v[r][j].z * k * gg.z, v[r][j].w * k * gg.w); } }
}

struct SchedTile {
    pg8::TileOrder ord; const char* Ab; const char* Bb; size_t tA, tB;
    __device__ __forceinline__ bool next(int i, Unit& u) const { u.z = 0; return ord.tile(i, u.pm, u.pn); }
    __device__ __forceinline__ const char* A(const Unit& u) const { return Ab + (size_t)u.pm * tA; }
    __device__ __forceinline__ const char* B(const Unit& u) const { return Bb + (size_t)u.pn * tB; }
};
struct SchedProj {
    pg8::TileOrder ord; const char* Ab; const char* Bb; size_t tA, tB; int fp8;
    __device__ __forceinline__ bool next(int i, Unit& u) const { int pn; if (!ord.tile(i, u.pm, pn)) return false; u.z = pn;
        u.pn = fp8 ? (pn < 16 ? 15 + pn : (pn < 19 ? pn - 4 : 31)) : pn; return true; }
    __device__ __forceinline__ const char* A(const Unit& u) const { return Ab + (size_t)u.pm * tA; }
    __device__ __forceinline__ const char* B(const Unit& u) const { return Bb + (size_t)u.z * tB; }
};
struct SchedBal {
    int G, c; const char* Ab; const char* Bb; size_t tA, tB;
    __device__ __forceinline__ bool next(int i, Unit& u) const { int L;
        if (G == 256) { if (c < 128) { if (i > 0) return false; L = c; } else { if (i > 2) return false; L = 128 + (c - 128) + 128 * i; } }
        else { L = i * G + c; if (L >= 512) return false; }
        u.pm = L >> 3; u.pn = L & 7; u.z = 0; return true; }
    __device__ __forceinline__ const char* A(const Unit& u) const { return Ab + (size_t)u.pm * tA; }
    __device__ __forceinline__ const char* B(const Unit& u) const { return Bb + (size_t)u.pn * tB; }
};
struct SchedOff {
    int nN, n, c; const char* Ab; const char* Bb; size_t tA, tB;
    __device__ __forceinline__ bool next(int i, Unit& u) const { if (i > 0 || c < 0 || c >= n) return false; u.pm = c / nN; u.pn = c % nN; u.z = 0; return true; }
    __device__ __forceinline__ const char* A(const Unit& u) const { return Ab + (size_t)u.pm * tA; }
    __device__ __forceinline__ const char* B(const Unit& u) const { return Bb + (size_t)u.pn * tB; }
};
struct SchedGate {
    pg8::TileOrder ord; const char* A0; const char* A1; const char* B0; const char* B1; size_t tA, tB;
    __device__ __forceinline__ bool next(int j, Unit& u) const { u.z = j & 1; return ord.tile(j >> 1, u.pm, u.pn); }
    __device__ __forceinline__ const char* A(const Unit& u) const { return (u.z ? A1 : A0) + (size_t)u.pm * tA; }
    __device__ __forceinline__ const char* B(const Unit& u) const { return (u.z ? B1 : B0) + (size_t)u.pn * tB; }
};
struct MoeTab { const LAS int* tpre; const LAS int* cnt; };
__device__ __forceinline__ int moe_find(const MoeTab& t, int T) { int e = 0;
#pragma unroll 1
    for (int k = 1; k < 32; ++k) if (T >= t.tpre[k]) e = k;
    return e; }
struct SchedMoe1 {
    MoeTab tab; int G, vcu; const char* Ab; const char* Bb; const int* list;
    __device__ __forceinline__ bool next(int i, Unit& u) const { const int L = i * G + vcu; if (L >= tab.tpre[32] * 4) return false; u.pm = L >> 2; u.pn = L & 3; const int e = moe_find(tab, u.pm); u.z = e | ((u.pm - tab.tpre[e]) << 8); return true; }
    __device__ __forceinline__ const char* A(const Unit&) const { return Ab; }
    __device__ __forceinline__ const char* B(const Unit& u) const { return Bb + ((size_t)(u.z & 255) * 1024 + (size_t)u.pn * 256) * 2048; }
    __device__ __forceinline__ int arow(const Unit& u, int r) const { const int e = u.z & 255, c = tab.cnt[e]; int idx = (u.z >> 8) * 256 + r; idx = idx < c ? idx : c - 1; return list[e * NTOK + idx]; }
};
struct SchedMoe2 {
    MoeTab tab; int G, vcu; const char* Ab; const char* Bb;
    __device__ __forceinline__ bool next(int i, Unit& u) const { const int L = i * G + vcu; if (L >= tab.tpre[32] * 8) return false; u.pm = L >> 3; u.pn = L & 7; u.z = moe_find(tab, u.pm); return true; }
    __device__ __forceinline__ const char* A(const Unit& u) const { return Ab + (size_t)u.pm * (256 * 512); }
    __device__ __forceinline__ const char* B(const Unit& u) const { return Bb + ((size_t)u.z * 2048 + (size_t)u.pn * 256) * 512; }
};

#define EPI_ROWS_BEGIN  _Pragma("unroll") for (int ai = 0; ai < 2; ++ai) _Pragma("unroll") for (int m = 0; m < 4; ++m) { const int row = u.pm * 256 + ai * 128 + wr * 64 + m * 16 + fr;
#define EPI_ROWS_END    }
__device__ __forceinline__ f32x4 unpack4_u8(unsigned w) { return (f32x4){(float)(w & 0xffu), (float)((w >> 8) & 0xffu), (float)((w >> 16) & 0xffu), (float)(w >> 24)}; }
__device__ __forceinline__ void st16(bf16* p, const f32x4 a, const f32x4 b) { *(GAS u32x4*)p = pg8::pack8(a, b); }

__device__ __forceinline__ void store_pair16(const u32x2 wa, const u32x2 wb, unsigned char* pa, unsigned char* pb, int odd) {
    const auto sx = __builtin_amdgcn_permlane16_swap(wa.x, wb.x, false, false), sy = __builtin_amdgcn_permlane16_swap(wa.y, wb.y, false, false);
    const u32x4 w = {sx[0], sy[0], sx[1], sy[1]};
    *(GAS u32x4*)(odd ? pb - 8 : pa) = w;
}
struct EpiProj {
    static constexpr bool PERM = true;
    bf16 *QD, *KD, *VD; const float* rope_d; const float* rstd;
    __device__ __forceinline__ void operator()(f32x4 (&acc)[2][2][4][2], const Unit& u, int wr, int wc, int fr, int fq) const {
        const int pn = u.pn, colw = wc * 32 + 8 * fq;
        if (pn < 8) {
            bf16* dst = pn < 4 ? QD : KD; const float sc = pn < 4 ? C2D : 1.f; const bool rot = ((wc & 1) == 0) && fq < 2;
#pragma unroll
            for (int ai = 0; ai < 2; ++ai) {
                f32x4 cs[4][2]; float rs[4];
#pragma unroll
                for (int m = 0; m < 4; ++m) rs[m] = sc * (1.f / (XN_I8 * W_I8));
#pragma unroll
                for (int m = 0; m < 4; ++m) if (rot) { const int row = u.pm * 256 + ai * 128 + wr * 64 + m * 16 + fr; const GAS f32x4* t = (const GAS f32x4*)(rope_d + (size_t)row * 16 + fq * 8); cs[m][0] = t[0]; cs[m][1] = t[1]; }
#pragma unroll
                for (int m = 0; m < 4; ++m) { const int row = u.pm * 256 + ai * 128 + wr * 64 + m * 16 + fr;
#pragma unroll
                    for (int bj = 0; bj < 2; ++bj) { f32x4 v0 = acc_i2f(acc[ai][bj][m][0]), v1 = acc_i2f(acc[ai][bj][m][1]);
                        if (rot) {
#pragma unroll
                            for (int j = 0; j < 4; ++j) { const float c = cs[m][j >> 1][(j & 1) * 2], s = cs[m][j >> 1][(j & 1) * 2 + 1], x1 = v0[j], x2 = v1[j]; v0[j] = x1 * c - x2 * s; v1[j] = x2 * c + x1 * s; } }
                        st16(dst + (size_t)row * 1024 + (pn & 3) * 256 + bj * 128 + colw, v0 * rs[m], v1 * rs[m]); } }
            }
        } else if (pn < 12) {
            float rs[2][4];
#pragma unroll
            for (int ai = 0; ai < 2; ++ai)
#pragma unroll
                for (int m = 0; m < 4; ++m) rs[ai][m] = 1.f / (XN_I8 * W_I8);
            EPI_ROWS_BEGIN
#pragma unroll
                for (int bj = 0; bj < 2; ++bj) st16(VD + (size_t)row * 1024 + (pn - 8) * 256 + bj * 128 + colw, acc_i2f(acc[ai][bj][m][0]) * rs[ai][m], acc_i2f(acc[ai][bj][m][1]) * rs[ai][m]);
            EPI_ROWS_END
        }
    }
};
struct EpiGates {
    static constexpr bool PERM = true;
    bf16 *SGA, *SGB, *CQ, *CKV, *KM; float *ss_cq, *ss_ckv; const float* rope_m; float scale;
    __device__ __forceinline__ void operator()(f32x4 (&acc)[2][2][4][2], const Unit& u, int wr, int wc, int fr, int fq) const {
        const int pn = u.pn, colw = wc * 32 + 8 * fq;
        if (pn < 15) {
            unsigned char* dst = pn < 14 ? (unsigned char*)CQ + (pn - 12) * 256 : (unsigned char*)CKV; const int ld = pn < 14 ? 512 : 256; float* ss = pn < 14 ? ss_cq + (pn - 12) * 4 + wc : ss_ckv + wc; const int ssld = pn < 14 ? 8 : 4;
            EPI_ROWS_BEGIN
                float s = 0.f;
#pragma unroll
                for (int bj = 0; bj < 2; ++bj) { const f32x4 v0 = acc_i2f(acc[ai][bj][m][0]) * scale, v1 = acc_i2f(acc[ai][bj][m][1]) * scale;
                    s += (v0[0] * v0[0] + v0[1] * v0[1]) + (v0[2] * v0[2] + v0[3] * v0[3]) + (v1[0] * v1[0] + v1[1] * v1[1]) + (v1[2] * v1[2] + v1[3] * v1[3]);
                    u32x2 w; w.x = pg8::pack4_fp8(v0[0], v0[1], v0[2], v0[3]); w.y = pg8::pack4_fp8(v1[0], v1[1], v1[2], v1[3]);
                    *(GAS u32x2*)(dst + (size_t)row * ld + bj * 128 + colw) = w; }
                s += __shfl_xor(s, 16); s += __shfl_xor(s, 32);
                if (fq == 0) ss[(size_t)row * ssld] = s;
            EPI_ROWS_END
            return;
        }
        if (pn == 31) {
            if (wc < 2) {
                const int q = 4 * wc + fq;
#pragma unroll
                for (int ai = 0; ai < 2; ++ai) {
                    f32x4 cs[4][2];
#pragma unroll
                    for (int m = 0; m < 4; ++m) { const int row = u.pm * 256 + ai * 128 + wr * 64 + m * 16 + fr; const GAS f32x4* t = (const GAS f32x4*)(rope_m + (size_t)row * 64 + q * 8); cs[m][0] = t[0]; cs[m][1] = t[1]; }
#pragma unroll
                    for (int m = 0; m < 4; ++m) { const int row = u.pm * 256 + ai * 128 + wr * 64 + m * 16 + fr;
                        f32x4 v0 = acc_i2f(acc[ai][0][m][0]) * scale, v1 = acc_i2f(acc[ai][0][m][1]) * scale;
#pragma unroll
                        for (int j = 0; j < 4; ++j) { const float c = cs[m][j >> 1][(j & 1) * 2], s = cs[m][j >> 1][(j & 1) * 2 + 1], x1 = v0[j], x2 = v1[j]; v0[j] = x1 * c - x2 * s; v1[j] = x2 * c + x1 * s; }
                        u32x2 w; w.x = pg8::pack4_fp8(v0[0] * MLA_KS, v0[1] * MLA_KS, v0[2] * MLA_KS, v0[3] * MLA_KS); w.y = pg8::pack4_fp8(v1[0] * MLA_KS, v1[1] * MLA_KS, v1[2] * MLA_KS, v1[3] * MLA_KS);
                        *(GAS u32x2*)((unsigned char*)KM + (size_t)row * 64 + 8 * q) = w; }
                }
            }
            return;
        }
        unsigned char* dst = (unsigned char*)(pn < 23 ? SGA : SGB) + (pn < 23 ? pn - 15 : pn - 23) * 256; const float nsc = -scale * LOG2E;
#pragma unroll
        for (int ai = 0; ai < 2; ++ai)
#pragma unroll
            for (int mp = 0; mp < 2; ++mp)
#pragma unroll
                for (int bj = 0; bj < 2; ++bj) { u32x2 w[2];
#pragma unroll
                    for (int mm = 0; mm < 2; ++mm) { f32x4 v0 = acc_i2f(acc[ai][bj][2 * mp + mm][0]), v1 = acc_i2f(acc[ai][bj][2 * mp + mm][1]);
#pragma unroll
                        for (int j = 0; j < 4; ++j) { v0[j] = fmaxf(__builtin_amdgcn_rcpf(fmaf(__builtin_amdgcn_exp2f(v0[j] * nsc), 1.f / 255.f, 1.f / 255.f)), 1.f); v1[j] = fmaxf(__builtin_amdgcn_rcpf(fmaf(__builtin_amdgcn_exp2f(v1[j] * nsc), 1.f / 255.f, 1.f / 255.f)), 1.f); }
                        w[mm].x = pack4_u8(v0[0], v0[1], v0[2], v0[3]); w[mm].y = pack4_u8(v1[0], v1[1], v1[2], v1[3]); }
                    const int row = u.pm * 256 + ai * 128 + wr * 64 + 2 * mp * 16 + fr; unsigned char* pa = dst + (size_t)row * 2048 + bj * 128 + colw;
                    store_pair16(w[0], w[1], pa, pa + 16 * 2048, fq & 1); }
    }
};
struct EpiQup {
    static constexpr bool PERM = true;
    bf16* QM; const float* ss_cq; const float* rope_m;
    __device__ __forceinline__ void operator()(f32x4 (&acc)[2][2][4][2], const Unit& u, int wr, int wc, int fr, int fq) const {
        const int colw = wc * 32 + 8 * fq;
        int c0[2], hh[2], off[2];
#pragma unroll
        for (int bj = 0; bj < 2; ++bj) { c0[bj] = u.pn * 256 + bj * 128 + colw; hh[bj] = c0[bj] / 192; off[bj] = c0[bj] - hh[bj] * 192; }
#pragma unroll
        for (int ai = 0; ai < 2; ++ai)
#pragma unroll
            for (int mp = 0; mp < 2; ++mp) {
                f32x4 sa[2], sb[2], cs[2][2][2];
#pragma unroll
                for (int mm = 0; mm < 2; ++mm) { const int row = u.pm * 256 + ai * 128 + wr * 64 + (mp * 2 + mm) * 16 + fr; const GAS f32x4* sp = (const GAS f32x4*)(ss_cq + (size_t)row * 8); sa[mm] = sp[0]; sb[mm] = sp[1];
#pragma unroll
                    for (int bj = 0; bj < 2; ++bj) if (off[bj] >= 128) { const GAS f32x4* t = (const GAS f32x4*)(rope_m + (size_t)row * 64 + ((off[bj] - 128) >> 3) * 8); cs[mm][bj][0] = t[0]; cs[mm][bj][1] = t[1]; } }
                u32x2 qw[2][2];
#pragma unroll
                for (int mm = 0; mm < 2; ++mm) { const int m = mp * 2 + mm;
                    const float rs = rsqrtf((((sa[mm][0] + sa[mm][1]) + (sa[mm][2] + sa[mm][3])) + ((sb[mm][0] + sb[mm][1]) + (sb[mm][2] + sb[mm][3]))) * (1.f / 512.f) + 1e-6f) * (C2M * MLA_QS / WIN_SCALE);
#pragma unroll
                    for (int bj = 0; bj < 2; ++bj) { f32x4 v0 = acc[ai][bj][m][0] * rs, v1 = acc[ai][bj][m][1] * rs;
                        if (off[bj] >= 128) {
#pragma unroll
                            for (int j = 0; j < 4; ++j) { const float c = cs[mm][bj][j >> 1][(j & 1) * 2], s = cs[mm][bj][j >> 1][(j & 1) * 2 + 1], x1 = v0[j], x2 = v1[j]; v0[j] = x1 * c - x2 * s; v1[j] = x2 * c + x1 * s; } }
                        qw[mm][bj].x = pg8::pack4_fp8(v0[0], v0[1], v0[2], v0[3]); qw[mm][bj].y = pg8::pack4_fp8(v1[0], v1[1], v1[2], v1[3]); } }
#pragma unroll
                for (int bj = 0; bj < 2; ++bj) { unsigned char* pa = (unsigned char*)QM + (size_t)(u.pm * 256 + ai * 128 + wr * 64 + mp * 32 + fr) * 1536 + c0[bj]; store_pair16(qw[0][bj], qw[1][bj], pa, pa + 16 * 1536, fq & 1); }
            }
    }
};
struct EpiKVup {
    static constexpr bool PERM = true;
    bf16 *KM, *VM; const float* ss_ckv;
    __device__ __forceinline__ void operator()(f32x4 (&acc)[2][2][4][2], const Unit& u, int wr, int wc, int fr, int fq) const {
        const int colw = wc * 32 + 8 * fq, h = u.pn;
#pragma unroll
        for (int ai = 0; ai < 2; ++ai) {
            f32x4 sa[4];
#pragma unroll
            for (int m = 0; m < 4; ++m) { const int row = u.pm * 256 + ai * 128 + wr * 64 + m * 16 + fr; sa[m] = *(const GAS f32x4*)(ss_ckv + (size_t)row * 4); }
            u32x2 kw_[2], vw_[2];
#pragma unroll
            for (int m = 0; m < 4; ++m) { const int row = u.pm * 256 + ai * 128 + wr * 64 + m * 16 + fr;
                const float rs = rsqrtf(((sa[m][0] + sa[m][1]) + (sa[m][2] + sa[m][3])) * (1.f / 256.f) + 1e-6f) * (1.f / WIN_SCALE);
                { const f32x4 k0 = acc[ai][0][m][0] * (rs * MLA_KS), k1 = acc[ai][0][m][1] * (rs * MLA_KS); kw_[m & 1].x = pg8::pack4_fp8(k0[0], k0[1], k0[2], k0[3]); kw_[m & 1].y = pg8::pack4_fp8(k1[0], k1[1], k1[2], k1[3]); }
                { const f32x4 v0 = acc[ai][1][m][0] * (rs * MLA_VS), v1 = acc[ai][1][m][1] * (rs * MLA_VS); vw_[m & 1].x = pg8::pack4_fp8(v0[0], v0[1], v0[2], v0[3]); vw_[m & 1].y = pg8::pack4_fp8(v1[0], v1[1], v1[2], v1[3]); }
                if (m & 1) { const size_t o_ = (size_t)(row - 16) * 1024 + h * 128 + colw; store_pair16(kw_[0], kw_[1], (unsigned char*)KM + o_, (unsigned char*)KM + o_ + 16 * 1024, fq & 1); store_pair16(vw_[0], vw_[1], (unsigned char*)VM + o_, (unsigned char*)VM + o_ + 16 * 1024, fq & 1); } }
        }
    }
};
template <bool I32> struct EpiPlain {
    static constexpr bool PERM = true;
    bf16* O; int ldc; const float* ss; float ssn_inv, scale; int f8;
    __device__ __forceinline__ void operator()(f32x4 (&acc)[2][2][4][2], const Unit& u, int wr, int wc, int fr, int fq) const {
        const int colw = wc * 32 + 8 * fq;
        float rsv[2][4];
#pragma unroll
        for (int ai = 0; ai < 2; ++ai)
#pragma unroll
            for (int m = 0; m < 4; ++m) rsv[ai][m] = scale;
        if (ss) {
#pragma unroll
            for (int ai = 0; ai < 2; ++ai)
#pragma unroll
                for (int mp = 0; mp < 2; ++mp) { f32x4 q[2][2];
#pragma unroll
                    for (int mm = 0; mm < 2; ++mm) { const int row = u.pm * 256 + ai * 128 + wr * 64 + (mp * 2 + mm) * 16 + fr; const GAS f32x4* sp = (const GAS f32x4*)(ss + (size_t)row * 32) + 2 * fq;
                        q[mm][0] = sp[0]; q[mm][1] = sp[1]; }
#pragma unroll
                    for (int mm = 0; mm < 2; ++mm) { float t = ((q[mm][0][0] + q[mm][0][1]) + (q[mm][0][2] + q[mm][0][3])) + ((q[mm][1][0] + q[mm][1][1]) + (q[mm][1][2] + q[mm][1][3]));
                        t += __shfl_xor(t, 16); t += __shfl_xor(t, 32);
                        rsv[ai][mp * 2 + mm] = rsqrtf(t * ssn_inv + 1e-6f) * scale; } }
        }
        EPI_ROWS_BEGIN
            const float rs = rsv[ai][m];
#pragma unroll
            for (int bj = 0; bj < 2; ++bj) { const f32x4 v0 = (I32 ? acc_i2f(acc[ai][bj][m][0]) : acc[ai][bj][m][0]) * rs, v1 = (I32 ? acc_i2f(acc[ai][bj][m][1]) : acc[ai][bj][m][1]) * rs;
                u32x2 w; w.x = pg8::pack4_fp8(v0[0], v0[1], v0[2], v0[3]); w.y = pg8::pack4_fp8(v1[0], v1[1], v1[2], v1[3]); *(GAS u32x2*)((unsigned char*)O + (size_t)row * ldc + u.pn * 256 + bj * 128 + colw) = w; }
        EPI_ROWS_END
    }
};
struct EpiDown {
    static constexpr bool PERM = true;
    bf16* O; MoeTab tab; float scale;
    __device__ __forceinline__ void operator()(f32x4 (&acc)[2][2][4][2], const Unit& u, int wr, int wc, int fr, int fq) const {
        const int nvalid = tab.cnt[u.z] - (u.pm - tab.tpre[u.z]) * 256, odd = fq & 1, colp = wc * 32 + 8 * (fq & ~1);
#pragma unroll
        for (int ai = 0; ai < 2; ++ai)
#pragma unroll
            for (int mp = 0; mp < 2; ++mp)
#pragma unroll
                for (int bj = 0; bj < 2; ++bj) {
                    const f32x4 a0 = acc[ai][bj][2 * mp][0] * scale, a1 = acc[ai][bj][2 * mp][1] * scale, b0 = acc[ai][bj][2 * mp + 1][0] * scale, b1 = acc[ai][bj][2 * mp + 1][1] * scale;
                    const unsigned ax = pg8::pack4_fp8(a0[0], a0[1], a0[2], a0[3]), ay = pg8::pack4_fp8(a1[0], a1[1], a1[2], a1[3]), bx = pg8::pack4_fp8(b0[0], b0[1], b0[2], b0[3]), by = pg8::pack4_fp8(b1[0], b1[1], b1[2], b1[3]);
                    const auto sx = __builtin_amdgcn_permlane16_swap(ax, bx, false, false), sy = __builtin_amdgcn_permlane16_swap(ay, by, false, false);
                    const u32x4 w = {sx[0], sy[0], sx[1], sy[1]};
                    const int rl = ai * 128 + wr * 64 + (2 * mp + odd) * 16 + fr;
                    if (rl < nvalid) *(GAS u32x4*)((unsigned char*)O + (size_t)(u.pm * 256 + rl) * 2048 + u.pn * 256 + bj * 128 + colp) = w; }
    }
};
struct EpiGate {
    static constexpr bool PERM = true;
    const bf16 *SGA, *SGB; bf16* MG;
    __device__ __forceinline__ void mid(f32x4 (&acc)[2][2][4][2], const Unit& u, int wr, int wc, int fr, int fq) const {
        const int colw = wc * 32 + 8 * fq; const unsigned char* A8 = (const unsigned char*)SGA; const unsigned char* B8 = (const unsigned char*)SGB;
        EPI_ROWS_BEGIN
#pragma unroll
            for (int bj = 0; bj < 2; ++bj) { const size_t off = (size_t)row * 2048 + u.pn * 256 + bj * 128 + colw;
                const u32x2 a = *(const GAS u32x2*)(A8 + off), b = *(const GAS u32x2*)(B8 + off);
                const f32x4 a0 = unpack4_u8(a.x), a1 = unpack4_u8(a.y), b0 = unpack4_u8(b.x), b1 = unpack4_u8(b.y);
                f32x4& v0 = acc[ai][bj][m][0]; f32x4& v1 = acc[ai][bj][m][1];
                v0 = acc_i2f(v0); v1 = acc_i2f(v1);
#pragma unroll
                for (int j = 0; j < 4; ++j) { v0[j] *= a0[j] * __builtin_amdgcn_rcpf(b0[j]) * (1.f / (OA_I8 * WOA_I8)); v1[j] *= a1[j] * __builtin_amdgcn_rcpf(b1[j]) * (1.f / (OA_I8 * WOA_I8)); } }
        EPI_ROWS_END
    }
    __device__ __forceinline__ void operator()(f32x4 (&acc)[2][2][4][2], const Unit& u, int wr, int wc, int fr, int fq) const {
        const int colw = wc * 32 + 8 * fq; const unsigned char* B8 = (const unsigned char*)SGB;
#pragma unroll
        for (int ai = 0; ai < 2; ++ai) {
            u32x2 g[4][2];
#pragma unroll
            for (int m = 0; m < 4; ++m)
#pragma unroll
                for (int bj = 0; bj < 2; ++bj) { const int row = u.pm * 256 + ai * 128 + wr * 64 + m * 16 + fr; g[m][bj] = *(const GAS u32x2*)(B8 + (size_t)row * 2048 + u.pn * 256 + bj * 128 + colw); }
#pragma unroll
            for (int mp = 0; mp < 2; ++mp)
#pragma unroll
                for (int bj = 0; bj < 2; ++bj) { u32x2 w[2];
#pragma unroll
                    for (int mm = 0; mm < 2; ++mm) { const int m = 2 * mp + mm; const f32x4 g0 = unpack4_u8(g[m][bj].x), g1 = unpack4_u8(g[m][bj].y);
                        const f32x4 v0 = acc[ai][bj][m][0] * g0, v1 = acc[ai][bj][m][1] * g1; constexpr float c_ = MG_SCALE / 255.f;
                        w[mm].x = pack4_u8(fmaf(v0[0], c_, 128.f), fmaf(v0[1], c_, 128.f), fmaf(v0[2], c_, 128.f), fmaf(v0[3], c_, 128.f)) ^ 0x80808080u;
                        w[mm].y = pack4_u8(fmaf(v1[0], c_, 128.f), fmaf(v1[1], c_, 128.f), fmaf(v1[2], c_, 128.f), fmaf(v1[3], c_, 128.f)) ^ 0x80808080u; }
                    const int row = u.pm * 256 + ai * 128 + wr * 64 + 2 * mp * 16 + fr; unsigned char* pa = (unsigned char*)MG + (size_t)row * 2048 + u.pn * 256 + bj * 128 + colw;
                    store_pair16(w[0], w[1], pa, pa + 16 * 2048, fq & 1); }
        }
    }
};
template <bool BASE_BF16, bool I32ACC = false> struct EpiResid {
    static constexpr bool PERM = true;
    const void* base; bf16* HB; float* ss; unsigned char* H8; float ascale;
    __device__ __forceinline__ void operator()(f32x4 (&acc)[2][2][4][2], const Unit& u, int wr, int wc, int fr, int fq) const {
        const int colw = wc * 32 + 8 * fq;
#pragma unroll
        for (int ai = 0; ai < 2; ++ai) {
            if constexpr (BASE_BF16) {
#pragma unroll
                for (int m = 0; m < 4; ++m)
#pragma unroll
                    for (int bj = 0; bj < 2; ++bj) { const int row = u.pm * 256 + ai * 128 + wr * 64 + m * 16 + fr; const u32x4 g = *(const GAS u32x4*)((const bf16*)base + (size_t)row * 2048 + u.pn * 256 + bj * 128 + colw);
                        f32x4& v0 = acc[ai][bj][m][0]; f32x4& v1 = acc[ai][bj][m][1];
                        if constexpr (I32ACC) { v0 = __builtin_convertvector(__builtin_bit_cast(pg8::i32x4, v0), f32x4); v1 = __builtin_convertvector(__builtin_bit_cast(pg8::i32x4, v1), f32x4); }
                        v0[0] = v0[0] * ascale + pg8::bf_lo(g.x); v0[1] = v0[1] * ascale + pg8::bf_hi(g.x); v0[2] = v0[2] * ascale + pg8::bf_lo(g.y); v0[3] = v0[3] * ascale + pg8::bf_hi(g.y); v1[0] = v1[0] * ascale + pg8::bf_lo(g.z); v1[1] = v1[1] * ascale + pg8::bf_hi(g.z); v1[2] = v1[2] * ascale + pg8::bf_lo(g.w); v1[3] = v1[3] * ascale + pg8::bf_hi(g.w); }
            } else {
#pragma unroll
                for (int m = 0; m < 4; ++m)
#pragma unroll
                    for (int bj = 0; bj < 2; ++bj) { const int row = u.pm * 256 + ai * 128 + wr * 64 + m * 16 + fr; const size_t off = (size_t)row * 2048 + u.pn * 256 + bj * 128 + colw;
                        acc[ai][bj][m][0] += *(const GAS f32x4*)((const float*)base + off); acc[ai][bj][m][1] += *(const GAS f32x4*)((const float*)base + off + 4); }
            }
            u32x2 h8w[4][2];
#pragma unroll
            for (int m = 0; m < 4; ++m) { const int row = u.pm * 256 + ai * 128 + wr * 64 + m * 16 + fr; float s = 0.f;
#pragma unroll
                for (int bj = 0; bj < 2; ++bj) { const size_t off = (size_t)row * 2048 + u.pn * 256 + bj * 128 + colw; const f32x4 v0 = acc[ai][bj][m][0], v1 = acc[ai][bj][m][1];
                    st16(HB + off, v0, v1);
                    if (H8) { h8w[m][bj].x = pack4_i8(v0[0] * H_I8, v0[1] * H_I8, v0[2] * H_I8, v0[3] * H_I8); h8w[m][bj].y = pack4_i8(v1[0] * H_I8, v1[1] * H_I8, v1[2] * H_I8, v1[3] * H_I8); }
                    s += (v0[0] * v0[0] + v0[1] * v0[1]) + (v0[2] * v0[2] + v0[3] * v0[3]) + (v1[0] * v1[0] + v1[1] * v1[1]) + (v1[2] * v1[2] + v1[3] * v1[3]); }
                if (ss) { s += __shfl_xor(s, 16); s += __shfl_xor(s, 32); if (fq == 0) ss[(size_t)row * 32 + u.pn * 4 + wc] = s; } }
            if (H8) {
#pragma unroll
                for (int mp = 0; mp < 2; ++mp)
#pragma unroll
                    for (int bj = 0; bj < 2; ++bj) { const int row = u.pm * 256 + ai * 128 + wr * 64 + 2 * mp * 16 + fr; unsigned char* pa = H8 + (size_t)row * 2048 + u.pn * 256 + bj * 128 + colw;
                        store_pair16(h8w[2 * mp][bj], h8w[2 * mp + 1][bj], pa, pa + 16 * 2048, fq & 1); } }
        }
    }
};
struct EpiHid {
    static constexpr bool PERM = true;
    bf16* HID; const float* listr; const LAS int* cnt;
    __device__ __forceinline__ void operator()(f32x4 (&acc)[2][2][4][2], const Unit& u, int wr, int wc, int fr, int fq) const {
        const int colw = wc * 32 + 8 * fq, e = u.z & 255, tl = u.z >> 8, c = cnt[e];
        float rsv[2][4];
#pragma unroll
        for (int ai = 0; ai < 2; ++ai)
#pragma unroll
            for (int m = 0; m < 4; ++m) { const int r = ai * 128 + wr * 64 + m * 16 + fr; int idx = tl * 256 + r; idx = idx < c ? idx : c - 1; rsv[ai][m] = listr[e * NTOK + idx]; }
#pragma unroll
        for (int ai = 0; ai < 2; ++ai) { u32x2 hw[2];
#pragma unroll
            for (int m = 0; m < 4; ++m) {
                const float rs = rsv[ai][m] * (1.f / (H_I8 * W_I8));
                f32x4 o0, o1;
                const f32x4 ag0 = acc_i2f(acc[ai][0][m][0]), au0 = acc_i2f(acc[ai][1][m][0]), ag1 = acc_i2f(acc[ai][0][m][1]), au1 = acc_i2f(acc[ai][1][m][1]);
                const float nrs = -rs * LOG2E, rs2 = rs * rs * HID_SCALE;
#pragma unroll
                for (int j = 0; j < 4; ++j) { o0[j] = ag0[j] * au0[j] * rs2 * __builtin_amdgcn_rcpf(1.f + __builtin_amdgcn_exp2f(ag0[j] * nrs)); o1[j] = ag1[j] * au1[j] * rs2 * __builtin_amdgcn_rcpf(1.f + __builtin_amdgcn_exp2f(ag1[j] * nrs)); }
                hw[m & 1].x = pg8::pack4_fp8(o0[0], o0[1], o0[2], o0[3]); hw[m & 1].y = pg8::pack4_fp8(o1[0], o1[1], o1[2], o1[3]);
                if (m & 1) { unsigned char* pa = (unsigned char*)HID + (size_t)(u.pm * 256 + ai * 128 + wr * 64 + (m - 1) * 16 + fr) * 512 + u.pn * 128 + colw; store_pair16(hw[0], hw[1], pa, pa + 16 * 512, fq & 1); } } }
    }
};

__device__ __forceinline__ void store_o_bf16(const att::f32x16 (&o)[4], bf16* O, int ldo, int wid, int r32, int hi) {
#pragma unroll
    for (int r = 0; r < 16; ++r) { bf16* rowp = O + (size_t)(wid * 32 + att::crow(r, hi)) * ldo + r32;
#pragma unroll
        for (int d0 = 0; d0 < 4; ++d0) rowp[d0 * 32] = (bf16)(pg8::cvt_pk_bf16(o[d0][r], 0.f) & 0xffffu); }
}
__device__ __forceinline__ void store_ot_bf16(const att::f32x16 (&o)[4], bf16* O, int ldo, int wid, int r32, int hi) {
    bf16* rowp = O + (size_t)(wid * 32 + r32) * ldo + 4 * hi;
#pragma unroll
    for (int d0 = 0; d0 < 4; ++d0)
#pragma unroll
        for (int rg = 0; rg < 4; ++rg) { u32x2 w; w.x = pg8::cvt_pk_bf16(o[d0][4 * rg], o[d0][4 * rg + 1]); w.y = pg8::cvt_pk_bf16(o[d0][4 * rg + 2], o[d0][4 * rg + 3]); *(GAS u32x2*)(rowp + 32 * d0 + 8 * rg) = w; }
}
__device__ __forceinline__ void store_ot_fp8(const att::f32x16 (&o)[4], unsigned char* O8, int ldo_bytes, int wid, int r32, int hi, float scale) {
    unsigned char* rowp = O8 + (size_t)(wid * 32 + r32) * ldo_bytes + 4 * hi;
#pragma unroll
    for (int d0 = 0; d0 < 4; ++d0)
#pragma unroll
        for (int rg = 0; rg < 4; ++rg) *(GAS unsigned*)(rowp + 32 * d0 + 8 * rg) = pg8::pack4_fp8(o[d0][4 * rg] * scale, o[d0][4 * rg + 1] * scale, o[d0][4 * rg + 2] * scale, o[d0][4 * rg + 3] * scale);
}
__device__ __forceinline__ void store_o_i8(const att::f32x16 (&o)[4], unsigned char* O8, int ldo_bytes, int wid, int r32, int hi, float scale) {
#pragma unroll
    for (int r = 0; r < 16; ++r) { unsigned char* rowp = O8 + (size_t)(wid * 32 + att::crow(r, hi)) * ldo_bytes + r32;
#pragma unroll
        for (int d0 = 0; d0 < 4; ++d0) rowp[d0 * 32] = (unsigned char)((__builtin_amdgcn_cvt_pk_u8_f32(o[d0][r] * scale + 128.f, 0, 0u) ^ 0x80u) & 0xffu); }
}
__device__ __forceinline__ void store_o_i8_lds(const att::f32x16 (&o)[4], LAS unsigned char* img, unsigned char* O8, int ldo_bytes, int tid, float scale) {
    const int wid = tid >> 6, r32 = tid & 31, hi = (tid >> 5) & 1;
#pragma unroll
    for (int r = 0; r < 16; ++r) { LAS unsigned char* rowp = img + (wid * 32 + att::crow(r, hi)) * 128 + r32;
#pragma unroll
        for (int d0 = 0; d0 < 4; ++d0) rowp[d0 * 32] = (unsigned char)((__builtin_amdgcn_cvt_pk_u8_f32(o[d0][r] * scale + 128.f, 0, 0u) ^ 0x80u) & 0xffu); }
    __syncthreads();
#pragma unroll
    for (int i = 0; i < 4; ++i) { const int c = tid + 512 * i, row = c >> 3, c16 = c & 7;
        *(GAS u32x4*)(O8 + (size_t)row * ldo_bytes + c16 * 16) = *(const LAS u32x4*)(img + row * 128 + c16 * 16); }
}
__device__ __forceinline__ void store_ot_fp8_lds(const att::f32x16 (&o)[4], LAS unsigned char* img, unsigned char* O8, int ldo_bytes, int tid, float scale) {
    const int wid = tid >> 6, r32 = tid & 31, hi = (tid >> 5) & 1;
    LAS unsigned char* rowp = img + (wid * 32 + r32) * 144 + 4 * hi;
#pragma unroll
    for (int d0 = 0; d0 < 4; ++d0)
#pragma unroll
        for (int rg = 0; rg < 4; ++rg) *(LAS unsigned*)(rowp + 32 * d0 + 8 * rg) = pg8::pack4_fp8(o[d0][4 * rg] * scale, o[d0][4 * rg + 1] * scale, o[d0][4 * rg + 2] * scale, o[d0][4 * rg + 3] * scale);
    __syncthreads();
#pragma unroll
    for (int i = 0; i < 4; ++i) { const int c = tid + 512 * i, row = c >> 3, c16 = c & 7;
        *(GAS u32x4*)(O8 + (size_t)row * ldo_bytes + c16 * 16) = *(const LAS u32x4*)(img + row * 144 + c16 * 16); }
    __syncthreads();
}
}
namespace mk {
constexpr int N_PHASES = 13;
#define WIN_T ((bf16*)(ws + WS_WIN_T))
#define WOA_T ((bf16*)(ws + WS_WOA_T))
#define WOB_T ((bf16*)(ws + WS_WOB_T))
#define WOUT_T ((bf16*)(ws + WS_WOUT_T))
#define WUQ_T ((bf16*)(ws + WS_WUQ_T))
#define WUKV_T ((bf16*)(ws + WS_WUKV_T))
#define WCQ_T ((bf16*)(ws + WS_WCQ_T))
#define WCKV_T ((bf16*)(ws + WS_WCKV_T))
#define WCO_T ((bf16*)(ws + WS_WCO_T))
#define XN ((bf16*)(ws + WS_XN))
#define QM ((bf16*)(ws + WS_QM))
#define MG ((bf16*)(ws + WS_MG))
#define QD ((bf16*)(ws + WS_QD))
#define KD ((bf16*)(ws + WS_KD))
#define VD ((bf16*)(ws + WS_VD))
#define CQ ((bf16*)(ws + WS_CQ))
#define CKV ((bf16*)(ws + WS_CKV))
#define SGA ((bf16*)(ws + WS_SGA))
#define SGB ((bf16*)(ws + WS_SGB))
#define KM ((bf16*)(ws + WS_KM))
#define VM ((bf16*)(ws + WS_VM))
#define OB ((bf16*)(ws + WS_OB))
#define MEMN ((bf16*)(ws + WS_MEMN))
#define KVC ((bf16*)(ws + WS_KVC))
#define HB ((bf16*)(ws + WS_HB))
#define QC ((bf16*)(ws + WS_QC))
#define OC ((bf16*)(ws + WS_OC))
#define WGU_T ((bf16*)(ws + WS_WGU_T))
#define WD_T ((bf16*)(ws + WS_WD_T))
#define HID ((bf16*)(ws + WS_HID))
#define Y ((bf16*)(ws + WS_Y))
#define SS_CQ ((float*)(ws + WS_SS_CQ))
#define SS_CKV ((float*)(ws + WS_SS_CKV))
#define SS_H1 ((float*)(ws + WS_SS_H1))
#define ROPE_D ((float*)(ws + WS_ROPE_D))
#define ROPE_M ((float*)(ws + WS_ROPE_M))
#define WR_T ((float*)(ws + WS_WR_T))
#define TOKES ((int*)(ws + WS_TOKES))
#define TOKW ((float*)(ws + WS_TOKW))
#define SCAL ((float*)(ws + WS_SCAL))
#define LIST ((int*)(ws + WS_LIST))
#define LISTR ((float*)(ws + WS_LISTR))


__device__ __forceinline__ int mk_lane_now() { int t; asm volatile("v_mbcnt_lo_u32_b32 %0, -1, 0\n\tv_mbcnt_hi_u32_b32 %0, -1, %0" : "=v"(t)); return t; }
typedef const __attribute__((address_space(4))) Args* ArgP;
constexpr int MOE_I_GU = (2048 / 64) * (1024 / 32), MOE_I_DN = (512 / 64) * (2048 / 32), MOE_I_E = MOE_I_GU + MOE_I_DN, MOE_CONV_ITEMS = 32 * MOE_I_E;
constexpr int MOE_N_GU = 32 * MOE_I_GU, MOE_N_DN = 32 * MOE_I_DN, MOE_GU_P5 = MOE_N_GU - 6400;
constexpr int MOE_CONV_P5 = (MOE_CONV_ITEMS * 91 / 100) / 8 * 8;
__device__ __forceinline__ void moe_conv_item(int it, ArgP ap, unsigned char* ws, LAS float* scr, int lane) {
    const int e = it / MOE_I_E; int r = it - e * MOE_I_E; const int nl = lane & 31;
    if (r < MOE_I_GU) { const int nblk = 1024 / 32, kb = r / nblk, nb = r % nblk, n = nb * 32, pn = n >> 8, half = (n >> 7) & 1, j = n & 127;
        const float* src = (half ? ap->w_up : ap->w_gate) + (size_t)e * 2048 * 512;
        transpose_item<true>(src, 512, pn * 128 + j + nl, ap->ffn_norm_g, kb * 64, (bf16*)((unsigned char*)WGU_T + (size_t)e * 1024 * 2048), 2048, n, scr, lane, WGU_SCALE); }
    else { r -= MOE_I_GU; const int nblk = 2048 / 32, kb = r / nblk, nb = r % nblk;
        transpose_item<true>(ap->w_down + (size_t)e * 512 * 2048, 2048, nb * 32 + nl, nullptr, kb * 64, (bf16*)((unsigned char*)WD_T + (size_t)e * 2048 * 512), 512, nb * 32, scr, lane, WD_SCALE); }
}
__device__ __forceinline__ TItem moe_item(int it, ArgP ap, unsigned char* ws, int lane) {
    const int e = it / MOE_I_E; int r = it - e * MOE_I_E; const int nl = lane & 31;
    if (r < MOE_I_GU) { const int nblk = 1024 / 32, kb = r / nblk, nb = r % nblk, n = nb * 32, pn = n >> 8, half = (n >> 7) & 1, j = n & 127;
        const float* src = (half ? ap->w_up : ap->w_gate) + (size_t)e * 2048 * 512;
        return tr_make(src, 512, pn * 128 + j + nl, ap->ffn_norm_g, kb * 64, (unsigned char*)WGU_T + (size_t)e * 1024 * 2048, 2048, n, lane, 2, W_I8); }
    r -= MOE_I_GU; const int nblk = 2048 / 32, kb = r / nblk, nb = r % nblk;
    return tr_make(ap->w_down + (size_t)e * 512 * 2048, 2048, nb * 32 + nl, nullptr, kb * 64, (unsigned char*)WD_T + (size_t)e * 2048 * 512, 512, nb * 32, lane, true, WD_SCALE);
}
template <int KIND> __device__ __forceinline__ int moe_map(int i) { return KIND == 0 ? (i / MOE_I_GU) * MOE_I_E + i % MOE_I_GU : (i / MOE_I_DN) * MOE_I_E + MOE_I_GU + i % MOE_I_DN; }
template <int KIND> __device__ __forceinline__ void moe_conv_run(int first, int limit, int stride, ArgP ap, unsigned char* ws, LAS float* scr, int lane) {
    if (first >= limit) return;
    TItem cur = moe_item(moe_map<KIND>(first), ap, ws, lane); float v[32]; tr_load(cur, v);
    for (int it = first; ; ) { const int nx = it + stride; const bool has = nx < limit; TItem nt_; float w[32];
        if (has) { nt_ = moe_item(moe_map<KIND>(nx), ap, ws, lane); tr_load(nt_, w); }
        tr_finish(cur, v, scr, lane);
        if (!has) break;
        cur = nt_; it = nx;
#pragma unroll
        for (int i = 0; i < 32; ++i) v[i] = w[i]; }
}
__device__ __forceinline__ ArgP argp() { ArgP p = (ArgP)__builtin_amdgcn_kernarg_segment_ptr(); asm volatile("" : "+s"(p)); return p; }
__global__ void __launch_bounds__(NWAVES * 64, 2) fused_fwd(Args a_kernarg) {
    extern __shared__ __attribute__((aligned(16))) unsigned char lds_raw[];
    LAS unsigned char* lds = (LAS unsigned char*)lds_raw;
    volatile LAS unsigned* MISC = (volatile LAS unsigned*)(lds + MISC_OFF);
    const int tid0 = threadIdx.x;
    const int wave0 = __builtin_amdgcn_readfirstlane(tid0 >> 6);
#define MK_TID() (wave0 * 64 + mk_lane_now())
    const int G = gridDim.x, bx = blockIdx.x, vcu = (G % 8 == 0) ? (bx % 8) * (G / 8) + bx / 8 : bx;
    for (int u = tid0; u < (LDS_BYTES - LDSCTL_OFF) / 4; u += NWAVES * 64) ((LAS unsigned*)(lds + LDSCTL_OFF))[u] = 0u;
    __syncthreads();
    (void)xcd_barrier_post((unsigned*)((gu32*)argp()->ws + CW_BAR), MISC + 8);
#define MK_BAR() XcdBarrier{(unsigned*)((gu32*)argp()->ws + CW_BAR), xb_xcc_id(), (volatile LAS unsigned*)(lds + MISC_OFF) + 8}
    const int lo = argp()->ph_lo, hi = argp()->ph_hi & 0xffff;
#ifdef MK_PROBE_SKIP
    const bool skip_epi = (argp()->ph_hi >> 16) & 1;
#else
    constexpr bool skip_epi = false;
#endif
#ifndef MK_P3_DIFF
#define MK_P3_DIFF 1
#endif
#ifndef MK_P3_MLA
#define MK_P3_MLA 1
#endif
#ifndef MK_PHASE_MASK
#define MK_PHASE_MASK 0xFFFF
#endif
#define IN(k) (((MK_PHASE_MASK >> (k)) & 1) && lo <= (k) && (k) < hi)
#define PHASE_IDS() int tid = MK_TID(); asm volatile("" : "+v"(tid)); const int lane = tid & 63, wave = __builtin_amdgcn_readfirstlane(tid >> 6), gw = vcu * NWAVES + wave; \
    LAS float* scr = (LAS float*)(lds + RING_OFF + wave * 16384); const ArgP ap = argp(); unsigned char* const ws = ap->ws; gu32* const ctl = (gu32*)ws; (void)lane; (void)gw; (void)scr; (void)ap; (void)ctl
#define SEAM(k) do { if (IN(k) && IN((k) + 1)) { const XcdBarrier bar_ = MK_BAR(); xcd_barrier(bar_, MK_TID()); } } while (0)
    const int NGW = G * NWAVES;

    if (IN(0)) { asm volatile("; MKPHASE 0" ::: "memory"); PHASE_IDS();
        constexpr int I_IN = (2048 / 64) * (NPROJ / 32), I_OA = (1024 / 64) * (2048 / 32), I_OUT = (2048 / 64) * (2048 / 32), I_UQ = (512 / 64) * (1536 / 32), I_UKV = (256 / 64) * (2048 / 32),
                      I_CQ = (2048 / 64) * (512 / 32), I_CKV = (2048 / 64) * (1024 / 32), I_CO = (512 / 64) * (2048 / 32);
        constexpr int NITEMS = I_IN + 2 * I_OA + I_OUT + I_UQ + I_UKV + I_CQ + I_CKV + I_CO;
        auto p0_item = [&](int it) -> TItem { int r = it; const int nl = lane & 31;
            if (r < I_IN) { const int nblk = NPROJ / 32, kb = r / nblk, nb = r % nblk, n0 = nb * 32;
                if (n0 >= 3072) { const int r8 = n0 < 3840 ? n0 - 3072 + 4096 : (n0 < 7936 ? n0 - 3840 : n0 - 7936 + 4864);
                    return tr_make(ap->w_in, D_IN, win_src(n0 + nl), nullptr, kb * 64, ws + WS_WIN8, 2048, r8, lane, 2, W_I8); }
                return tr_make(ap->w_in, D_IN, win_src(n0 + nl), nullptr, kb * 64, WIN_T, 2048, n0, lane, 2, W_I8); }
            r -= I_IN;
            if (r < I_OA) { const int nblk = 2048 / 32, kb = r / nblk, nb = r % nblk; return tr_make(ap->w_o_diff, 2048, nb * 32 + nl, nullptr, kb * 64, WOA_T, 2048, nb * 32, lane, 2, WOA_I8); } r -= I_OA;
            if (r < I_OA) { const int nblk = 2048 / 32, kb = r / nblk, nb = r % nblk; return tr_make(ap->w_o_mla, 2048, nb * 32 + nl, nullptr, kb * 64, WOB_T, 2048, nb * 32, lane, true, 64.f); } r -= I_OA;
            if (r < I_OUT) { const int nblk = 2048 / 32, kb = r / nblk, nb = r % nblk; return tr_make(ap->w_out, 2048, nb * 32 + nl, nullptr, kb * 64, WOUT_T, 2048, nb * 32, lane, 2, WOUT_SCALE); } r -= I_OUT;
            if (r < I_UQ) { const int nblk = 1536 / 32, kb = r / nblk, nb = r % nblk; return tr_make(ap->w_uq, 1536, wuq_src(nb * 32 + nl), ap->mla_q_norm_g, kb * 64, WUQ_T, 512, nb * 32, lane, true, WIN_SCALE); } r -= I_UQ;
            if (r < I_UKV) { const int nblk = 2048 / 32, kb = r / nblk, nb = r % nblk; return tr_make(ap->w_ukv, 2048, nb * 32 + nl, ap->mla_kv_norm_g, kb * 64, WUKV_T, 256, nb * 32, lane, true, WIN_SCALE); } r -= I_UKV;
            if (r < I_CQ) { const int nblk = 512 / 32, kb = r / nblk, nb = r % nblk; return tr_make(ap->w_cq, 512, nb * 32 + nl, ap->cross_norm_g, kb * 64, ws + WS_WCQ8, 2048, nb * 32, lane, 2, W_I8); } r -= I_CQ;
            if (r < I_CKV) { const int nblk = 1024 / 32, kb = r / nblk, nb = r % nblk; return tr_make(ap->w_ckv, 1024, nb * 32 + nl, nullptr, kb * 64, ws + WS_WCKV8, 2048, nb * 32, lane, true, WIN_SCALE); } r -= I_CKV;
            { const int nblk = 2048 / 32, kb = r / nblk, nb = r % nblk; return tr_make(ap->w_co, 2048, nb * 32 + nl, nullptr, kb * 64, WCO_T, 512, nb * 32, lane, true, 64.f); } };
        if (gw < NITEMS) {
            TItem cur = p0_item(gw); float v[32]; tr_load(cur, v);
            for (int it = gw; ; ) { const int nx = it + NGW; const bool has = nx < NITEMS; TItem nt_; float w[32];
                if (has) { nt_ = p0_item(nx); tr_load(nt_, w); }
                tr_finish(cur, v, scr, lane);
                if (!has) break;
                cur = nt_; it = nx;
#pragma unroll
                for (int i = 0; i < 32; ++i) v[i] = w[i]; } }
        { int m = gw;
          for (; m + 3 * NGW < NTOK; m += 4 * NGW) rms_rowsN_x<4>(ap->x, ap->attn_norm_g, ws + WS_XN8, HB, (float*)(ws + WS_RSTDX), m, NGW, lane);
          for (; m + NGW < NTOK; m += 2 * NGW) { const int m2 = m + NGW;
              rms_rows2_x(ap->x + (size_t)m * DM, ap->x + (size_t)m2 * DM, ap->attn_norm_g, ws + WS_XN8 + (size_t)m * DM, ws + WS_XN8 + (size_t)m2 * DM, HB + (size_t)m * DM, HB + (size_t)m2 * DM, (float*)(ws + WS_RSTDX) + m, (float*)(ws + WS_RSTDX) + m2, lane); }
          if (m < NTOK) rms_row_to_bf16(ap->x + (size_t)m * DM, ap->attn_norm_g, nullptr, lane, ws + WS_XN8 + (size_t)m * DM, HB + (size_t)m * DM, (float*)(ws + WS_RSTDX) + m, XN_I8); }
        for (int m = gw; m < NB * MEML; m += NGW) rms_row_to_bf16(ap->mem + (size_t)m * DM, ap->mem_norm_g, MEMN + (size_t)m * DM, lane, ws + WS_MEMN8 + (size_t)m * DM);
        for (int idx = (vcu * NWAVES * 64) + tid; idx < NTOK * 40; idx += G * NWAVES * 64) { const int tok = idx / 40, j = idx - tok * 40; const float p = (float)ap->positions[tok];
            if (j < 8) { const float inv = powf(500000.0f, -(float)j * 2.0f / 16.0f), ang = p * inv; ROPE_D[(size_t)tok * 16 + j * 2] = cosf(ang); ROPE_D[(size_t)tok * 16 + j * 2 + 1] = sinf(ang); }
            else { const int i = j - 8; const float inv = powf(500000.0f, -(float)i * 2.0f / 64.0f), ang = p * inv; ROPE_M[(size_t)tok * 64 + i * 2] = cosf(ang); ROPE_M[(size_t)tok * 64 + i * 2 + 1] = sinf(ang); } }
        for (int idx = (vcu * NWAVES * 64) + tid; idx < 48 * DM; idx += G * NWAVES * 64) { const int j = idx / DM, k = idx - j * DM; float v = 0.f;
            if (j < 4) v = ap->w_rg[k * 4 + j] * ap->ffn_norm_g[k]; else if (j < 36) v = ap->w_re[k * 32 + (j - 4)] * ap->ffn_norm_g[k];
            const unsigned hi = pg8::cvt_pk_bf16(v, 0.f) & 0xffffu; const float r = v - __uint_as_float(hi << 16); const unsigned lo = pg8::cvt_pk_bf16(r, 0.f) & 0xffffu;
            ((bf16*)WR_T)[idx] = (bf16)hi; ((bf16*)WR_T)[48 * DM + idx] = (bf16)lo; }
        if (bx == 0 && wave == 0) { const float p1 = wave_sum(ap->lq1[lane] * ap->lk1[lane]), p2 = wave_sum(ap->lq2[lane] * ap->lk2[lane]); if (lane == 0) SCAL[0] = expf(p1) - expf(p2) + 0.2f; }
    }
    SEAM(0);

    if (IN(1)) { asm volatile("; MKPHASE 1" ::: "memory"); PHASE_IDS();
        { SchedProj S; S.ord.init(NTOK / 256, 12, G, bx); S.Ab = (const char*)(ws + WS_XN8); S.Bb = (const char*)WIN_T; S.tA = (size_t)256 * 2048; S.tB = (size_t)256 * 2048; S.fp8 = 0;
          EpiProj E{QD, KD, VD, ROPE_D, (const float*)(ws + WS_RSTDX)};
          pg8::gemm_phase<EpiProj, SchedProj, false, true, false, 1, false, true>(lds + RING_OFF, 2048, 2048, 2048, S, E, MK_TID(), skip_epi); }
        { SchedProj S; S.ord.init(NTOK / 256, 20, G, bx); S.Ab = (const char*)(ws + WS_XN8); S.Bb = (const char*)(ws + WS_WIN8); S.tA = (size_t)256 * 2048; S.tB = (size_t)256 * 2048; S.fp8 = 1;
          EpiGates E{SGA, SGB, CQ, CKV, (bf16*)(ws + WS_KPE), SS_CQ, SS_CKV, ROPE_M, 1.f / (XN_I8 * W_I8)};
          pg8::gemm_phase<EpiGates, SchedProj, false, true, false, 1, false, true>(lds + RING_OFF, 2048, 2048, 2048, S, E, MK_TID(), skip_epi); }
    }
    SEAM(1);

    if (IN(2)) { asm volatile("; MKPHASE 2" ::: "memory"); PHASE_IDS();
        { SchedTile S; S.ord.init(NTOK / 256, 1536 / 256, G, vcu); S.Ab = (const char*)CQ; S.Bb = (const char*)WUQ_T; S.tA = (size_t)256 * 512; S.tB = (size_t)256 * 512;
          EpiQup E{QM, SS_CQ, ROPE_M}; pg8::gemm_phase<EpiQup, SchedTile, false, true, false, 1>(lds + RING_OFF, 512, 512, 512, S, E, MK_TID(), skip_epi); }
        { SchedBal S{G, vcu, (const char*)CKV, (const char*)WUKV_T, (size_t)256 * 256, (size_t)256 * 256};
          EpiKVup E{KM, VM, SS_CKV}; pg8::gemm_phase<EpiKVup, SchedBal, false, true, false, 1>(lds + RING_OFF, 256, 256, 256, S, E, MK_TID(), skip_epi); }
    }
    SEAM(2);

    if (IN(3)) { asm volatile("; MKPHASE 3" ::: "memory"); PHASE_IDS();
        char* al = (char*)lds_raw + RING_OFF;
        const float lam = __uint_as_float(__builtin_amdgcn_readfirstlane(__hip_atomic_load((const unsigned*)SCAL, RLX_AGENT)));
        for (int L = vcu; L < 1024; L += G) {
            att::f32x16 o[4];
            if (MK_P3_DIFF && L < 512) {
                int tl = MK_TID(); asm volatile("" : "+v"(tl));
                const int bh = L >> 3, qb = L & 7, b = bh >> 3, h = bh & 7; const size_t tok0 = (size_t)b * SEQ + qb * 256;
                LAS unsigned* stash = (LAS unsigned*)(lds + 65536);
                att::attn_core<64, 2>(QD + tok0 * 1024 + (2 * h) * 64, 1024, KD + (size_t)b * SEQ * 1024 + (2 * h) * 64, 1024, VD + (size_t)b * SEQ * 1024 + h * 128, 1024, SEQ, al, o, tl);
#pragma unroll
                for (int d0 = 0; d0 < 4; ++d0)
#pragma unroll
                    for (int r = 0; r < 16; r += 2) stash[(d0 * 8 + (r >> 1)) * 512 + tl] = pg8::cvt_pk_bf16(o[d0][r], o[d0][r + 1]);
                int tl2 = tl; asm volatile("" : "+v"(tl2)); const int r32b = tl2 & 31, hhb = (tl2 >> 5) & 1, twb = tl2 >> 6;
                att::attn_core<64, 2>(QD + tok0 * 1024 + (2 * h + 1) * 64, 1024, KD + (size_t)b * SEQ * 1024 + (2 * h + 1) * 64, 1024, VD + (size_t)b * SEQ * 1024 + h * 128, 1024, SEQ, al, o, tl2);
                float q[16];
#pragma unroll
                for (int r = 0; r < 16; ++r) q[r] = 0.f;
#pragma unroll
                for (int d0 = 0; d0 < 4; ++d0)
#pragma unroll
                    for (int r = 0; r < 16; r += 2) { const unsigned w = stash[(d0 * 8 + (r >> 1)) * 512 + tl2];
                        o[d0][r] = pg8::bf_lo(w) - lam * o[d0][r]; o[d0][r + 1] = pg8::bf_hi(w) - lam * o[d0][r + 1]; q[r] += o[d0][r] * o[d0][r]; q[r + 1] += o[d0][r + 1] * o[d0][r + 1]; }
#pragma unroll
                for (int r = 0; r < 16; ++r) { float s = q[r];
#define SWZ_ADD(m) s += __int_as_float(__builtin_amdgcn_ds_swizzle(__float_as_int(s), ((m) << 10) | 0x1f))
                    SWZ_ADD(1); SWZ_ADD(2); SWZ_ADD(4); SWZ_ADD(8); SWZ_ADD(16);
#undef SWZ_ADD
                    q[r] = rsqrtf(s * (1.f / 128.f) + 1e-5f) * 0.8f; }
#pragma unroll
                for (int d0 = 0; d0 < 4; ++d0) { const float g = ap->subln_g[d0 * 32 + r32b];
#pragma unroll
                    for (int r = 0; r < 16; ++r) o[d0][r] *= q[r] * g; }
                (void)twb; (void)hhb; store_o_i8_lds(o, lds + RING_OFF, ws + (288u << 20) + tok0 * 2048 + h * 128, 2048, tl2, OA_I8);
                __syncthreads();
            } else if (MK_P3_MLA) {
                int tl = MK_TID(); asm volatile("" : "+v"(tl));
                const int L2 = L - 512, bh = L2 >> 3, qb = L2 & 7, b = bh >> 3, h = bh & 7; const size_t tok0 = (size_t)b * SEQ + qb * 256;
                att::attn_core_f8<3, true>((const unsigned char*)QM + tok0 * 1536 + h * 192, 1536, (const unsigned char*)KM + (size_t)b * SEQ * 1024 + h * 128, 1024, ws + WS_KPE + (size_t)b * SEQ * 64, (const unsigned char*)VM + (size_t)b * SEQ * 1024 + h * 128, 1024, SEQ, al, o, tl, MLA_SCA, MLA_SCB, MLA_SCV, MLA_SCP);
                int tl3 = tl; asm volatile("" : "+v"(tl3));
                store_ot_fp8_lds(o, lds + RING_OFF, (unsigned char*)OB + tok0 * 2048 + h * 128, 2048, tl3, 8.f);
            }
        }
    }
    SEAM(3);

    if (IN(4)) { asm volatile("; MKPHASE 4" ::: "memory"); PHASE_IDS();
        SchedGate S; S.ord.init(NTOK / 256, 2048 / 256, G, bx); S.A0 = (const char*)(ws + (288u << 20)); S.A1 = (const char*)OB; S.B0 = (const char*)WOA_T; S.B1 = (const char*)WOB_T; S.tA = (size_t)256 * 1024 * 2; S.tB = (size_t)256 * 1024 * 2;
        EpiGate E{SGA, SGB, MG};
        pg8::gemm_phase<EpiGate, SchedGate, false, true, true, 2, true, true>(lds + RING_OFF, 1024, 1024, 1024, S, E, MK_TID(), skip_epi);
    }
    SEAM(4);

    if (IN(5)) { asm volatile("; MKPHASE 5" ::: "memory"); PHASE_IDS();
        const bool conv_first = (G != 256) || (((vcu >> 5) & 1) == 0);
        const int nconv = (G == 256) ? MOE_GU_P5 : MOE_N_GU;
        if (conv_first) { moe_conv_run<0>(gw, nconv, NGW, ap, ws, scr, lane); __syncthreads(); }
        { SchedTile S; S.ord.init(NTOK / 256, 2048 / 256, G, bx); S.Ab = (const char*)MG; S.Bb = (const char*)WOUT_T; S.tA = (size_t)256 * 2048; S.tB = (size_t)256 * 2048;
          EpiResid<true, true> E{HB, HB, SS_H1, ws + WS_H8, 1.f / (MG_SCALE * WOUT_SCALE)};
          pg8::gemm_phase<EpiResid<true, true>, SchedTile, false, true, false, 1, false, true>(lds + RING_OFF, 2048, 2048, 2048, S, E, MK_TID(), skip_epi); }
        if (!conv_first) { __syncthreads(); moe_conv_run<0>(gw, nconv, NGW, ap, ws, scr, lane); }
    }
    SEAM(5);

    if (IN(6)) { asm volatile("; MKPHASE 6" ::: "memory"); PHASE_IDS();
        if (bx < 128 || G != 256) {
            SchedTile S; S.ord.init(NTOK / 256, 512 / 256, G, bx); S.Ab = (const char*)(ws + WS_H8); S.Bb = (const char*)(ws + WS_WCQ8); S.tA = (size_t)256 * 2048; S.tB = (size_t)256 * 2048;
            EpiPlain<true> E{QC, 512, SS_H1, 1.f / 2048.f, C2C * MLA_QS / (H_I8 * W_I8), 1};
            pg8::gemm_phase<EpiPlain<true>, SchedTile, false, true, false, 1, false, true>(lds + RING_OFF, 2048, 2048, 2048, S, E, MK_TID(), skip_epi);
        }
        if (G != 256 || (bx >= 128 && bx < 160)) {
            SchedOff S{1024 / 256, NB * MEML / 256 * 4, G == 256 ? bx - 128 : bx, (const char*)(ws + WS_MEMN8), (const char*)(ws + WS_WCKV8), (size_t)256 * 2048, (size_t)256 * 2048};
            EpiPlain<false> E{KVC, 1024, nullptr, 0.f, MLA_KS / WIN_SCALE, 1}; pg8::gemm_phase<EpiPlain<false>, SchedOff, false, true, false, 1>(lds + RING_OFF, 2048, 2048, 2048, S, E, MK_TID(), skip_epi);
        }
        if (G == 256 && bx >= 160) moe_conv_run<0>(MOE_GU_P5 + (bx - 160) * NWAVES + wave, MOE_N_GU, 96 * NWAVES, ap, ws, scr, lane);
    }
    SEAM(6);

    if (IN(7)) { asm volatile("; MKPHASE 7" ::: "memory"); PHASE_IDS();
        char* al = (char*)lds_raw + RING_OFF;
        for (int L = vcu; L < 256; L += G) {
            const int bh = L >> 3, qb = L & 7, b = bh >> 2, h = bh & 3; const size_t tok0 = (size_t)b * SEQ + qb * 256;
            att::f32x16 o[4]; int tl = MK_TID(); asm volatile("" : "+v"(tl));
            att::attn_core_f8<2, false>((const unsigned char*)QC + tok0 * 512 + h * 128, 512, (const unsigned char*)KVC + (size_t)b * MEML * 1024 + h * 128, 1024, nullptr, (const unsigned char*)KVC + (size_t)b * MEML * 1024 + 512 + h * 128, 1024, MEML, al, o, tl, MLA_SCA, MLA_SCB, MLA_SCV, MLA_SCP);
            int tl3 = tl; asm volatile("" : "+v"(tl3));
            store_ot_fp8_lds(o, lds + RING_OFF, (unsigned char*)OC + tok0 * 512 + h * 128, 512, tl3, 8.f);
        }
    }
    SEAM(7);

    if (IN(8)) { asm volatile("; MKPHASE 8" ::: "memory"); PHASE_IDS();
        SchedTile S; S.ord.init(NTOK / 256, 2048 / 256, G, bx); S.Ab = (const char*)OC; S.Bb = (const char*)WCO_T; S.tA = (size_t)256 * 512; S.tB = (size_t)256 * 512;
        EpiResid<true> E{HB, HB, nullptr, ws + WS_H8, 1.f / 512.f};
        pg8::gemm_phase<EpiResid<true>, SchedTile, false, true, false, 1>(lds + RING_OFF, 512, 512, 512, S, E, MK_TID(), skip_epi);
    }
    SEAM(8);

    if (IN(9)) { asm volatile("; MKPHASE 9" ::: "memory"); PHASE_IDS();
        const int tg = wave & 1, kq4 = wave >> 1;
        LAS float* rbias = (LAS float*)(lds + RING_OFF + 65536);
        if (wave == 0 && lane < 36) rbias[lane] = lane < 4 ? ap->b_rg[lane] : ap->b_re[lane - 4];
        LAS float* lgb = (LAS float*)(lds + RING_OFF + tg * 32768);
        LAS float* lg = lgb + kq4 * 1600;
        for (int grp = vcu * 2 + tg; grp < NTOK / 32; grp += G * 2) {
            const int row = lane & 15, kq = lane >> 4, tok0 = grp * 32;
            const GAS u32x4* hp0 = (const GAS u32x4*)(HB + (size_t)(tok0 + row) * DM + kq4 * (DM / 4)) + kq; const GAS u32x4* hp1 = hp0 + 16 * DM / 8;
            const GAS u32x4* wh = (const GAS u32x4*)((const bf16*)WR_T + (size_t)row * DM + kq4 * (DM / 4)) + kq;
            const GAS u32x4* wl = wh + 48 * DM / 8;
            f32x4 c[2][3]; float ss0 = 0.f, ss1 = 0.f;
#pragma unroll
            for (int i = 0; i < 2; ++i)
#pragma unroll
                for (int j = 0; j < 3; ++j) c[i][j] = (f32x4){0.f, 0.f, 0.f, 0.f};
#pragma unroll 4
            for (int ks = 0; ks < DM / 128; ++ks) { const u32x4 aw0 = hp0[ks * 4], aw1 = hp1[ks * 4];
                u32x4 bh[3], bl[3];
#pragma unroll
                for (int j = 0; j < 3; ++j) { bh[j] = wh[ks * 4 + j * 16 * DM / 8]; bl[j] = wl[ks * 4 + j * 16 * DM / 8]; }
#define SSQ(W) (((pg8::bf_lo(W.x) * pg8::bf_lo(W.x) + pg8::bf_hi(W.x) * pg8::bf_hi(W.x)) + (pg8::bf_lo(W.y) * pg8::bf_lo(W.y) + pg8::bf_hi(W.y) * pg8::bf_hi(W.y))) + ((pg8::bf_lo(W.z) * pg8::bf_lo(W.z) + pg8::bf_hi(W.z) * pg8::bf_hi(W.z)) + (pg8::bf_lo(W.w) * pg8::bf_lo(W.w) + pg8::bf_hi(W.w) * pg8::bf_hi(W.w))))
                ss0 += SSQ(aw0); ss1 += SSQ(aw1);
#undef SSQ
                const bf16x8 af0 = __builtin_bit_cast(bf16x8, aw0), af1 = __builtin_bit_cast(bf16x8, aw1);
#pragma unroll
                for (int j = 0; j < 3; ++j) { const bf16x8 fh = __builtin_bit_cast(bf16x8, bh[j]), fl = __builtin_bit_cast(bf16x8, bl[j]);
                    c[0][j] = __builtin_amdgcn_mfma_f32_16x16x32_bf16(af0, fh, c[0][j], 0, 0, 0); c[0][j] = __builtin_amdgcn_mfma_f32_16x16x32_bf16(af0, fl, c[0][j], 0, 0, 0);
                    c[1][j] = __builtin_amdgcn_mfma_f32_16x16x32_bf16(af1, fh, c[1][j], 0, 0, 0); c[1][j] = __builtin_amdgcn_mfma_f32_16x16x32_bf16(af1, fl, c[1][j], 0, 0, 0); } }
            ss0 += __shfl_xor(ss0, 16); ss0 += __shfl_xor(ss0, 32); ss1 += __shfl_xor(ss1, 16); ss1 += __shfl_xor(ss1, 32);
#pragma unroll
            for (int mb = 0; mb < 2; ++mb)
#pragma unroll
                for (int t = 0; t < 4; ++t) { const int i = 16 * mb + 4 * kq + t;
#pragma unroll
                    for (int j = 0; j < 3; ++j) lg[i * 48 + 16 * j + row] = c[mb][j][t]; }
            if (kq == 0) { lg[1536 + row] = ss0; lg[1536 + 16 + row] = ss1; }
            __syncthreads();
            if (kq4 == 0) {
                const int tl = lane & 31; const LAS float* l = lgb + tl * 48;
                const float rs = rsqrtf(((lgb[1536 + tl] + lgb[1600 + 1536 + tl]) + (lgb[3200 + 1536 + tl] + lgb[4800 + 1536 + tl])) * (1.f / DM) + 1e-6f);
#define LG(j) (((l[j] + l[1600 + (j)]) + (l[3200 + (j)] + l[4800 + (j)])) * rs)
                int g = 0; float gm = LG(0) + rbias[0];
                for (int j = 1; j < 4; ++j) { const float v = LG(j) + rbias[j]; if (v > gm) { gm = v; g = j; } }
                float gs = 0.f; for (int j = 0; j < 4; ++j) gs += expf(LG(j) + rbias[j] - gm); const float gp = 1.f / gs;
                int i0 = 0; float m0 = LG(4 + g * 8) + rbias[4 + g * 8];
                for (int j = 1; j < 8; ++j) { const float v = LG(4 + g * 8 + j) + rbias[4 + g * 8 + j]; if (v > m0) { m0 = v; i0 = j; } }
                int i1 = 0; float m1 = -3.0e38f;
                for (int j = 0; j < 8; ++j) { const float v = LG(4 + g * 8 + j) + rbias[4 + g * 8 + j]; if (j != i0 && v > m1) { m1 = v; i1 = j; } }
#undef LG
                const float p1 = expf(m1 - m0), w0 = 1.f / (1.f + p1), w1 = p1 / (1.f + p1);
                const int second = lane >> 5, e = g * 8 + (second ? i1 : i0), tk = tok0 + tl;
                int rank = 0, run = 0, lead = 0;
#pragma unroll 1
                for (int x = 0; x < 32; ++x) { const unsigned long long mk_ = __ballot(e == x);
                    if (e == x) { rank = __popcll(mk_ & ((1ull << lane) - 1ull)); run = __popcll(mk_); lead = __ffsll((long long)mk_) - 1; } }
                int base = 0; if (lane == lead) base = (int)__hip_atomic_fetch_add(ctl + CW_CNT + 16 * e, (unsigned)run, RLX_AGENT);
                base = __shfl(base, lead); const int slot = base + rank;
                LIST[e * NTOK + slot] = tk; LISTR[e * NTOK + slot] = rs;
                TOKES[tk * 2 + second] = (e << 16) | slot; TOKW[tk * 2 + second] = gp * (second ? w1 : w0);
            }
            __syncthreads();
        }
    }
    SEAM(9);
    LAS int* tpre = (LAS int*)(lds + LDSCTL_OFF); LAS int* ecnt = (LAS int*)(lds + LDSCTL_OFF + 160);
    if (hi > 10 && lo <= 12) { gu32* const ctl = (gu32*)argp()->ws;
        if (MK_TID() == 0) { int s = 0; for (int e = 0; e < 32; ++e) { const int c = (int)__hip_atomic_load(ctl + CW_CNT + 16 * e, RLX_AGENT); ecnt[e] = c; tpre[e] = s; s += (c + 255) >> 8; } tpre[32] = s; }
        __syncthreads();
    }
    const MoeTab tab{tpre, ecnt};

    if (IN(10)) { asm volatile("; MKPHASE 10" ::: "memory"); PHASE_IDS();
        SchedMoe1 S{tab, G, vcu, (const char*)(ws + WS_H8), (const char*)WGU_T, LIST};
        EpiHid E{HID, LISTR, ecnt};
        pg8::gemm_phase<EpiHid, SchedMoe1, true, true, false, 1, false, true>(lds + RING_OFF, 2048, 2048, 2048, S, E, MK_TID(), skip_epi);
        { const int U = tab.tpre[32] * 4, R = (U + G - 1) / G, first_light = U - (R - 1) * G, n_light = G - first_light;
          __syncthreads();
          if (n_light >= 32) { if (vcu >= first_light) moe_conv_run<1>((vcu - first_light) * NWAVES + wave, MOE_N_DN, n_light * NWAVES, ap, ws, scr, lane); }
          else moe_conv_run<1>(gw, MOE_N_DN, NGW, ap, ws, scr, lane); }
    }
    SEAM(10);

    if (IN(11)) { asm volatile("; MKPHASE 11" ::: "memory"); PHASE_IDS();
        SchedMoe2 S{tab, G, vcu, (const char*)HID, (const char*)WD_T};
        EpiDown E{Y, tab, Y_SCALE / (HID_SCALE * WD_SCALE)};
        pg8::gemm_phase<EpiDown, SchedMoe2, false, true, false, 1>(lds + RING_OFF, 512, 512, 512, S, E, MK_TID(), skip_epi);
    }
    SEAM(11);

    if (IN(12)) { asm volatile("; MKPHASE 12" ::: "memory"); PHASE_IDS();
        for (int tokA = gw; tokA < NTOK; tokA += 4 * NGW) {
            const GAS f32x4* gp = (const GAS f32x4*)ap->final_norm_g + lane;
#define P12_DECL(X, TOKX) const bool has##X = (TOKX) < NTOK; const int t##X = has##X ? (TOKX) : tokA; \
            const int e0##X = TOKES[t##X * 2], e1##X = TOKES[t##X * 2 + 1]; const float w0##X = TOKW[t##X * 2] * (1.f / Y_SCALE), w1##X = TOKW[t##X * 2 + 1] * (1.f / Y_SCALE); \
            const size_t r0##X = (size_t)tpre[e0##X >> 16] * 256 + (e0##X & 0xffff), r1##X = (size_t)tpre[e1##X >> 16] * 256 + (e1##X & 0xffff); \
            const GAS u32x2* h##X = (const GAS u32x2*)(HB + (size_t)t##X * DM) + lane; const GAS unsigned* y0##X = (const GAS unsigned*)((const unsigned char*)Y + r0##X * DM) + lane; const GAS unsigned* y1##X = (const GAS unsigned*)((const unsigned char*)Y + r1##X * DM) + lane; \
            u32x2 hw##X[8]; unsigned p##X[8], q##X[8];
#define P12_LD(X) _Pragma("unroll") for (int j = 0; j < 8; ++j) { hw##X[j] = h##X[64 * j]; p##X[j] = y0##X[64 * j]; q##X[j] = y1##X[64 * j]; }
            P12_DECL(A, tokA) P12_DECL(B, tokA + NGW) P12_DECL(C, tokA + 2 * NGW) P12_DECL(D, tokA + 3 * NGW)
            P12_LD(A) P12_LD(B) P12_LD(C) P12_LD(D)
#undef P12_DECL
#undef P12_LD
#define P12_ONE(TOK, HW, PP, QQ, W0, W1) do { f32x4 v[8]; float s_ = 0.f; \
            _Pragma("unroll") for (int j = 0; j < 8; ++j) { f32x4 t = {pg8::bf_lo(HW[j].x), pg8::bf_hi(HW[j].x), pg8::bf_lo(HW[j].y), pg8::bf_hi(HW[j].y)}; \
                { const auto p01 = __builtin_amdgcn_cvt_pk_f32_fp8((int)PP[j], false), p23 = __builtin_amdgcn_cvt_pk_f32_fp8((int)PP[j], true), q01 = __builtin_amdgcn_cvt_pk_f32_fp8((int)QQ[j], false), q23 = __builtin_amdgcn_cvt_pk_f32_fp8((int)QQ[j], true); \
                  t[0] += W0 * p01[0] + W1 * q01[0]; t[1] += W0 * p01[1] + W1 * q01[1]; t[2] += W0 * p23[0] + W1 * q23[0]; t[3] += W0 * p23[1] + W1 * q23[1]; } \
                v[j] = t; s_ += (t[0] * t[0] + t[1] * t[1]) + (t[2] * t[2] + t[3] * t[3]); } \
            const float rstd_ = rsqrtf(wave_sum(s_) * (1.f / DM) + 1e-6f); GAS f32x4* op_ = (GAS f32x4*)(ap->out + (size_t)(TOK) * DM) + lane; \
            _Pragma("unroll") for (int j = 0; j < 8; ++j) op_[64 * j] = v[j] * rstd_ * gp[64 * j]; } while (0)
            P12_ONE(tA, hwA, pA, qA, w0A, w1A);
            if (hasB) P12_ONE(tB, hwB, pB, qB, w0B, w1B);
            if (hasC) P12_ONE(tC, hwC, pC, qC, w0C, w1C);
            if (hasD) P12_ONE(tD, hwD, pD, qD, w0D, w1D);
#undef P12_ONE
        }
    }
#undef IN
#undef SEAM
}

static int g_grid = 0;
static bool launch_fused(const Args& a0, int ph_lo, int ph_hi, hipStream_t stream, size_t ws_size) {
    if (g_grid == 0) {
        int dev = 0, cus = 0, per_cu = 0;
        if (ws_size < WS_END) { fprintf(stderr, "kernel_launch: workspace too small: %zu < %zu\n", ws_size, (size_t)WS_END); g_grid = -1; return false; }
        if (hipGetDevice(&dev) != hipSuccess || hipDeviceGetAttribute(&cus, hipDeviceAttributeMultiprocessorCount, dev) != hipSuccess) { g_grid = -1; return false; }
        if (hipFuncSetAttribute((const void*)fused_fwd, hipFuncAttributeMaxDynamicSharedMemorySize, LDS_BYTES) != hipSuccess) { fprintf(stderr, "kernel_launch: hipFuncSetAttribute failed\n"); g_grid = -1; return false; }
        if (hipOccupancyMaxActiveBlocksPerMultiprocessor(&per_cu, (const void*)fused_fwd, NWAVES * 64, LDS_BYTES) != hipSuccess || per_cu < 1) { fprintf(stderr, "kernel_launch: occupancy query reports %d blocks per CU\n", per_cu); (void)hipGetLastError(); g_grid = -1; return false; }
        g_grid = cus;
    }
    if (g_grid < 0) return false;
    Args a = a0; a.ph_lo = ph_lo; a.ph_hi = ph_hi;
    hipLaunchKernelGGL(fused_fwd, dim3(g_grid), dim3(NWAVES * 64), LDS_BYTES, stream, a);
    return true;
}
static Args make_args(void* const* d_in, void* d_out, void* d_ws) {
    Args a{}; int k = 0;
    a.x = (const float*)d_in[k++]; a.mem = (const float*)d_in[k++]; a.positions = (const int*)d_in[k++]; a.attn_norm_g = (const float*)d_in[k++]; a.w_in = (const float*)d_in[k++];
    a.lq1 = (const float*)d_in[k++]; a.lk1 = (const float*)d_in[k++]; a.lq2 = (const float*)d_in[k++]; a.lk2 = (const float*)d_in[k++]; a.subln_g = (const float*)d_in[k++]; a.w_o_diff = (const float*)d_in[k++];
    a.mla_q_norm_g = (const float*)d_in[k++]; a.w_uq = (const float*)d_in[k++]; a.mla_kv_norm_g = (const float*)d_in[k++]; a.w_ukv = (const float*)d_in[k++]; a.w_o_mla = (const float*)d_in[k++]; a.w_out = (const float*)d_in[k++];
    a.cross_norm_g = (const float*)d_in[k++]; a.mem_norm_g = (const float*)d_in[k++]; a.w_cq = (const float*)d_in[k++]; a.w_ckv = (const float*)d_in[k++]; a.w_co = (const float*)d_in[k++];
    a.ffn_norm_g = (const float*)d_in[k++]; a.w_rg = (const float*)d_in[k++]; a.b_rg = (const float*)d_in[k++]; a.w_re = (const float*)d_in[k++]; a.b_re = (const float*)d_in[k++];
    a.w_gate = (const float*)d_in[k++]; a.w_up = (const float*)d_in[k++]; a.w_down = (const float*)d_in[k++]; a.final_norm_g = (const float*)d_in[k++];
    a.out = (float*)d_out; a.ws = (unsigned char*)d_ws; a.ph_lo = 0; a.ph_hi = N_PHASES;
    return a;
}
#undef WIN_T
#undef WOA_T
#undef WOB_T
#undef WOUT_T
#undef WUQ_T
#undef WUKV_T
#undef WCQ_T
#undef WCKV_T
#undef WCO_T
#undef XN
#undef QM
#undef MG
#undef QD
#undef KD
#undef VD
#undef CQ
#undef CKV
#undef SGA
#undef SGB
#undef KM
#undef VM
#undef OB
#undef MEMN
#undef KVC
#undef HB
#undef QC
#undef OC
#undef WGU_T
#undef WD_T
#undef HID
#undef Y
#undef SS_CQ
#undef SS_CKV
#undef SS_H1
#undef ROPE_D
#undef ROPE_M
#undef WR_T
#undef TOKES
#undef TOKW
#undef SCAL
#undef LIST
#undef LISTR
}
extern "C" void kernel_launch(void* const* d_in, const int* in_sizes, int n_in, void* d_out, int out_size, void* d_ws, size_t ws_size, hipStream_t stream) {
    if (n_in != 31 || out_size != mk::NTOK * mk::DM) { fprintf(stderr, "kernel_launch: unexpected n_in %d / out_size %d\n", n_in, out_size); return; }
    const mk::Args a = mk::make_args(d_in, d_out, d_ws);
    if (hipMemsetAsync((char*)d_ws + mk::WS_CTL, 0, mk::CTL_ZERO_BYTES, stream) != hipSuccess) return;
    mk::launch_fused(a, 0, mk::N_PHASES, stream, ws_size);
}
```
